# Optimizing an MI355X kernel written in HIP

```python
import jax, jax.numpy as jnp
from jax import lax
import numpy as np

D_MODEL = 1024
BATCH = 8
SEQ = 2048
DEPTH = 4
DEC_BATCH = 128
DEC_SEQ = 8
PAST_LEN = 16384
PAGE_SIZE = 128

N_MIXERS = 2
N_POOL_LAYERS = (DEPTH + 1) // 2
N_SSD_LAYERS = DEPTH // 2
EXPAND = 2
D_INNER = EXPAND * D_MODEL
POOL_WINDOWS = (2, 4, 8, 16)
N_POOL_GROUPS = len(POOL_WINDOWS)
POOL_GROUP = D_INNER // N_POOL_GROUPS
POOL_BUF = max(POOL_WINDOWS) - 1
HEAD_DIM = 64
N_HEADS = D_INNER // HEAD_DIM
D_STATE = 128
N_GROUPS = 4
HEADS_PER_GROUP = N_HEADS // N_GROUPS
CONV_K = 4
CONV_DIM = D_INNER + 2 * N_GROUPS * D_STATE
SSD_IN = D_INNER + CONV_DIM + N_HEADS
CHUNK = 128
EPS = 1e-6

kernel_name = 'pool_ssd_hybrid_step'


def rmsnorm(x, w):
    xf = x.astype(jnp.float32)
    y = xf * lax.rsqrt(jnp.mean(xf * xf, axis=-1, keepdims=True) + EPS)
    return (y * w.astype(jnp.float32)).astype(x.dtype)


def pool_mixer(h, buf, start, w_in, w_mix, scale, w_out):
    b, l, _ = h.shape
    uz = h @ w_in
    u, z = uz[..., :D_INNER], uz[..., D_INNER:]
    u_ext = jnp.concatenate([buf.astype(u.dtype), u], axis=1)
    csum = jnp.cumsum(u_ext.astype(jnp.float32), axis=1)
    csum = jnp.concatenate([jnp.zeros((b, 1, D_INNER), jnp.float32), csum], axis=1)
    hi = csum[:, POOL_BUF + 1:]
    pos = start + jnp.arange(l)
    uf = u.astype(jnp.float32)
    outs = []
    for g, w in enumerate(POOL_WINDOWS):
        sl = slice(g * POOL_GROUP, (g + 1) * POOL_GROUP)
        lo = csum[:, POOL_BUF + 1 - w:POOL_BUF + 1 - w + l, sl]
        cnt = jnp.minimum(pos + 1, w).astype(jnp.float32)[None, :, None]
        outs.append((hi[..., sl] - lo) / cnt - uf[..., sl])
    p = jnp.stack(outs, axis=2)
    mixed = jnp.einsum('blgc,gcd->blgd', p, w_mix.astype(jnp.float32)).reshape(b, l, D_INNER)
    y = mixed * scale.astype(jnp.float32) * jax.nn.silu(z.astype(jnp.float32))
    return y.astype(h.dtype) @ w_out, u_ext[:, -POOL_BUF:]


def causal_conv(xbc, buf, w, bias):
    l = xbc.shape[1]
    ext = jnp.concatenate([buf.astype(xbc.dtype), xbc], axis=1)
    out = ext[:, 0:l] * w[0]
    for k in range(1, CONV_K):
        out = out + ext[:, k:k + l] * w[k]
    return jax.nn.silu(out + bias), ext[:, -(CONV_K - 1):]


def ssd_scan(x, dt, A, B, C, h0):
    b, l = x.shape[:2]
    q = min(CHUNK, l)
    nc = l // q
    x = x.reshape(b, nc, q, N_GROUPS, HEADS_PER_GROUP, HEAD_DIM)
    dt = dt.reshape(b, nc, q, N_GROUPS, HEADS_PER_GROUP)
    B = B.reshape(b, nc, q, N_GROUPS, D_STATE)
    C = C.reshape(b, nc, q, N_GROUPS, D_STATE)
    a = dt * A.reshape(N_GROUPS, HEADS_PER_GROUP)
    a_cum_t = jnp.moveaxis(jnp.cumsum(a, axis=2), 2, -1)
    dt_t = jnp.moveaxis(dt, 2, -1)
    causal = jnp.tril(jnp.ones((q, q), bool))
    seg = a_cum_t[..., :, None] - a_cum_t[..., None, :]
    L = jnp.exp(jnp.where(causal, seg, -jnp.inf))
    CB = jnp.einsum('bcign,bcjgn->bcgij', C, B)
    W = CB[:, :, :, None] * L * dt_t[..., None, :]
    y_diag = jnp.einsum('bcgeij,bcjgep->bcigep', W, x)
    decay_to_end = jnp.exp(a_cum_t[..., -1:] - a_cum_t) * dt_t
    chunk_states = jnp.einsum('bcjgn,bcgej,bcjgep->bcgepn', B, decay_to_end, x)
    chunk_decay = jnp.exp(a_cum_t[..., -1])

    def step(hs, inp):
        s, d = inp
        return d[..., None, None] * hs + s, hs

    h0g = h0.reshape(b, N_GROUPS, HEADS_PER_GROUP, HEAD_DIM, D_STATE)
    h_final, h_prev = lax.scan(step, h0g, (jnp.moveaxis(chunk_states, 1, 0), jnp.moveaxis(chunk_decay, 1, 0)))
    h_prev = jnp.moveaxis(h_prev, 0, 1)
    y_off = jnp.einsum('bcign,bcgepn,bcgei->bcigep', C, h_prev, jnp.exp(a_cum_t))
    y = (y_diag + y_off).reshape(b, l, N_HEADS, HEAD_DIM)
    return y, h_final.reshape(b, N_HEADS, HEAD_DIM, D_STATE)


def ssd_mixer(h, conv_buf, ssm_state, w_in, conv_w, conv_b, dt_bias, A_log, D_skip, norm_w, w_out):
    b, l, _ = h.shape
    proj = h @ w_in
    z = proj[..., :D_INNER]
    xbc = proj[..., D_INNER:D_INNER + CONV_DIM]
    dt_raw = proj[..., D_INNER + CONV_DIM:]
    xbc, new_conv = causal_conv(xbc, conv_buf, conv_w, conv_b)
    xbc = xbc.astype(jnp.float32)
    xs = xbc[..., :D_INNER].reshape(b, l, N_HEADS, HEAD_DIM)
    Bm = xbc[..., D_INNER:D_INNER + N_GROUPS * D_STATE].reshape(b, l, N_GROUPS, D_STATE)
    Cm = xbc[..., D_INNER + N_GROUPS * D_STATE:].reshape(b, l, N_GROUPS, D_STATE)
    dt = jax.nn.softplus(dt_raw.astype(jnp.float32) + dt_bias.astype(jnp.float32))
    A = -jnp.exp(A_log.astype(jnp.float32))
    y, new_ssm = ssd_scan(xs, dt, A, Bm, Cm, ssm_state.astype(jnp.float32))
    y = y + D_skip.astype(jnp.float32)[:, None] * xs
    y = y.reshape(b, l, D_INNER) * jax.nn.silu(z.astype(jnp.float32))
    y = rmsnorm(y, norm_w)
    return y.astype(h.dtype) @ w_out, new_conv, new_ssm.astype(ssm_state.dtype)


def trunk(x, pool_buf, conv_buf, ssm_buf, start, norm_w, pool_in_w, pool_mix_w, pool_scale, pool_out_w,
          ssd_in_w, ssd_conv_w, ssd_conv_b, ssd_dt_bias, ssd_A_log, ssd_D, ssd_norm_w, ssd_out_w, final_norm_w):
    new_pool, new_conv, new_ssm = [], [], []
    for i in range(DEPTH):
        h = rmsnorm(x, norm_w[i])
        j = i // N_MIXERS
        if i % N_MIXERS == 0:
            out, nb = pool_mixer(h, pool_buf[j], start, pool_in_w[j], pool_mix_w[j], pool_scale[j], pool_out_w[j])
            new_pool.append(nb)
        else:
            out, nc, ns = ssd_mixer(h, conv_buf[j], ssm_buf[j], ssd_in_w[j], ssd_conv_w[j], ssd_conv_b[j],
                                    ssd_dt_bias[j], ssd_A_log[j], ssd_D[j], ssd_norm_w[j], ssd_out_w[j])
            new_conv.append(nc)
            new_ssm.append(ns)
        x = x + out
    return rmsnorm(x, final_norm_w), jnp.stack(new_pool), jnp.stack(new_conv), jnp.stack(new_ssm)


def setup_inputs(seed: int = 0) -> dict:
    key = jax.random.key(seed)
    ks = jax.random.split(key, 20)
    f32 = jnp.float32
    nrm = lambda k, s, sc: jax.random.normal(k, s, f32) * sc
    dt0 = jnp.exp(jax.random.uniform(ks[14], (N_SSD_LAYERS, N_HEADS), f32, np.log(1e-3), np.log(1e-1)))
    return {
        'x_prompt': nrm(ks[0], (BATCH, SEQ, D_MODEL), 1.0),
        'x_sample': nrm(ks[1], (DEC_BATCH, DEC_SEQ, D_MODEL), 1.0),
        'state_pool': nrm(ks[2], (N_POOL_LAYERS, DEC_BATCH, POOL_BUF, D_INNER), 1.0),
        'state_conv': nrm(ks[3], (N_SSD_LAYERS, DEC_BATCH, CONV_K - 1, CONV_DIM), 1.0),
        'state_ssm': nrm(ks[4], (N_SSD_LAYERS, DEC_BATCH, N_HEADS, HEAD_DIM, D_STATE), 0.1),
        'norm_w': 1.0 + nrm(ks[5], (DEPTH, D_MODEL), 0.02),
        'pool_in_w': nrm(ks[6], (N_POOL_LAYERS, D_MODEL, 2 * D_INNER), D_MODEL ** -0.5),
        'pool_mix_w': nrm(ks[7], (N_POOL_LAYERS, N_POOL_GROUPS, POOL_GROUP, POOL_GROUP), POOL_GROUP ** -0.5),
        'pool_scale': 1.0 + nrm(ks[8], (N_POOL_LAYERS, D_INNER), 0.1),
        'pool_out_w': nrm(ks[9], (N_POOL_LAYERS, D_INNER, D_MODEL), D_INNER ** -0.5),
        'ssd_in_w': nrm(ks[10], (N_SSD_LAYERS, D_MODEL, SSD_IN), D_MODEL ** -0.5),
        'ssd_conv_w': nrm(ks[11], (N_SSD_LAYERS, CONV_K, CONV_DIM), CONV_K ** -0.5),
        'ssd_conv_b': nrm(ks[12], (N_SSD_LAYERS, CONV_DIM), 0.01),
        'ssd_dt_bias': dt0 + jnp.log(-jnp.expm1(-dt0)),
        'ssd_A_log': jnp.log(jax.random.uniform(ks[13], (N_SSD_LAYERS, N_HEADS), f32, 1.0, 16.0)),
        'ssd_D': 1.0 + nrm(ks[15], (N_SSD_LAYERS, N_HEADS), 0.1),
        'ssd_norm_w': 1.0 + nrm(ks[16], (N_SSD_LAYERS, D_INNER), 0.02),
        'ssd_out_w': nrm(ks[17], (N_SSD_LAYERS, D_INNER, D_MODEL), D_INNER ** -0.5),
        'final_norm_w': 1.0 + nrm(ks[18], (D_MODEL,), 0.02),
    }


def reference(x_prompt, x_sample, state_pool, state_conv, state_ssm, norm_w, pool_in_w, pool_mix_w, pool_scale,
              pool_out_w, ssd_in_w, ssd_conv_w, ssd_conv_b, ssd_dt_bias, ssd_A_log, ssd_D, ssd_norm_w, ssd_out_w,
              final_norm_w):
    b = x_prompt.shape[0]
    dt = x_prompt.dtype
    zero_pool = jnp.zeros((N_POOL_LAYERS, b, POOL_BUF, D_INNER), dt)
    zero_conv = jnp.zeros((N_SSD_LAYERS, b, CONV_K - 1, CONV_DIM), dt)
    zero_ssm = jnp.zeros((N_SSD_LAYERS, b, N_HEADS, HEAD_DIM, D_STATE), state_ssm.dtype)
    y_prompt, pool_p, conv_p, ssm_p = trunk(
        x_prompt, zero_pool, zero_conv, zero_ssm, 0, norm_w, pool_in_w, pool_mix_w, pool_scale, pool_out_w,
        ssd_in_w, ssd_conv_w, ssd_conv_b, ssd_dt_bias, ssd_A_log, ssd_D, ssd_norm_w, ssd_out_w, final_norm_w)
    y_sample, pool_s, conv_s, ssm_s = trunk(
        x_sample, state_pool, state_conv, state_ssm, PAST_LEN, norm_w, pool_in_w, pool_mix_w, pool_scale, pool_out_w,
        ssd_in_w, ssd_conv_w, ssd_conv_b, ssd_dt_bias, ssd_A_log, ssd_D, ssd_norm_w, ssd_out_w, final_norm_w)
    return (y_prompt, y_sample, pool_p, pool_s, conv_p, conv_s, ssm_p, ssm_s)
```

```cpp
#include <hip/hip_runtime.h>
#include <hip/hip_cooperative_groups.h>
#include <cstdio>
#include <cstdint>
namespace cg = cooperative_groups;

#ifndef SPLITQ
#define SPLITQ 8
#endif
#ifndef MK_MULTI
#define MK_MULTI 0
#endif

constexpr int D_MODEL = 1024, BATCH = 8, SEQ = 2048, DEC_BATCH = 128, DEC_SEQ = 8;
constexpr int D_INNER = 2048, POOL_BUF = 15, N_HEADS = 32, D_STATE = 128, CONV_DIM = 3072, SSD_IN = 5152;
constexpr int TP = BATCH * SEQ;
constexpr int TS = DEC_BATCH * DEC_SEQ;
constexpr int T = TP + TS;
constexpr int NPANEL = T / 256;
constexpr int SSD_IN_PAD = 5376;
constexpr float EPS = 1e-6f;

constexpr size_t O_YP = 0, O_YS = O_YP + (size_t)TP * D_MODEL, O_POOLP = O_YS + (size_t)TS * D_MODEL,
                 O_POOLS = O_POOLP + (size_t)2 * BATCH * POOL_BUF * D_INNER, O_CONVP = O_POOLS + (size_t)2 * DEC_BATCH * POOL_BUF * D_INNER,
                 O_CONVS = O_CONVP + (size_t)2 * BATCH * 3 * CONV_DIM, O_SSMP = O_CONVS + (size_t)2 * DEC_BATCH * 3 * CONV_DIM,
                 O_SSMS = O_SSMP + (size_t)2 * BATCH * N_HEADS * 64 * D_STATE;

constexpr size_t al(size_t x) { return (x + 4095) & ~(size_t)4095; }
constexpr size_t WS_CTL = 0;
constexpr size_t WS_SS = 16384;
constexpr size_t WS_SS2 = al(WS_SS + (size_t)5 * T * 8);
constexpr size_t WS_WPIN = al(WS_SS2 + (size_t)2 * T * 8);
constexpr size_t WS_WMIX = al(WS_WPIN + (size_t)2 * 4096 * 1024 * 2);
constexpr size_t WS_WPOUT = al(WS_WMIX + (size_t)2 * 2048 * 512 * 2);
constexpr size_t WS_WSIN = al(WS_WPOUT + (size_t)2 * 1024 * 2048 * 2);
constexpr size_t WS_WSOUT = al(WS_WSIN + (size_t)2 * SSD_IN_PAD * 1024 * 2);
constexpr size_t WS_X = al(WS_WSOUT + (size_t)2 * 1024 * 2048 * 2);
constexpr size_t WS_XB = al(WS_X + (size_t)T * 1024 * 4);
constexpr size_t WS_U = al(WS_XB + (size_t)T * 1024 * 2);
constexpr size_t WS_Z = al(WS_U + (size_t)T * 2048 * 2);
constexpr size_t WS_P = al(WS_Z + (size_t)T * 2048 * 2);
constexpr size_t WS_Y = al(WS_P + (size_t)T * 2048 * 2);
constexpr size_t WS_XBC = al(WS_Y + (size_t)T * 2048 * 2);
constexpr size_t WS_XBCC = al(WS_XBC + (size_t)T * 3072 * 2);
constexpr size_t WS_DT = al(WS_XBCC + (size_t)T * 3072 * 2);
constexpr size_t WS_PART = al(WS_DT + (size_t)T * 32 * 4);
constexpr size_t WS_END = al(WS_PART + (size_t)8 * TS * 1024 * 4);

constexpr int LDS_STAGE = 131072 + 20480;
constexpr int LDS_BYTES = LDS_STAGE + 64;
constexpr int NTHREADS = 512;

typedef unsigned short bf16_t;
typedef short bf16x8 __attribute__((ext_vector_type(8)));
typedef float f32x4 __attribute__((ext_vector_type(4)));
typedef float f32x2 __attribute__((ext_vector_type(2)));
typedef unsigned u32x4 __attribute__((ext_vector_type(4)));
typedef unsigned u32x2 __attribute__((ext_vector_type(2)));

struct Params {
    const float *x_prompt, *x_sample, *state_pool, *state_conv, *state_ssm, *norm_w, *pool_in_w, *pool_mix_w, *pool_scale, *pool_out_w,
        *ssd_in_w, *ssd_conv_w, *ssd_conv_b, *ssd_dt_bias, *ssd_A_log, *ssd_D, *ssd_norm_w, *ssd_out_w, *final_norm_w;
    float* out;
    unsigned char* ws;
    int ph_lo, ph_hi;
};

__device__ __forceinline__ unsigned cvt_pk_bf16(float lo, float hi) { unsigned r; asm volatile("v_cvt_pk_bf16_f32 %0, %1, %2" : "=v"(r) : "v"(lo), "v"(hi)); return r; }
__device__ __forceinline__ float bf_lo(unsigned u) { return __uint_as_float(u << 16); }
__device__ __forceinline__ float bf_hi(unsigned u) { return __uint_as_float(u & 0xffff0000u); }
__device__ __forceinline__ float bf1(bf16_t b) { return __uint_as_float(((unsigned)b) << 16); }
__device__ __forceinline__ float shx(float v, int lane, int m) { return __int_as_float(__builtin_amdgcn_ds_bpermute((lane ^ m) << 2, __float_as_int(v))); }
__device__ __forceinline__ float shup(float v, int lane, int d) { const int src = lane >= d ? lane - d : lane; return __int_as_float(__builtin_amdgcn_ds_bpermute(src << 2, __float_as_int(v))); }
typedef unsigned long long u64;
__device__ __forceinline__ u64 fx(float s) { const unsigned hi = (unsigned)s; const unsigned lo = (unsigned)((s - (float)hi) * 4294967296.f); return ((u64)hi << 32) | lo; }
__device__ __forceinline__ float ssf(const u64* p) { const u64 v = *p; return (float)(unsigned)(v >> 32) + (float)(unsigned)v * 2.3283064365386963e-10f; }
__device__ __forceinline__ float silu_f(float v) { return v * __builtin_amdgcn_rcpf(1.f + __expf(-v)); }
__device__ __forceinline__ float softplus_f(float v) { return fmaxf(v, 0.f) + __logf(1.f + __expf(-fabsf(v))); }

namespace pg8 {
#define PG8_LAS __attribute__((address_space(3)))
constexpr int BM = 256, BK = 64, HALF = 128, HTB = HALF * BK * 2, STAGE_BYTES = 8 * HTB, NXCD = 8, WGM = 8;
__host__ __device__ __forceinline__ int lds_byte(int r, int c) { const int st = (r >> 4) * 2 + (c >> 5), rr = r & 15, cc = c & 31, ob = rr * 64 + cc * 2; return st * 1024 + (ob ^ (((ob >> 9) & 1) << 5)); }
__host__ __device__ __forceinline__ void stage_rc(int b, int& R, int& C) { const int st = b / 1024, sb = b % 1024, swz = sb ^ (((sb >> 9) & 1) << 5); R = (st >> 1) * 16 + swz / 64; C = (st & 1) * 32 + (swz % 64) / 2; }
__host__ __device__ __forceinline__ int perm32(int rho) { const int n = rho >> 4, i = rho & 15; return 8 * (i >> 2) + 4 * n + (i & 3); }

struct Unit { int pm, pn, kofs, nt; };
struct Gemm { const bf16_t* A; const bf16_t* Bt; int M, N, K; };

struct Sched {
    int nM, nN, nwg, G, c, grouped, ntf, split;
    __device__ void init(int nM_, int nN_, int G_, int c_, int grouped_, int ntf_, int split_) { nM = nM_; nN = nN_; nwg = nM * nN + (split_ ? 16 * SPLITQ : 0); G = G_; c = c_; grouped = grouped_; ntf = ntf_; split = split_; }
    __device__ bool next(int i, Unit& u) const {
        const long L = (long)i * G + c; if (L >= nwg) return false;
        const int nfull = nM * nN;
        if (L >= nfull) { const int idx = (int)L - nfull, tile = idx / SPLITQ, q = idx % SPLITQ; u.pm = 64 + (tile >> 2); u.pn = tile & 3; u.kofs = q * (ntf / SPLITQ) * BK * 2; u.nt = ntf / SPLITQ; return true; }
        int wgid = (int)L; { const int q = nfull / NXCD, r = nfull % NXCD, xcd = wgid % NXCD, off = wgid / NXCD; wgid = (xcd < r ? xcd * (q + 1) : r * (q + 1) + (xcd - r) * q) + off; }
        const int nig = WGM * nN, gid = wgid / nig, fm = gid * WGM, gsz = (nM - fm) < WGM ? (nM - fm) : WGM;
        u.pm = fm + ((wgid % nig) % gsz); u.pn = (wgid % nig) / gsz; u.kofs = 0; u.nt = ntf;
        if (grouped) u.pm += (u.pn >> 1) * NPANEL;
        return true;
    }
    __device__ __forceinline__ void a_ready(const Unit&) const {}
    __device__ __forceinline__ void done(const Unit&) const {}
};

template <class Epi, class Sch>
__device__ __forceinline__ void gemm_phase(PG8_LAS unsigned char* lds, const Gemm g, const Sch& S, const Epi& E, const int tid) {
    const int wid = __builtin_amdgcn_readfirstlane(tid >> 6), lane = tid & 63, wr = wid >> 2, wc = wid & 3, fr = lane & 15, fq = lane >> 4;
    const int K = g.K;
    unsigned voffA[2], voffB[2];
#pragma unroll
    for (int i = 0; i < 2; ++i) { int R, C; stage_rc(tid * 16 + i * 8192, R, C); const int Rb = Epi::PERM ? ((R & ~31) + perm32(R & 31)) : R;
        voffA[i] = (unsigned)(R * K + C) * 2u; voffB[i] = (unsigned)(Rb * K + C) * 2u; }
    const size_t kstep = (size_t)(BK * 2);
    const size_t hstep = (size_t)HALF * K * 2;
    const size_t tstep = 2 * hstep;
    const unsigned ldsw = (unsigned)wid * 1024u;
    const int aoff = lds_byte(wr * 64 + fr, fq * 8), boff = lds_byte(wc * 32 + fr, fq * 8);
#define PG8_SA(b, h) (((b) * 2 + (h)) * HTB)
#define PG8_SB(b, h) ((4 + (b) * 2 + (h)) * HTB)
#define PG8_STAGE(bufoff, gbase, voff) do { _Pragma("unroll") for (int _i = 0; _i < 2; ++_i) \
        __builtin_amdgcn_global_load_lds((const unsigned*)((const char*)(gbase) + (voff)[_i]), (PG8_LAS unsigned*)(lds + (bufoff) + ldsw + _i * 8192), 16, 0, 0); } while (0)
#define PG8_LDA(dst, b, h) do { _Pragma("unroll") for (int m = 0; m < 4; ++m) _Pragma("unroll") for (int k = 0; k < 2; ++k) dst[m][k] = *(const PG8_LAS bf16x8*)(lds + PG8_SA(b, h) + aoff + m * 2048 + k * 1024); } while (0)
#define PG8_LDB(dst, b, h) do { _Pragma("unroll") for (int n = 0; n < 2; ++n) _Pragma("unroll") for (int k = 0; k < 2; ++k) dst[n][k] = *(const PG8_LAS bf16x8*)(lds + PG8_SB(b, h) + boff + n * 2048 + k * 1024); } while (0)
#define PG8_MMA(ai, bj, At, Bt) do { __builtin_amdgcn_s_setprio(1); _Pragma("unroll") for (int m = 0; m < 4; ++m) _Pragma("unroll") for (int n = 0; n < 2; ++n) _Pragma("unroll") for (int k = 0; k < 2; ++k) \
        acc[ai][bj][m][n] = __builtin_amdgcn_mfma_f32_16x16x32_bf16(Bt[n][k], At[m][k], acc[ai][bj][m][n], 0, 0, 0); __builtin_amdgcn_s_setprio(0); } while (0)
#define PG8_WAIT_V(n) asm volatile("s_waitcnt vmcnt(" #n ")" ::: "memory")
#define PG8_WAIT_L(n) asm volatile("s_waitcnt lgkmcnt(" #n ")" ::: "memory")
#define PG8_BAR __builtin_amdgcn_s_barrier()
#define PG8_SCHED __builtin_amdgcn_sched_barrier(0)
    Unit cur, nxt; int ui = 0;
    if (!S.next(0, cur)) return;
    f32x4 acc[2][2][4][2];
#pragma unroll
    for (int a = 0; a < 2; ++a)
#pragma unroll
        for (int b = 0; b < 2; ++b)
#pragma unroll
            for (int m = 0; m < 4; ++m)
#pragma unroll
                for (int n = 0; n < 2; ++n) acc[a][b][m][n] = (f32x4){0.f, 0.f, 0.f, 0.f};
    bf16x8 At[4][2], B0[2][2], B1[2][2];
    const char* cA = (const char*)g.A + (size_t)cur.pm * tstep + cur.kofs; const char* cB = (const char*)g.Bt + (size_t)cur.pn * tstep + cur.kofs;
    int nt = cur.nt;
    S.a_ready(cur);
    PG8_STAGE(PG8_SB(0, 0), cB, voffB); PG8_STAGE(PG8_SA(0, 0), cA, voffA); PG8_STAGE(PG8_SB(0, 1), cB + hstep, voffB); PG8_STAGE(PG8_SA(0, 1), cA + hstep, voffA);
    if (wr == 1) PG8_BAR;
    PG8_WAIT_V(4); PG8_BAR;
    PG8_STAGE(PG8_SB(1, 0), cB + kstep, voffB); PG8_STAGE(PG8_SA(1, 0), cA + kstep, voffA); PG8_STAGE(PG8_SB(1, 1), cB + hstep + kstep, voffB);
    PG8_WAIT_V(6); PG8_BAR;
    for (;;) {
        const bool has_next = S.next(ui + 1, nxt);
        const char* nA = has_next ? (const char*)g.A + (size_t)nxt.pm * tstep + nxt.kofs : cA; const char* nB = has_next ? (const char*)g.Bt + (size_t)nxt.pn * tstep + nxt.kofs : cB;
        for (int t = 0; t < nt; t += 2) {
            const bool last = (t == nt - 2);
            const char* a1 = cA + (size_t)(t + 1) * kstep;
            const char* a2 = last ? nA : cA + (size_t)(t + 2) * kstep; const char* b2 = last ? nB : cB + (size_t)(t + 2) * kstep;
            const char* a3 = a2 + kstep; const char* b3 = b2 + kstep;
            if (last && has_next) S.a_ready(nxt);
            PG8_LDB(B0, 0, 0); PG8_SCHED; PG8_LDA(At, 0, 0); PG8_STAGE(PG8_SA(1, 1), a1 + hstep, voffA);
            PG8_WAIT_L(8); PG8_BAR; PG8_WAIT_L(0); PG8_MMA(0, 0, At, B0); PG8_BAR; PG8_SCHED;
            PG8_LDB(B1, 0, 1); PG8_STAGE(PG8_SB(0, 0), b2, voffB);
            PG8_BAR; PG8_WAIT_L(0); PG8_MMA(0, 1, At, B1); PG8_BAR;
            PG8_LDA(At, 0, 1); PG8_STAGE(PG8_SA(0, 0), a2, voffA);
            PG8_BAR; PG8_WAIT_L(0); PG8_MMA(1, 0, At, B0); PG8_BAR; PG8_SCHED;
            PG8_STAGE(PG8_SB(0, 1), b2 + hstep, voffB);
            PG8_WAIT_V(6); PG8_BAR; PG8_MMA(1, 1, At, B1); PG8_BAR;
            PG8_LDB(B0, 1, 0); PG8_SCHED; PG8_LDA(At, 1, 0); PG8_STAGE(PG8_SA(0, 1), a2 + hstep, voffA);
            PG8_WAIT_L(8); PG8_BAR; PG8_WAIT_L(0); PG8_MMA(0, 0, At, B0); PG8_BAR; PG8_SCHED;
            PG8_LDB(B1, 1, 1); PG8_STAGE(PG8_SB(1, 0), b3, voffB);
            PG8_BAR; PG8_WAIT_L(0); PG8_MMA(0, 1, At, B1); PG8_BAR;
            PG8_LDA(At, 1, 1); PG8_STAGE(PG8_SA(1, 0), a3, voffA);
            PG8_BAR; PG8_WAIT_L(0); PG8_MMA(1, 0, At, B0); PG8_BAR; PG8_SCHED;
            PG8_STAGE(PG8_SB(1, 1), b3 + hstep, voffB);
            PG8_WAIT_V(6); PG8_BAR; PG8_MMA(1, 1, At, B1); PG8_BAR;
        }
        E(acc, cur, wr, wc, fr, fq); S.done(cur);
        if (!has_next) break;
#pragma unroll
        for (int a = 0; a < 2; ++a)
#pragma unroll
            for (int b = 0; b < 2; ++b)
#pragma unroll
                for (int m = 0; m < 4; ++m)
#pragma unroll
                    for (int n = 0; n < 2; ++n) acc[a][b][m][n] = (f32x4){0.f, 0.f, 0.f, 0.f};
        cur = nxt; cA = nA; cB = nB; nt = cur.nt; ++ui;
    }
    PG8_WAIT_V(0);
    if (wr == 0) PG8_BAR;
    PG8_BAR;
#undef PG8_SA
#undef PG8_SB
#undef PG8_STAGE
#undef PG8_LDA
#undef PG8_LDB
#undef PG8_MMA
#undef PG8_WAIT_V
#undef PG8_WAIT_L
#undef PG8_BAR
#undef PG8_SCHED
}

struct EpiPoolIn {
    static constexpr bool PERM = true;
    bf16_t* U; bf16_t* Z; const u64* ss;
    __device__ __forceinline__ void operator()(const f32x4 (&acc)[2][2][4][2], const Unit& u, int wr, int wc, int fr, int fq) const {
        const int row0 = u.pm * BM + wr * 64 + fr; const bool isz = u.pn >= 8; bf16_t* base = isz ? Z : U;
        const int col0 = (u.pn & 7) * BM + wc * 32 + 8 * fq;
        float rs[2][4];
#pragma unroll
        for (int ai = 0; ai < 2; ++ai)
#pragma unroll
            for (int m = 0; m < 4; ++m) rs[ai][m] = ssf(ss + row0 + ai * HALF + m * 16);
#pragma unroll
        for (int ai = 0; ai < 2; ++ai)
#pragma unroll
            for (int m = 0; m < 4; ++m) { const int row = row0 + ai * HALF + m * 16; const float rstd = rsqrtf(rs[ai][m] * (1.f / D_MODEL) + EPS);
                bf16_t* rowp = base + (size_t)row * D_INNER + col0;
#pragma unroll
                for (int bj = 0; bj < 2; ++bj) { f32x4 v0 = acc[ai][bj][m][0] * rstd, v1 = acc[ai][bj][m][1] * rstd;
                    if (isz) { v0[0] = silu_f(v0[0]); v0[1] = silu_f(v0[1]); v0[2] = silu_f(v0[2]); v0[3] = silu_f(v0[3]); v1[0] = silu_f(v1[0]); v1[1] = silu_f(v1[1]); v1[2] = silu_f(v1[2]); v1[3] = silu_f(v1[3]); }
                    u32x4 o; o[0] = cvt_pk_bf16(v0[0], v0[1]); o[1] = cvt_pk_bf16(v0[2], v0[3]); o[2] = cvt_pk_bf16(v1[0], v1[1]); o[3] = cvt_pk_bf16(v1[2], v1[3]);
                    *(u32x4*)(rowp + bj * HALF) = o; } }
    }
};
struct EpiPoolMix {
    static constexpr bool PERM = true;
    bf16_t* Y; const bf16_t* Z; const float* scale;
    __device__ __forceinline__ void operator()(const f32x4 (&acc)[2][2][4][2], const Unit& u, int wr, int wc, int fr, int fq) const {
        const int pm = u.pm - (u.pn >> 1) * NPANEL;
        const int row0 = pm * BM + wr * 64 + fr; const int col0 = u.pn * BM + wc * 32 + 8 * fq;
        f32x4 sc[2][2];
#pragma unroll
        for (int bj = 0; bj < 2; ++bj) { sc[bj][0] = *(const f32x4*)(scale + col0 + bj * HALF); sc[bj][1] = *(const f32x4*)(scale + col0 + bj * HALF + 4); }
#pragma unroll
        for (int ai = 0; ai < 2; ++ai) {
            u32x4 zz[4][2];
#pragma unroll
            for (int m = 0; m < 4; ++m)
#pragma unroll
                for (int bj = 0; bj < 2; ++bj) zz[m][bj] = *(const u32x4*)(Z + (size_t)(row0 + ai * HALF + m * 16) * D_INNER + col0 + bj * HALF);
#pragma unroll
            for (int m = 0; m < 4; ++m) { const size_t ro = (size_t)(row0 + ai * HALF + m * 16) * D_INNER + col0;
#pragma unroll
                for (int bj = 0; bj < 2; ++bj) { const u32x4 z4 = zz[m][bj];
                    f32x4 v0 = acc[ai][bj][m][0] * sc[bj][0], v1 = acc[ai][bj][m][1] * sc[bj][1];
                    v0[0] *= bf_lo(z4[0]); v0[1] *= bf_hi(z4[0]); v0[2] *= bf_lo(z4[1]); v0[3] *= bf_hi(z4[1]);
                    v1[0] *= bf_lo(z4[2]); v1[1] *= bf_hi(z4[2]); v1[2] *= bf_lo(z4[3]); v1[3] *= bf_hi(z4[3]);
                    u32x4 o; o[0] = cvt_pk_bf16(v0[0], v0[1]); o[1] = cvt_pk_bf16(v0[2], v0[3]); o[2] = cvt_pk_bf16(v1[0], v1[1]); o[3] = cvt_pk_bf16(v1[2], v1[3]);
                    *(u32x4*)(Y + ro + bj * HALF) = o; } } }
    }
};
struct EpiOut {
    static constexpr bool PERM = false;
    const float* xin_p; const float* xin_s;
    float* X; bf16_t* XB; u64* ssn; const u64* ss2; int dry; float* PART;
    __device__ __forceinline__ void operator()(const f32x4 (&acc)[2][2][4][2], const Unit& u, int wr, int wc, int fr, int fq) const {
        const int row0 = u.pm * BM + wr * 64 + fr, col0 = u.pn * BM + wc * 32 + 4 * fq;
        if (u.pm >= 64) {
            float* dst = PART + (size_t)(u.kofs / (u.nt * BK * 2)) * TS * D_MODEL;
            float r2[2][4];
#pragma unroll
            for (int ai = 0; ai < 2; ++ai)
#pragma unroll
                for (int m = 0; m < 4; ++m) r2[ai][m] = ss2 ? ssf(ss2 + row0 + ai * HALF + m * 16) : 0.f;
#pragma unroll
            for (int ai = 0; ai < 2; ++ai)
#pragma unroll
                for (int m = 0; m < 4; ++m) { const int row = row0 + ai * HALF + m * 16; const float rr = ss2 ? rsqrtf(r2[ai][m] * (1.f / D_INNER) + EPS) : 1.f;
#pragma unroll
                    for (int bj = 0; bj < 2; ++bj)
#pragma unroll
                        for (int n = 0; n < 2; ++n) *(f32x4*)(dst + (size_t)(row - TP) * D_MODEL + col0 + bj * HALF + n * 16) = acc[ai][bj][m][n] * rr; }
            return;
        }
#pragma unroll
        for (int ai = 0; ai < 2; ++ai)
#pragma unroll
            for (int mp = 0; mp < 2; ++mp) {
                f32x4 xv[2][2][2]; float r2[2];
#pragma unroll
                for (int mm = 0; mm < 2; ++mm) { const int row = row0 + ai * HALF + (2 * mp + mm) * 16;
                    const float* xo = (row < TP ? xin_p + (size_t)row * D_MODEL : xin_s + (size_t)(row - TP) * D_MODEL) + col0;
                    r2[mm] = ss2 ? ssf(ss2 + row) : 0.f;
#pragma unroll
                    for (int bj = 0; bj < 2; ++bj)
#pragma unroll
                        for (int n = 0; n < 2; ++n) xv[mm][bj][n] = *(const f32x4*)(xo + bj * HALF + n * 16); }
#pragma unroll
                for (int mm = 0; mm < 2; ++mm) { const int m = 2 * mp + mm, row = row0 + ai * HALF + m * 16;
                    const float rr = ss2 ? rsqrtf(r2[mm] * (1.f / D_INNER) + EPS) : 1.f;
                    float s = 0.f;
#pragma unroll
                    for (int bj = 0; bj < 2; ++bj)
#pragma unroll
                        for (int n = 0; n < 2; ++n) { const int co = bj * HALF + n * 16;
                            const f32x4 v = xv[mm][bj][n] + acc[ai][bj][m][n] * rr;
                            if (!dry) { *(f32x4*)(X + (size_t)row * D_MODEL + col0 + co) = v;
                                u32x2 o; o[0] = cvt_pk_bf16(v[0], v[1]); o[1] = cvt_pk_bf16(v[2], v[3]);
                                *(u32x2*)(XB + (size_t)row * D_MODEL + col0 + co) = o; }
                            s += v[0] * v[0] + v[1] * v[1] + v[2] * v[2] + v[3] * v[3]; }
                    { const int ln = fq * 16 + fr; s += shx(s, ln, 16); s += shx(s, ln, 32); }
                    if (fq == 0 && !dry) atomicAdd(ssn + row, fx(s)); } }
    }
};
struct EpiSsdIn {
    static constexpr bool PERM = true;
    bf16_t* Z; bf16_t* XBC; float* DT; const u64* ss; const float* dt_bias;
    __device__ __forceinline__ void operator()(const f32x4 (&acc)[2][2][4][2], const Unit& u, int wr, int wc, int fr, int fq) const {
        const int row0 = u.pm * BM + wr * 64 + fr;
        const int kind = u.pn < 8 ? 0 : (u.pn < 20 ? 1 : 2);
        const int colt = kind == 0 ? u.pn * BM : (u.pn - 8) * BM;
        const int col0 = colt + wc * 32 + 8 * fq;
        float rs[2][4];
#pragma unroll
        for (int ai = 0; ai < 2; ++ai)
#pragma unroll
            for (int m = 0; m < 4; ++m) rs[ai][m] = ssf(ss + row0 + ai * HALF + m * 16);
#pragma unroll
        for (int ai = 0; ai < 2; ++ai)
#pragma unroll
            for (int m = 0; m < 4; ++m) { const int row = row0 + ai * HALF + m * 16; const float rstd = rsqrtf(rs[ai][m] * (1.f / D_MODEL) + EPS);
#pragma unroll
                for (int bj = 0; bj < 2; ++bj) { f32x4 v0 = acc[ai][bj][m][0] * rstd, v1 = acc[ai][bj][m][1] * rstd;
                    if (kind == 2) {
                        if (bj == 0 && wc == 0) { const int c = 8 * fq;
                            f32x4 b0 = *(const f32x4*)(dt_bias + c), b1 = *(const f32x4*)(dt_bias + c + 4);
                            f32x4 o0, o1; o0[0] = softplus_f(v0[0] + b0[0]); o0[1] = softplus_f(v0[1] + b0[1]); o0[2] = softplus_f(v0[2] + b0[2]); o0[3] = softplus_f(v0[3] + b0[3]);
                            o1[0] = softplus_f(v1[0] + b1[0]); o1[1] = softplus_f(v1[1] + b1[1]); o1[2] = softplus_f(v1[2] + b1[2]); o1[3] = softplus_f(v1[3] + b1[3]);
                            *(f32x4*)(DT + (size_t)row * 32 + c) = o0; *(f32x4*)(DT + (size_t)row * 32 + c + 4) = o1; }
                    } else {
                        if (kind == 0) { v0[0] = silu_f(v0[0]); v0[1] = silu_f(v0[1]); v0[2] = silu_f(v0[2]); v0[3] = silu_f(v0[3]); v1[0] = silu_f(v1[0]); v1[1] = silu_f(v1[1]); v1[2] = silu_f(v1[2]); v1[3] = silu_f(v1[3]); }
                        u32x4 o; o[0] = cvt_pk_bf16(v0[0], v0[1]); o[1] = cvt_pk_bf16(v0[2], v0[3]); o[2] = cvt_pk_bf16(v1[0], v1[1]); o[3] = cvt_pk_bf16(v1[2], v1[3]);
                        bf16_t* dst = kind == 0 ? Z + (size_t)row * D_INNER : XBC + (size_t)row * CONV_DIM;
                        *(u32x4*)(dst + col0 + bj * HALF) = o; } } }
    }
};
}

__device__ __forceinline__ void transpose_item(const float* W, int K, int N, bf16_t* WT, const float* kscale, int k0, int n0, float* scr, int lane) {
    const int kr = lane >> 3, n4 = (lane & 7) * 4;
    f32x4 v[8]; float sc[8];
#pragma unroll
    for (int i = 0; i < 8; ++i) { v[i] = *(const f32x4*)(W + (size_t)(k0 + kr + 8 * i) * N + n0 + n4); sc[i] = kscale ? kscale[k0 + kr + 8 * i] : 1.f; }
#pragma unroll
    for (int i = 0; i < 8; ++i) { float* t = scr + (kr + 8 * i) * 33 + n4; t[0] = v[i][0] * sc[i]; t[1] = v[i][1] * sc[i]; t[2] = v[i][2] * sc[i]; t[3] = v[i][3] * sc[i]; }
    asm volatile("s_waitcnt lgkmcnt(0)" ::: "memory");
    const int c = lane & 7;
#pragma unroll
    for (int jn = 0; jn < 4; ++jn) { const int n = (lane >> 3) + 8 * jn; const float* t = scr + (8 * c) * 33 + n;
        u32x4 o; o[0] = cvt_pk_bf16(t[0], t[33]); o[1] = cvt_pk_bf16(t[2 * 33], t[3 * 33]); o[2] = cvt_pk_bf16(t[4 * 33], t[5 * 33]); o[3] = cvt_pk_bf16(t[6 * 33], t[7 * 33]);
        *(u32x4*)(WT + (size_t)(n0 + n) * K + k0 + 8 * c) = o; }
    asm volatile("s_waitcnt lgkmcnt(0)" ::: "memory");
}

constexpr int W_FIRST = 16 * 128;
__device__ __forceinline__ void prep_weights(const Params& p, unsigned char* lds, int vb, int VG, const int tid, int it_lo, int it_hi) {
    const int lane = tid & 63, wid = tid >> 6;
    float* scr = (float*)lds + wid * (64 * 33);
    constexpr int T_PIN = 16 * 128, T_MIX = 4 * 8 * 16, T_POUT = 32 * 32, T_SIN = 16 * 161, T_SOUT = 32 * 32, T_PER = T_PIN + T_MIX + T_POUT + T_SIN + T_SOUT;
    for (int it = it_lo + vb * 8 + wid; it < (it_hi < 0 ? 2 * T_PER : it_hi); it += VG * 8) {
        const int j = it / T_PER; int r = it % T_PER;
        if (r < T_PIN) { const int kb = r / 128, nb = r % 128;
            transpose_item(p.pool_in_w + (size_t)j * 1024 * 4096, 1024, 4096, (bf16_t*)(p.ws + WS_WPIN) + (size_t)j * 4096 * 1024, p.norm_w + (2 * j) * 1024, kb * 64, nb * 32, scr, lane); continue; }
        r -= T_PIN;
        if (r < T_MIX) { const int g = r / 128, kb = (r % 128) / 16, nb = r % 16;
            transpose_item(p.pool_mix_w + ((size_t)j * 4 + g) * 512 * 512, 512, 512, (bf16_t*)(p.ws + WS_WMIX) + ((size_t)j * 2048 + g * 512) * 512, nullptr, kb * 64, nb * 32, scr, lane); continue; }
        r -= T_MIX;
        if (r < T_POUT) { const int kb = r / 32, nb = r % 32;
            transpose_item(p.pool_out_w + (size_t)j * 2048 * 1024, 2048, 1024, (bf16_t*)(p.ws + WS_WPOUT) + (size_t)j * 1024 * 2048, nullptr, kb * 64, nb * 32, scr, lane); continue; }
        r -= T_POUT;
        if (r < T_SIN) { const int kb = r / 161, nb = r % 161;
            transpose_item(p.ssd_in_w + (size_t)j * 1024 * SSD_IN, 1024, SSD_IN, (bf16_t*)(p.ws + WS_WSIN) + (size_t)j * SSD_IN_PAD * 1024, p.norm_w + (2 * j + 1) * 1024, kb * 64, nb * 32, scr, lane); continue; }
        r -= T_SIN;
        { const int kb = r / 32, nb = r % 32;
            transpose_item(p.ssd_out_w + (size_t)j * 2048 * 1024, 2048, 1024, (bf16_t*)(p.ws + WS_WSOUT) + (size_t)j * 1024 * 2048, p.ssd_norm_w + j * 2048, kb * 64, nb * 32, scr, lane); }
    }
}

__device__ __forceinline__ void phase_prep(const Params& p, unsigned char* lds, int bid, int G, const int tid) {
    const int lane = tid & 63, wid = tid >> 6;
    prep_weights(p, lds, bid, G, tid, 0, G > 64 ? W_FIRST : -1);
    { const size_t gt = (size_t)bid * NTHREADS + tid, gn = (size_t)G * NTHREADS;
        for (int j = 0; j < 2; ++j) { u32x4* z = (u32x4*)((bf16_t*)(p.ws + WS_WSIN) + ((size_t)j * SSD_IN_PAD + SSD_IN) * 1024);
            const size_t n16 = (size_t)(SSD_IN_PAD - SSD_IN) * 1024 * 2 / 16;
            for (size_t i = gt; i < n16; i += gn) z[i] = (u32x4){0u, 0u, 0u, 0u}; }
        u64* ss = (u64*)(p.ws + WS_SS) + T; for (size_t i = gt; i < (size_t)4 * T; i += gn) ss[i] = 0ull;
        u64* ss2 = (u64*)(p.ws + WS_SS2); for (size_t i = gt; i < (size_t)2 * T; i += gn) ss2[i] = 0ull; }
    { u64* ss0 = (u64*)(p.ws + WS_SS); bf16_t* XB = (bf16_t*)(p.ws + WS_XB);
        for (int row = bid * 8 + wid; row < T; row += G * 8) {
            const float* xr = row < TP ? p.x_prompt + (size_t)row * D_MODEL : p.x_sample + (size_t)(row - TP) * D_MODEL;
            float s = 0.f; f32x4 v[4];
#pragma unroll
            for (int i = 0; i < 4; ++i) v[i] = *(const f32x4*)(xr + i * 256 + lane * 4);
#pragma unroll
            for (int i = 0; i < 4; ++i) {
                s += v[i][0] * v[i][0] + v[i][1] * v[i][1] + v[i][2] * v[i][2] + v[i][3] * v[i][3];
                u32x2 o; o[0] = cvt_pk_bf16(v[i][0], v[i][1]); o[1] = cvt_pk_bf16(v[i][2], v[i][3]);
                *(u32x2*)(XB + (size_t)row * D_MODEL + i * 256 + lane * 4) = o; }
#pragma unroll
            for (int o = 1; o < 64; o <<= 1) s += shx(s, lane, o);
            if (lane == 0) ss0[row] = fx(s); } }
}

__device__ __forceinline__ void ld8(const bf16_t* p, float (&v)[8]) { const u32x4 u = *(const u32x4*)p;
    v[0] = bf_lo(u[0]); v[1] = bf_hi(u[0]); v[2] = bf_lo(u[1]); v[3] = bf_hi(u[1]); v[4] = bf_lo(u[2]); v[5] = bf_hi(u[2]); v[6] = bf_lo(u[3]); v[7] = bf_hi(u[3]); }
__device__ __forceinline__ void ld8f(const float* p, float (&v)[8]) { const f32x4 a = *(const f32x4*)p, b = *(const f32x4*)(p + 4);
    v[0] = a[0]; v[1] = a[1]; v[2] = a[2]; v[3] = a[3]; v[4] = b[0]; v[5] = b[1]; v[6] = b[2]; v[7] = b[3]; }
__device__ __forceinline__ void st8(bf16_t* p, const float (&v)[8]) { u32x4 o; o[0] = cvt_pk_bf16(v[0], v[1]); o[1] = cvt_pk_bf16(v[2], v[3]); o[2] = cvt_pk_bf16(v[4], v[5]); o[3] = cvt_pk_bf16(v[6], v[7]); *(u32x4*)p = o; }
__device__ __forceinline__ void st8f(float* p, const float (&v)[8]) { *(f32x4*)p = (f32x4){v[0], v[1], v[2], v[3]}; *(f32x4*)(p + 4) = (f32x4){v[4], v[5], v[6], v[7]}; }

__device__ __forceinline__ void up8(const u32x4 u, float (&v)[8]) { v[0] = bf_lo(u[0]); v[1] = bf_hi(u[0]); v[2] = bf_lo(u[1]); v[3] = bf_hi(u[1]); v[4] = bf_lo(u[2]); v[5] = bf_hi(u[2]); v[6] = bf_lo(u[3]); v[7] = bf_hi(u[3]); }
__device__ __forceinline__ u32x4 pk8f(const float* p) { const f32x4 a = *(const f32x4*)p, b = *(const f32x4*)(p + 4); u32x4 o; o[0] = cvt_pk_bf16(a[0], a[1]); o[1] = cvt_pk_bf16(a[2], a[3]); o[2] = cvt_pk_bf16(b[0], b[1]); o[3] = cvt_pk_bf16(b[2], b[3]); return o; }

template <int W, int NR, bool PROMPT>
__device__ __forceinline__ void pool_run(const Params& p, int j, const bf16_t* U, bf16_t* P, int run, int c0, int g) {
    const int cl = c0 - g * 512;
    u32x4 ext[W - 1 + NR];
    int row0, t0 = 0, b = 0, sb = 0;
    if (PROMPT) { row0 = run * NR; t0 = row0 & (SEQ - 1); b = row0 >> 11;
#pragma unroll
        for (int k = 0; k < W - 1; ++k) ext[k] = (t0 - (W - 1 - k) >= 0) ? *(const u32x4*)(U + (size_t)(row0 - (W - 1 - k)) * D_INNER + c0) : (u32x4){0u, 0u, 0u, 0u};
    } else { sb = run; row0 = TP + sb * DEC_SEQ;
        const float* buf = p.state_pool + (((size_t)j * DEC_BATCH + sb) * POOL_BUF) * D_INNER + c0;
#pragma unroll
        for (int k = 0; k < W - 1; ++k) ext[k] = pk8f(buf + (size_t)(POOL_BUF - (W - 1 - k)) * D_INNER); }
#pragma unroll
    for (int t = 0; t < NR; ++t) ext[W - 1 + t] = *(const u32x4*)(U + (size_t)(row0 + t) * D_INNER + c0);
    float sum[8], u[8], o[8];
#pragma unroll
    for (int e = 0; e < 8; ++e) sum[e] = 0.f;
#pragma unroll
    for (int k = 0; k < W - 1; ++k) { up8(ext[k], u);
#pragma unroll
        for (int e = 0; e < 8; ++e) sum[e] += u[e]; }
#pragma unroll
    for (int t = 0; t < NR; ++t) { const int row = row0 + t; up8(ext[W - 1 + t], u);
        const float inv = PROMPT ? 1.f / (float)min(t0 + t + 1, W) : 1.f / (float)W;
#pragma unroll
        for (int e = 0; e < 8; ++e) { sum[e] += u[e]; o[e] = sum[e] * inv - u[e]; }
        st8(P + ((size_t)g * T + row) * 512 + cl, o);
        if (PROMPT) { if (t0 + t >= SEQ - POOL_BUF) st8f(p.out + O_POOLP + (((size_t)j * BATCH + b) * POOL_BUF + (t0 + t - (SEQ - POOL_BUF))) * D_INNER + c0, u); }
        else st8f(p.out + O_POOLS + (((size_t)j * DEC_BATCH + sb) * POOL_BUF + (POOL_BUF - DEC_SEQ + t)) * D_INNER + c0, u);
        up8(ext[t], u);
#pragma unroll
        for (int e = 0; e < 8; ++e) sum[e] -= u[e]; }
}

__device__ __forceinline__ void phase_pool(const Params& p, int j, int bid, int G, const int tid) {
    const bf16_t* U = (const bf16_t*)(p.ws + WS_U); bf16_t* P = (bf16_t*)(p.ws + WS_P);
    const int NPR = (TP / 8) * 256, NSA = DEC_BATCH * 256;
    for (int it = bid * NTHREADS + tid; it < NPR + NSA; it += G * NTHREADS) {
        const int chunk = it & 255, run = it >> 8, c0 = chunk * 8, g = __builtin_amdgcn_readfirstlane(chunk >> 6);
        if (run < TP / 8) {
            if (g == 0) pool_run<2, 8, true>(p, j, U, P, run, c0, 0); else if (g == 1) pool_run<4, 8, true>(p, j, U, P, run, c0, 1);
            else if (g == 2) pool_run<8, 8, true>(p, j, U, P, run, c0, 2); else pool_run<16, 8, true>(p, j, U, P, run, c0, 3);
        } else { const int sb = run - TP / 8;
            if (g == 0) pool_run<2, 8, false>(p, j, U, P, sb, c0, 0); else if (g == 1) pool_run<4, 8, false>(p, j, U, P, sb, c0, 1);
            else if (g == 2) pool_run<8, 8, false>(p, j, U, P, sb, c0, 2); else pool_run<16, 8, false>(p, j, U, P, sb, c0, 3);
            const float* buf = p.state_pool + (((size_t)j * DEC_BATCH + sb) * POOL_BUF) * D_INNER + c0;
            float* po = p.out + O_POOLS + (((size_t)j * DEC_BATCH + sb) * POOL_BUF) * D_INNER + c0;
            f32x4 cp[POOL_BUF - DEC_SEQ][2];
#pragma unroll
            for (int i = 0; i < POOL_BUF - DEC_SEQ; ++i) { cp[i][0] = *(const f32x4*)(buf + (size_t)(DEC_SEQ + i) * D_INNER); cp[i][1] = *(const f32x4*)(buf + (size_t)(DEC_SEQ + i) * D_INNER + 4); }
#pragma unroll
            for (int i = 0; i < POOL_BUF - DEC_SEQ; ++i) { *(f32x4*)(po + (size_t)i * D_INNER) = cp[i][0]; *(f32x4*)(po + (size_t)i * D_INNER + 4) = cp[i][1]; }
        }
    }
}

__device__ __forceinline__ void phase_conv(const Params& p, int j, int bid, int G, const int tid) {
    const bf16_t* R = (const bf16_t*)(p.ws + WS_XBC); bf16_t* O = (bf16_t*)(p.ws + WS_XBCC);
    const int NIT = (T / 8) * 384;
    for (int it = bid * NTHREADS + tid; it < NIT; it += G * NTHREADS) {
        const int chunk = it % 384, run = it / 384, c0 = chunk * 8, row0 = run * 8;
        float w0[8], w1[8], w2[8], w3[8], bs[8], h1[8], h2[8], h3[8], cur[8], o[8];
        const bool prompt = row0 < TP; const int t0 = prompt ? (row0 & (SEQ - 1)) : 0;
        u32x4 rr[8];
#pragma unroll
        for (int t = 0; t < 8; ++t) rr[t] = *(const u32x4*)(R + (size_t)(row0 + t) * CONV_DIM + c0);
        if (prompt) {
            if (t0 > 0) { ld8(R + (size_t)(row0 - 3) * CONV_DIM + c0, h3); ld8(R + (size_t)(row0 - 2) * CONV_DIM + c0, h2); ld8(R + (size_t)(row0 - 1) * CONV_DIM + c0, h1); }
            else {
#pragma unroll
                for (int e = 0; e < 8; ++e) { h1[e] = 0.f; h2[e] = 0.f; h3[e] = 0.f; } }
        } else { const int sb = (row0 - TP) >> 3; const float* sc = p.state_conv + (((size_t)j * DEC_BATCH + sb) * 3) * CONV_DIM + c0;
            ld8f(sc, h3); ld8f(sc + CONV_DIM, h2); ld8f(sc + 2 * CONV_DIM, h1); }
        const float* cw = p.ssd_conv_w + (size_t)j * 4 * CONV_DIM + c0;
        ld8f(cw, w0); ld8f(cw + CONV_DIM, w1); ld8f(cw + 2 * CONV_DIM, w2); ld8f(cw + 3 * CONV_DIM, w3); ld8f(p.ssd_conv_b + (size_t)j * CONV_DIM + c0, bs);
#pragma unroll
        for (int t = 0; t < 8; ++t) { const int row = row0 + t;
            up8(rr[t], cur);
#pragma unroll
            for (int e = 0; e < 8; ++e) { const float v = w0[e] * h3[e] + w1[e] * h2[e] + w2[e] * h1[e] + w3[e] * cur[e] + bs[e]; o[e] = silu_f(v); h3[e] = h2[e]; h2[e] = h1[e]; h1[e] = cur[e]; }
            st8(O + (size_t)row * CONV_DIM + c0, o);
            if (prompt) { const int tt = t0 + t; if (tt >= SEQ - 3) st8f(p.out + O_CONVP + (((size_t)j * BATCH + (row0 >> 11)) * 3 + (tt - (SEQ - 3))) * CONV_DIM + c0, cur); }
            else if (t >= DEC_SEQ - 3) st8f(p.out + O_CONVS + (((size_t)j * DEC_BATCH + ((row0 - TP) >> 3)) * 3 + (t - (DEC_SEQ - 3))) * CONV_DIM + c0, cur);
        }
    }
}

#define LAS __attribute__((address_space(3)))
constexpr int RS = 272;
constexpr int L_CS = 0, L_BS = 128 * RS, L_XT = 2 * 128 * RS, L_XW = L_XT + 64 * RS, L_HS = L_XW + 64 * RS  , L_DT = L_HS + 2 * 64 * RS, L_AC = L_DT + 512,
              L_STK = L_AC + 512  , L_SYS = L_STK + 8 * 320 * 2  , L_SDT = L_SYS + 8 * 64 * 4  , L_END = L_SDT + 64;
static_assert(L_END <= LDS_STAGE, "scan LDS");
typedef const LAS bf16x8* lfrag_t;
#define LFRAG(ptr, off) (*(lfrag_t)((ptr) + (off)))

__device__ __forceinline__ void scan_unit(const Params& p, int j, LAS unsigned char* L, int unit, const int tid, const int dry) {
    const int lane = tid & 63, w = __builtin_amdgcn_readfirstlane(tid >> 6), fr = lane & 15, fq = lane >> 4;
    const int b = unit >> 5, h = unit & 31, g = h >> 3;
    const bf16_t* XC = (const bf16_t*)(p.ws + WS_XBCC); const bf16_t* Z = (const bf16_t*)(p.ws + WS_Z); const float* DT = (const float*)(p.ws + WS_DT);
    bf16_t* YG = (bf16_t*)(p.ws + WS_Y); u64* ss2 = (u64*)(p.ws + WS_SS2) + (size_t)j * T;
    const float A = -__expf(p.ssd_A_log[j * N_HEADS + h]), Dh = p.ssd_D[j * N_HEADS + h];
    LAS unsigned char* const pCf = L + L_CS + (16 * w + fr) * RS + fq * 16;
    LAS unsigned char* const pBf = L + L_BS + fr * RS + fq * 16;
    LAS unsigned char* const pWr = L + L_BS + (16 * w + fr) * RS + fq * 8;
    LAS unsigned char* const pWf = L + L_BS + (16 * w + fr) * RS + fq * 16;
    LAS unsigned char* const pXf = L + L_XT + fr * RS + fq * 16;
    LAS unsigned char* const pBg = L + L_BS + (fq * 8) * RS + (16 * w + fr) * 2;
    LAS unsigned char* const pSt = L + L_CS + (tid >> 4) * RS + (tid & 15) * 16;
    LAS unsigned char* const pSx = L + L_XT + ((tid >> 7) * 8) * RS + (tid & 127) * 2;
    LAS unsigned char* const pXe = L + L_XT + (fq * 4) * RS + (16 * w + fr) * 2;
    LAS unsigned char* const pDq = L + L_DT + fq * 16;
    LAS unsigned char* const pDj = L + L_DT + (tid & 127) * 4;
    LAS unsigned char* const pDi = L + L_AC + (16 * w + fr) * 4;
    LAS unsigned char* const pHw = L + L_HS + fr * RS + (16 * w + fq * 4) * 2;
    f32x4 hacc[4];
#pragma unroll
    for (int i = 0; i < 4; ++i) hacc[i] = (f32x4){0.f, 0.f, 0.f, 0.f};
    for (int i = tid; i < 64 * RS / 16; i += NTHREADS) *(LAS u32x4*)(L + L_HS + i * 16) = (u32x4){0u, 0u, 0u, 0u};
    u32x4 creg[4], breg[4], xreg[2]; float d0 = 0.f, d1 = 0.f;
    const unsigned voffT = (unsigned)((tid >> 4) * CONV_DIM + (tid & 15) * 8) * 2u, voffX = (unsigned)((tid & 127) * CONV_DIM + (tid >> 7) * 8) * 2u;
#define SCAN_PREFETCH(c_) do { const int r0_ = b * SEQ + (c_) * 128; \
        const char* bB_ = (const char*)(XC + (size_t)r0_ * CONV_DIM + D_INNER + g * 128); const char* bX_ = (const char*)(XC + (size_t)r0_ * CONV_DIM + h * 64); \
        _Pragma("unroll") for (int i = 0; i < 4; ++i) { \
            breg[i] = *(const u32x4*)(bB_ + (size_t)i * (32 * CONV_DIM * 2) + voffT); creg[i] = *(const u32x4*)(bB_ + (size_t)i * (32 * CONV_DIM * 2) + 1024 + voffT); } \
        _Pragma("unroll") for (int i = 0; i < 2; ++i) xreg[i] = *(const u32x4*)(bX_ + i * 64 + voffX); \
        if (w == 0) { d0 = DT[(size_t)(r0_ + 2 * lane) * 32 + h]; d1 = DT[(size_t)(r0_ + 2 * lane + 1) * 32 + h]; } } while (0)
    SCAN_PREFETCH(0);
#pragma unroll 1
    for (int c = 0; c < SEQ / 128; ++c) {
        const int r0 = b * SEQ + c * 128;
        const int hb = (c & 1) * (64 * RS), hn = ((c & 1) ^ 1) * (64 * RS);
        if (w == 0) { const float a0 = d0 * A, a1 = d1 * A; float v = a0 + a1;
#pragma unroll
            for (int o = 1; o < 64; o <<= 1) { const float t = shup(v, lane, o); if (lane >= o) v += t; }
            *(LAS f32x2*)(L + L_DT + lane * 8) = (f32x2){d0, d1}; *(LAS f32x2*)(L + L_AC + lane * 8) = (f32x2){v - a1, v}; }
        __syncthreads();
        const float aend = *(const LAS float*)(L + L_AC + 127 * 4);
#pragma unroll
        for (int i = 0; i < 4; ++i) { *(LAS u32x4*)(pSt + 128 * RS + i * 32 * RS) = breg[i]; *(LAS u32x4*)(pSt + i * 32 * RS) = creg[i]; }
        { const float wj = __expf(aend - *(const LAS float*)(pDj + 512)) * *(const LAS float*)pDj;
#pragma unroll
            for (int i = 0; i < 2; ++i)
#pragma unroll
                for (int e2 = 0; e2 < 4; ++e2) { const unsigned u = xreg[i][e2]; const float x0 = bf_lo(u), x1 = bf_hi(u);
                    const int ro = (i * 32 + e2 * 2) * RS;
                    *(LAS bf16_t*)(pSx + ro) = (bf16_t)(u & 0xffffu); *(LAS bf16_t*)(pSx + ro + RS) = (bf16_t)(u >> 16);
                    const unsigned s = cvt_pk_bf16(x0 * wj, x1 * wj);
                    *(LAS bf16_t*)(pSx + 64 * RS + ro) = (bf16_t)(s & 0xffffu); *(LAS bf16_t*)(pSx + 64 * RS + ro + RS) = (bf16_t)(s >> 16); } }
        const int irow = r0 + 16 * w + fr;
        u32x2 zreg[4];
#pragma unroll
        for (int pt = 0; pt < 4; ++pt) zreg[pt] = *(const u32x2*)(Z + (size_t)irow * D_INNER + h * 64 + pt * 16 + fq * 4);
        __syncthreads();
        u32x2 wpk[8]; float ea;
        {
            bf16x8 cf[4];
#pragma unroll
            for (int ks = 0; ks < 4; ++ks) cf[ks] = LFRAG(pCf, ks * 64);
            const int i = 16 * w + fr; const float aci = *(const LAS float*)pDi; ea = __expf(aci);
#pragma unroll
            for (int j2 = 0; j2 < 4; ++j2) {
                wpk[2 * j2] = (u32x2){0u, 0u}; wpk[2 * j2 + 1] = (u32x2){0u, 0u};
                if (2 * j2 <= w) {
                    f32x4 g0 = (f32x4){0.f, 0.f, 0.f, 0.f}, g1 = (f32x4){0.f, 0.f, 0.f, 0.f};
#pragma unroll
                    for (int ks = 0; ks < 4; ++ks) { g0 = __builtin_amdgcn_mfma_f32_16x16x32_bf16(LFRAG(pBf, (2 * j2) * 16 * RS + ks * 64), cf[ks], g0, 0, 0, 0);
                        g1 = __builtin_amdgcn_mfma_f32_16x16x32_bf16(LFRAG(pBf, (2 * j2 + 1) * 16 * RS + ks * 64), cf[ks], g1, 0, 0, 0); }
#pragma unroll
                    for (int hh = 0; hh < 2; ++hh) { const int jt = 2 * j2 + hh, j0 = jt * 16 + fq * 4; const f32x4 gg = hh ? g1 : g0;
                        const f32x4 dtj = *(const LAS f32x4*)(pDq + jt * 64), acj = *(const LAS f32x4*)(pDq + 512 + jt * 64);
                        float v[4];
#pragma unroll
                        for (int r = 0; r < 4; ++r) v[r] = (j0 + r <= i) ? gg[r] * __expf(aci - acj[r]) * dtj[r] : 0.f;
                        wpk[jt][0] = cvt_pk_bf16(v[0], v[1]); wpk[jt][1] = cvt_pk_bf16(v[2], v[3]); }
                }
                __builtin_amdgcn_sched_barrier(0);
            }
        }
        {
            const float dec = __expf(aend);
#pragma unroll
            for (int pt = 0; pt < 4; ++pt) hacc[pt] = hacc[pt] * dec;
#pragma unroll
            for (int ks = 0; ks < 4; ++ks) { bf16x8 bg;
#pragma unroll
                for (int e = 0; e < 8; ++e) bg[e] = *(const LAS short*)(pBg + (ks * 32 + e) * RS);
#pragma unroll
                for (int pt = 0; pt < 4; ++pt) hacc[pt] = __builtin_amdgcn_mfma_f32_16x16x32_bf16(bg, LFRAG(pXf, 64 * RS + pt * 16 * RS + ks * 64), hacc[pt], 0, 0, 0);
                __builtin_amdgcn_sched_barrier(0); }
        }
        __syncthreads();
#pragma unroll
        for (int jt = 0; jt < 8; ++jt) *(LAS u32x2*)(pWr + jt * 32) = wpk[jt];
#pragma unroll
        for (int pt = 0; pt < 4; ++pt) { u32x2 o; o[0] = cvt_pk_bf16(hacc[pt][0], hacc[pt][1]); o[1] = cvt_pk_bf16(hacc[pt][2], hacc[pt][3]);
            *(LAS u32x2*)(pHw + hn + pt * 16 * RS) = o; }
        __syncthreads();
        if (c + 1 < SEQ / 128) SCAN_PREFETCH(c + 1);
        {
            f32x4 yd[4], yoff[4];
#pragma unroll
            for (int pt = 0; pt < 4; ++pt) { yd[pt] = (f32x4){0.f, 0.f, 0.f, 0.f}; yoff[pt] = (f32x4){0.f, 0.f, 0.f, 0.f}; }
            LAS unsigned char* const pHf = pXf + 2 * 64 * RS + hb;
#pragma unroll
            for (int ks = 0; ks < 4; ++ks) { const bf16x8 cfk = LFRAG(pCf, ks * 64);
#pragma unroll
                for (int pt = 0; pt < 4; ++pt) yoff[pt] = __builtin_amdgcn_mfma_f32_16x16x32_bf16(LFRAG(pHf, pt * 16 * RS + ks * 64), cfk, yoff[pt], 0, 0, 0);
                __builtin_amdgcn_sched_barrier(0); }
#pragma unroll
            for (int ks = 0; ks < 4; ++ks) if (2 * ks <= w) { const bf16x8 wf = LFRAG(pWf, ks * 64);
#pragma unroll
                for (int pt = 0; pt < 4; ++pt) yd[pt] = __builtin_amdgcn_mfma_f32_16x16x32_bf16(LFRAG(pXf, pt * 16 * RS + ks * 64), wf, yd[pt], 0, 0, 0);
                __builtin_amdgcn_sched_barrier(0); }
            float s = 0.f;
#pragma unroll
            for (int pt = 0; pt < 4; ++pt) { const int p0 = pt * 16 + fq * 4;
                float y[4];
#pragma unroll
                for (int r = 0; r < 4; ++r) { const float x = bf1(*(const LAS bf16_t*)(pXe + (pt * 16 + r) * RS)); y[r] = yd[pt][r] + ea * yoff[pt][r] + Dh * x; }
                y[0] *= bf_lo(zreg[pt][0]); y[1] *= bf_hi(zreg[pt][0]); y[2] *= bf_lo(zreg[pt][1]); y[3] *= bf_hi(zreg[pt][1]);
                s += y[0] * y[0] + y[1] * y[1] + y[2] * y[2] + y[3] * y[3];
                u32x2 o; o[0] = cvt_pk_bf16(y[0], y[1]); o[1] = cvt_pk_bf16(y[2], y[3]);
                *(u32x2*)(YG + (size_t)irow * D_INNER + h * 64 + p0) = o; }
            s += shx(s, lane, 16); s += shx(s, lane, 32);
            if (fq == 0 && !dry) atomicAdd(ss2 + irow, fx(s));
        }
    }
#undef SCAN_PREFETCH
    float* so = p.out + O_SSMP + (((size_t)j * BATCH + b) * N_HEADS + h) * 64 * D_STATE;
#pragma unroll
    for (int pt = 0; pt < 4; ++pt) *(f32x4*)(so + (size_t)(pt * 16 + fr) * D_STATE + 16 * w + fq * 4) = hacc[pt];
    __syncthreads();
}

__device__ __forceinline__ void phase_scan(const Params& p, int j, unsigned char* lds, int bid, int G, const int tid, const int dry) {
    for (int u = bid; u < BATCH * N_HEADS; u += G) scan_unit(p, j, (LAS unsigned char*)lds, u, tid, dry);
}

constexpr int D_TOK = 0  , D_YS = 8 * 320 * 4  , D_SDT = D_YS + 8 * 64 * 4  ;
__device__ __forceinline__ void decode_units(const Params& p, int j, LAS unsigned char* L, int bid, int G, const int tid, const int dry) {
    const int lane = tid & 63, w = __builtin_amdgcn_readfirstlane(tid >> 6), pp = tid >> 3, n0 = (tid & 7) * 16;
    const bf16_t* R = (const bf16_t*)(p.ws + WS_XBC); const bf16_t* Z = (const bf16_t*)(p.ws + WS_Z); const float* DT = (const float*)(p.ws + WS_DT);
    bf16_t* YG = (bf16_t*)(p.ws + WS_Y); u64* ss2 = (u64*)(p.ws + WS_SS2) + (size_t)j * T;
    const int NU = DEC_BATCH * N_HEADS;
    f32x4 hv[4], hvn[4]; float raw[8], rawn[8], hist[3], histn[3], cw[5], cwn[5]; float sd = 0.f, sdn = 0.f, zs = 0.f, zsn = 0.f;
#pragma unroll
    for (int i = 0; i < 8; ++i) { raw[i] = 0.f; rawn[i] = 0.f; }
#pragma unroll
    for (int i = 0; i < 3; ++i) { hist[i] = 0.f; histn[i] = 0.f; }
#pragma unroll
    for (int i = 0; i < 5; ++i) { cw[i] = 0.f; cwn[i] = 0.f; }
#define DEC_LOAD(u_, HV, RAW, HIST, CW, SD, ZS) do { const int sb_ = (u_) >> 5, h_ = (u_) & 31, g_ = h_ >> 3, row0_ = TP + sb_ * DEC_SEQ; \
        const float* sp_ = p.state_ssm + ((((size_t)j * DEC_BATCH + sb_) * N_HEADS + h_) * 64 + pp) * D_STATE + n0; \
        _Pragma("unroll") for (int i = 0; i < 4; ++i) HV[i] = *(const f32x4*)(sp_ + 4 * i); \
        if (tid < 320) { const int col_ = tid < 64 ? h_ * 64 + tid : (tid < 192 ? D_INNER + g_ * 128 + (tid - 64) : D_INNER + 512 + g_ * 128 + (tid - 192)); \
            _Pragma("unroll") for (int t = 0; t < 8; ++t) RAW[t] = bf1(R[(size_t)(row0_ + t) * CONV_DIM + col_]); \
            const float* sc_ = p.state_conv + (((size_t)j * DEC_BATCH + sb_) * 3) * CONV_DIM + col_; \
            HIST[0] = sc_[0]; HIST[1] = sc_[CONV_DIM]; HIST[2] = sc_[2 * CONV_DIM]; \
            const float* cw_ = p.ssd_conv_w + (size_t)j * 4 * CONV_DIM + col_; \
            CW[0] = cw_[0]; CW[1] = cw_[CONV_DIM]; CW[2] = cw_[2 * CONV_DIM]; CW[3] = cw_[3 * CONV_DIM]; CW[4] = p.ssd_conv_b[(size_t)j * CONV_DIM + col_]; } \
        if (tid >= 504) SD = DT[(size_t)(row0_ + tid - 504) * 32 + h_]; \
        ZS = bf1(Z[(size_t)(row0_ + w) * D_INNER + h_ * 64 + lane]); } while (0)
    int u = bid;
    if (u < NU) DEC_LOAD(u, hv, raw, hist, cw, sd, zs);
    for (; u < NU; u += G) {
        const int sb = u >> 5, h = u & 31, row0 = TP + sb * DEC_SEQ;
        const float A = -__expf(p.ssd_A_log[j * N_HEADS + h]), Dh = p.ssd_D[j * N_HEADS + h];
        if (tid < 320) { float h3 = hist[0], h2 = hist[1], h1 = hist[2];
#pragma unroll
            for (int t = 0; t < 8; ++t) { const float v = cw[0] * h3 + cw[1] * h2 + cw[2] * h1 + cw[3] * raw[t] + cw[4];
                *(LAS float*)(L + D_TOK + (t * 320 + tid) * 4) = silu_f(v); h3 = h2; h2 = h1; h1 = raw[t]; } }
        if (tid >= 504) { *(LAS float*)(L + D_SDT + (tid - 504) * 4) = sd; *(LAS float*)(L + D_SDT + 32 + (tid - 504) * 4) = __expf(sd * A); }
        __syncthreads();
        if (u + G < NU) DEC_LOAD(u + G, hvn, rawn, histn, cwn, sdn, zsn);
        float part[DEC_SEQ];
#pragma unroll
        for (int t = 0; t < DEC_SEQ; ++t) { LAS unsigned char* const tk = L + D_TOK + t * 1280;
            const float dec = *(const LAS float*)(L + D_SDT + 32 + t * 4), xdt = *(const LAS float*)(tk + pp * 4) * *(const LAS float*)(L + D_SDT + t * 4); float pt = 0.f;
#pragma unroll
            for (int i = 0; i < 4; ++i) { const f32x4 bv = *(const LAS f32x4*)(tk + 256 + (n0 + 4 * i) * 4), cv = *(const LAS f32x4*)(tk + 768 + (n0 + 4 * i) * 4);
                hv[i] = hv[i] * dec + bv * xdt;
                pt += hv[i][0] * cv[0] + hv[i][1] * cv[1] + hv[i][2] * cv[2] + hv[i][3] * cv[3]; }
            part[t] = pt; }
#pragma unroll
        for (int m = 1; m < 8; m <<= 1) {
#pragma unroll
            for (int t = 0; t < DEC_SEQ; ++t) part[t] += shx(part[t], lane, m); }
        if ((tid & 7) == 0) {
#pragma unroll
            for (int t = 0; t < DEC_SEQ; ++t) *(LAS float*)(L + D_YS + (t * 64 + pp) * 4) = part[t]; }
        { float* so = p.out + O_SSMS + ((((size_t)j * DEC_BATCH + sb) * N_HEADS + h) * 64 + pp) * D_STATE + n0;
#pragma unroll
            for (int i = 0; i < 4; ++i) *(f32x4*)(so + 4 * i) = hv[i]; }
        __syncthreads();
        { const int t = w, row = row0 + t; const float y = *(const LAS float*)(L + D_YS + (t * 64 + lane) * 4) + Dh * *(const LAS float*)(L + D_TOK + (t * 320 + lane) * 4);
            const float yg = y * zs;
            YG[(size_t)row * D_INNER + h * 64 + lane] = (bf16_t)(cvt_pk_bf16(yg, 0.f) & 0xffffu);
            float s = yg * yg;
#pragma unroll
            for (int o = 1; o < 64; o <<= 1) s += shx(s, lane, o);
            if (lane == 0 && !dry) atomicAdd(ss2 + row, fx(s)); }
        __syncthreads();
#pragma unroll
        for (int i = 0; i < 4; ++i) hv[i] = hvn[i];
#pragma unroll
        for (int i = 0; i < 8; ++i) raw[i] = rawn[i];
#pragma unroll
        for (int i = 0; i < 3; ++i) hist[i] = histn[i];
#pragma unroll
        for (int i = 0; i < 5; ++i) cw[i] = cwn[i];
        sd = sdn; zs = zsn;
    }
#undef DEC_LOAD
}

__device__ __forceinline__ void sample_fix(const Params& p, int L, int bid, int G, const int tid) {
    const int lane = tid & 63, wid = tid >> 6;
    float* X = (float*)(p.ws + WS_X); bf16_t* XB = (bf16_t*)(p.ws + WS_XB); const float* PART = (const float*)(p.ws + WS_PART);
    u64* ssn = (u64*)(p.ws + WS_SS) + (size_t)(L + 1) * T;
    for (int r = bid * 8 + wid; r < TS; r += G * 8) { const int row = TP + r;
        const float* xo = L == 0 ? p.x_sample + (size_t)r * D_MODEL : X + (size_t)row * D_MODEL;
        f32x4 v[4], ps[4];
#pragma unroll
        for (int i = 0; i < 4; ++i) { v[i] = *(const f32x4*)(xo + i * 256 + lane * 4); ps[i] = (f32x4){0.f, 0.f, 0.f, 0.f}; }
#pragma unroll
        for (int kb = 0; kb < SPLITQ; kb += 4) { f32x4 q[4][4];
#pragma unroll
            for (int i = 0; i < 4; ++i)
#pragma unroll
                for (int k = 0; k < 4; ++k) q[k][i] = *(const f32x4*)(PART + ((size_t)(kb + k) * TS + r) * D_MODEL + i * 256 + lane * 4);
#pragma unroll
            for (int i = 0; i < 4; ++i) ps[i] = (((ps[i] + q[0][i]) + q[1][i]) + q[2][i]) + q[3][i]; }
        float s = 0.f;
#pragma unroll
        for (int i = 0; i < 4; ++i) { const f32x4 x = v[i] + ps[i];
            *(f32x4*)(X + (size_t)row * D_MODEL + i * 256 + lane * 4) = x;
            u32x2 o; o[0] = cvt_pk_bf16(x[0], x[1]); o[1] = cvt_pk_bf16(x[2], x[3]);
            *(u32x2*)(XB + (size_t)row * D_MODEL + i * 256 + lane * 4) = o;
            s += x[0] * x[0] + x[1] * x[1] + x[2] * x[2] + x[3] * x[3]; }
#pragma unroll
        for (int o = 1; o < 64; o <<= 1) s += shx(s, lane, o);
        if (lane == 0) ssn[row] = fx(s); }
}

__device__ __forceinline__ void phase_final(const Params& p, int bid, int G, const int tid) {
    const int lane = tid & 63, wid = tid >> 6;
    const float* X = (const float*)(p.ws + WS_X); const u64* ss = (const u64*)(p.ws + WS_SS) + (size_t)4 * T;
    f32x4 wv[4];
#pragma unroll
    for (int i = 0; i < 4; ++i) wv[i] = *(const f32x4*)(p.final_norm_w + i * 256 + lane * 4);
    const float* PART = (const float*)(p.ws + WS_PART);
    for (int row = bid * 8 + wid; row < T; row += G * 8) { f32x4 v[4];
#pragma unroll
        for (int i = 0; i < 4; ++i) v[i] = *(const f32x4*)(X + (size_t)row * D_MODEL + i * 256 + lane * 4);
        float rstd;
        if (row >= TP) {
            f32x4 ps[4];
#pragma unroll
            for (int i = 0; i < 4; ++i) ps[i] = (f32x4){0.f, 0.f, 0.f, 0.f};
#pragma unroll
            for (int kb = 0; kb < SPLITQ; kb += 4) { f32x4 q[4][4];
#pragma unroll
                for (int i = 0; i < 4; ++i)
#pragma unroll
                    for (int k = 0; k < 4; ++k) q[k][i] = *(const f32x4*)(PART + ((size_t)(kb + k) * TS + (row - TP)) * D_MODEL + i * 256 + lane * 4);
#pragma unroll
                for (int i = 0; i < 4; ++i) ps[i] = (((ps[i] + q[0][i]) + q[1][i]) + q[2][i]) + q[3][i]; }
            float s = 0.f;
#pragma unroll
            for (int i = 0; i < 4; ++i) { v[i] = v[i] + ps[i]; s += v[i][0] * v[i][0] + v[i][1] * v[i][1] + v[i][2] * v[i][2] + v[i][3] * v[i][3]; }
#pragma unroll
            for (int o = 1; o < 64; o <<= 1) s += shx(s, lane, o);
            rstd = rsqrtf(s * (1.f / D_MODEL) + EPS);
        } else rstd = rsqrtf(ssf(ss + row) * (1.f / D_MODEL) + EPS);
#pragma unroll
        for (int i = 0; i < 4; ++i) *(f32x4*)(p.out + (size_t)row * D_MODEL + i * 256 + lane * 4) = v[i] * rstd * wv[i]; }
}

#define XB_TMO      128
#define XB_XCNT(j)  (256  + 64 * (j))
#define XB_XSUB(j)  (1280 + 64 * (j))
#define XB_XGEN(j)  (2304 + 64 * (j))
#define XB_TOP      3328
#define XB_TOPGEN   3392
#define XCD_BAR_WORDS 3456
#define XB_SPIN_CAP (1u << 18)
__device__ __forceinline__ unsigned xb_ld(unsigned* p)              { return __hip_atomic_load(p, __ATOMIC_RELAXED, __HIP_MEMORY_SCOPE_AGENT); }
__device__ __forceinline__ unsigned xb_add(unsigned* p, unsigned v) { return __hip_atomic_fetch_add(p, v, __ATOMIC_RELAXED, __HIP_MEMORY_SCOPE_AGENT); }
__device__ __forceinline__ unsigned xb_xcc_id() { return (unsigned)__builtin_amdgcn_s_getreg((3 << 11) | 20) & 0xFu; }
#define XB_SPIN(cond, bar) do { unsigned _sp = 0; while (cond) { __builtin_amdgcn_s_sleep(1); \
    if ((++_sp & 255u) == 0u) { if (xb_ld(&(bar)[XB_TMO])) break; if (_sp > XB_SPIN_CAP) { atomicAdd(&(bar)[XB_TMO], 1u); break; } } } } while (0)
struct XcdBarrier { unsigned* bar; unsigned x; volatile LAS unsigned* st; };
__device__ __forceinline__ XcdBarrier xcd_barrier_post(unsigned* bar, volatile LAS unsigned* st) {
    XcdBarrier b; b.bar = bar; b.x = xb_xcc_id(); b.st = st;
    if (threadIdx.x == 0) (void)xb_add(&bar[XB_XCNT(b.x)], 1u);
    return b;
}
__device__ __forceinline__ void xcd_barrier_complete(unsigned* bar, unsigned x, unsigned& nloc, unsigned& nx) {
    const unsigned G = gridDim.x * gridDim.y * gridDim.z;
    unsigned sum, cnt, mine, sp = 0u;
    for (;;) {
        sum = 0u; cnt = 0u; mine = 0u;
#pragma unroll
        for (unsigned j = 0; j < 16; ++j) { const unsigned c = xb_ld(&bar[XB_XCNT(j)]); sum += c; cnt += (c > 0u) ? 1u : 0u; }
        if (sum == G) { mine = xb_ld(&bar[XB_XCNT(x)]); break; }
        __builtin_amdgcn_s_sleep(1);
        if ((++sp & 255u) == 0u) { if (xb_ld(&bar[XB_TMO])) break; if (sp > XB_SPIN_CAP) { atomicAdd(&bar[XB_TMO], 1u); break; } }
    }
    nloc = mine > 0u ? mine : 1u; nx = cnt > 0u ? cnt : 1u;
}
__device__ __forceinline__ void xcd_barrier(const XcdBarrier& b, const int tid) {
    asm volatile("s_waitcnt vmcnt(0)" ::: "memory");
    __syncthreads();
    if (tid == 0) {
        unsigned* bar = b.bar;
        __builtin_amdgcn_s_waitcnt(0);
        unsigned nloc = b.st[0], nx = b.st[1];
        if (nloc == 0u) { xcd_barrier_complete(bar, b.x, nloc, nx); b.st[0] = nloc; b.st[1] = nx; }
        const unsigned old = xb_add(&bar[XB_XSUB(b.x)], 1u);
        const unsigned gen = old / nloc;
        if (old + 1u == (gen + 1u) * nloc) {
            __builtin_amdgcn_fence(__ATOMIC_RELEASE, "agent");
            asm volatile("s_waitcnt vmcnt(0)" ::: "memory");
            const unsigned og = xb_add(&bar[XB_TOP], 1u);
            const unsigned tg = og / nx;
            if (og + 1u == (tg + 1u) * nx) xb_add(&bar[XB_TOPGEN], 1u);
            else XB_SPIN(xb_ld(&bar[XB_TOPGEN]) == tg, bar);
            __builtin_amdgcn_fence(__ATOMIC_ACQUIRE, "agent");
            xb_add(&bar[XB_XGEN(b.x)], 1u);
            asm volatile("s_waitcnt vmcnt(0)" ::: "memory");
        } else {
            XB_SPIN(xb_ld(&bar[XB_XGEN(b.x)]) == gen, bar);
            __builtin_amdgcn_fence(__ATOMIC_ACQUIRE, "agent");
            asm volatile("s_waitcnt vmcnt(0)" ::: "memory");
        }
    }
    __syncthreads();
}

constexpr int N_PHASES = 18;
#ifndef PH_MASK
#define PH_MASK 0x1ff
#endif
#define PH_ON(k) ((PH_MASK >> (k)) & 1)
#ifndef REP_MASK
#define REP_MASK 0
#endif
#define NREP(k) (((REP_MASK >> (k)) & 1) ? 2 : 1)
#define FRESH_TID(name) int name##_z = 0; asm volatile("" : "+v"(name##_z)); const int name = wid_s * 64 + (int)__builtin_amdgcn_mbcnt_hi(~0u, __builtin_amdgcn_mbcnt_lo(~0u, (unsigned)name##_z))
__global__ void __launch_bounds__(NTHREADS, 2) fwd_kernel(Params pin) {
    extern __shared__ __attribute__((aligned(16))) unsigned char shm[];
    volatile LAS unsigned* bst = (volatile LAS unsigned*)(LAS unsigned char*)(shm + LDS_STAGE);
    if (threadIdx.x == 0) { bst[0] = 0u; bst[1] = 0u; }
    __syncthreads();
    const XcdBarrier xbar = xcd_barrier_post((unsigned*)(pin.ws + WS_CTL), bst);
    const int wid_s = __builtin_amdgcn_readfirstlane((int)threadIdx.x >> 6);
    if (pin.ph_lo == 0) {
        const int bid = (int)blockIdx.x, G = (int)gridDim.x, tid = (int)threadIdx.x;
        if (PH_ON(0)) for (int rep = 0; rep < NREP(0); ++rep) phase_prep(pin, (unsigned char*)shm, bid, G, tid);
        if (pin.ph_hi > 1000) cg::this_grid().sync();
        else if (pin.ph_hi > 1) xcd_barrier(xbar, tid);
    }
    for (int ph = pin.ph_lo > 1 ? pin.ph_lo : 1; ph < pin.ph_hi; ++ph) {
        int sz = 0; asm volatile("" : "+s"(sz));
        const int bid = (int)blockIdx.x + sz, G = (int)gridDim.x + sz;
        Params p = pin; p.ws = pin.ws + sz; p.out = pin.out + sz;
        unsigned lb = (unsigned)(size_t)(LAS unsigned char*)shm; asm volatile("" : "+s"(lb));
        LAS unsigned char* const lds3 = (LAS unsigned char*)(size_t)lb; unsigned char* const ldsg = (unsigned char*)lds3;
        if (false) {}
        else if (ph == N_PHASES - 1) { if (PH_ON(1)) { FRESH_TID(t1); for (int rep = 0; rep < NREP(1); ++rep) phase_final(p, bid, G, t1); } }
        else {
            const int L = (ph - 1) >> 2, sub = (ph - 1) & 3, j = L >> 1; const bool ssd = L & 1;
            u64* SS = (u64*)(p.ws + WS_SS);
            if (sub == 0) {
                pg8::Sched S;
                if (!ssd) { if (PH_ON(2)) { S.init(NPANEL, 16, G, bid, 0, 16, 0);
                    pg8::Gemm g{(const bf16_t*)(p.ws + WS_XB), (const bf16_t*)(p.ws + WS_WPIN) + (size_t)j * 4096 * 1024, T, 4096, 1024};
                    pg8::EpiPoolIn E{(bf16_t*)(p.ws + WS_U), (bf16_t*)(p.ws + WS_Z), SS + (size_t)L * T};
                    FRESH_TID(t2); for (int rep = 0; rep < NREP(2); ++rep) pg8::gemm_phase(lds3, g, S, E, t2);
                    if (L == 0 && G > 64 && bid >= 64) prep_weights(p, ldsg, bid - 64, G - 64, t2, W_FIRST, -1); }
                } else if (PH_ON(3)) { S.init(NPANEL, SSD_IN_PAD / 256, G, bid, 0, 16, 0);
                    pg8::Gemm g{(const bf16_t*)(p.ws + WS_XB), (const bf16_t*)(p.ws + WS_WSIN) + (size_t)j * SSD_IN_PAD * 1024, T, SSD_IN_PAD, 1024};
                    pg8::EpiSsdIn E{(bf16_t*)(p.ws + WS_Z), (bf16_t*)(p.ws + WS_XBC), (float*)(p.ws + WS_DT), SS + (size_t)L * T, p.ssd_dt_bias + j * N_HEADS};
                    FRESH_TID(t3); for (int rep = 0; rep < NREP(3); ++rep) pg8::gemm_phase(lds3, g, S, E, t3);
                }
            } else if (sub == 1) {
                if (!ssd) { if (PH_ON(4)) { FRESH_TID(t4); for (int rep = 0; rep < NREP(4); ++rep) phase_pool(p, j, bid, G, t4); } } else if (PH_ON(5)) { FRESH_TID(t5); for (int rep = 0; rep < NREP(5); ++rep) { phase_conv(p, j, bid, G, t5); decode_units(p, j, lds3, bid, G, t5, rep); } }
            } else if (sub == 2) {
                if (!ssd) { if (PH_ON(6)) { pg8::Sched S; S.init(NPANEL, 8, G, bid, 1, 8, 0);
                    pg8::Gemm g{(const bf16_t*)(p.ws + WS_P), (const bf16_t*)(p.ws + WS_WMIX) + (size_t)j * 2048 * 512, 4 * T, 2048, 512};
                    pg8::EpiPoolMix E{(bf16_t*)(p.ws + WS_Y), (const bf16_t*)(p.ws + WS_Z), p.pool_scale + j * D_INNER};
                    FRESH_TID(t6); for (int rep = 0; rep < NREP(6); ++rep) pg8::gemm_phase(lds3, g, S, E, t6); }
                } else if (PH_ON(7)) { FRESH_TID(t7); for (int rep = 0; rep < NREP(7); ++rep) phase_scan(p, j, ldsg, bid, G, t7, rep); }
            } else if (PH_ON(8)) {
                pg8::Sched S; S.init(64, 4, G, bid, 0, 32, 1);
                const bf16_t* Wt = ssd ? (const bf16_t*)(p.ws + WS_WSOUT) + (size_t)j * 1024 * 2048 : (const bf16_t*)(p.ws + WS_WPOUT) + (size_t)j * 1024 * 2048;
                pg8::Gemm g{(const bf16_t*)(p.ws + WS_Y), Wt, T, 1024, 2048};
                float* X = (float*)(p.ws + WS_X);
                pg8::EpiOut E{L == 0 ? p.x_prompt : X, L == 0 ? p.x_sample : X + (size_t)TP * D_MODEL, X, (bf16_t*)(p.ws + WS_XB), SS + (size_t)(L + 1) * T,
                              ssd ? (const u64*)(p.ws + WS_SS2) + (size_t)j * T : nullptr, 0, (float*)(p.ws + WS_PART)};
                FRESH_TID(t8); for (int rep = 0; rep < NREP(8); ++rep) { E.dry = rep; pg8::gemm_phase(lds3, g, S, E, t8); }
                if (L < 3) { xcd_barrier(xbar, t8); sample_fix(p, L, bid, G, t8); }
            }
        }
        if (ph + 1 < pin.ph_hi) { int tz2 = 0; asm volatile("" : "+v"(tz2));
            xcd_barrier(xbar, wid_s * 64 + (int)__builtin_amdgcn_mbcnt_hi(~0u, __builtin_amdgcn_mbcnt_lo(~0u, (unsigned)tz2))); }
    }
}

extern "C" void kernel_launch(void* const* d_in, const int* in_sizes, int n_in, void* d_out, int out_size, void* d_ws, size_t ws_size, hipStream_t stream) {
    static int grid = 0;
    if (grid == 0) {
        if (n_in != 19 || ws_size < WS_END) { fprintf(stderr, "kernel_launch: unexpected n_in %d / ws_size %zu (need %zu)\n", n_in, ws_size, (size_t)WS_END); grid = -1; return; }
        if (hipFuncSetAttribute((const void*)fwd_kernel, hipFuncAttributeMaxDynamicSharedMemorySize, LDS_BYTES) != hipSuccess) { fprintf(stderr, "kernel_launch: hipFuncSetAttribute failed\n"); grid = -1; return; }
        int dev = 0, cus = 0, per_cu = 0;
        hipGetDevice(&dev); hipDeviceGetAttribute(&cus, hipDeviceAttributeMultiprocessorCount, dev);
        hipOccupancyMaxActiveBlocksPerMultiprocessor(&per_cu, (const void*)fwd_kernel, NTHREADS, LDS_BYTES);
        (void)hipGetLastError();
        if (per_cu < 1) per_cu = 1;
        grid = cus;
    }
    if (grid < 0) return;
    Params p{};
    const float** f = (const float**)&p;
    for (int i = 0; i < 19; ++i) f[i] = (const float*)d_in[i];
    p.out = (float*)d_out; p.ws = (unsigned char*)d_ws;
    if (hipMemsetAsync((char*)d_ws + WS_CTL, 0, 16384, stream) != hipSuccess) { fprintf(stderr, "kernel_launch: memset failed\n"); return; }
#if MK_MULTI
    for (int ph = 0; ph < N_PHASES; ++ph) { p.ph_lo = ph; p.ph_hi = ph + 1; hipLaunchKernelGGL(fwd_kernel, dim3(grid), dim3(NTHREADS), LDS_BYTES, stream, p); }
#else
    p.ph_lo = 0; p.ph_hi = N_PHASES;
    void* args[] = {&p};
    hipError_t e = hipLaunchCooperativeKernel((const void*)fwd_kernel, dim3(grid), dim3(NTHREADS), args, LDS_BYTES, stream);
    if (e != hipSuccess) fprintf(stderr, "cooperative launch failed: %s (grid %d)\n", hipGetErrorString(e), grid);
#endif
}
```

```cpp
#include <hip/hip_runtime.h>
#include <hip/hip_cooperative_groups.h>
#include <cstdio>
#include <cstdint>
namespace cg = cooperative_groups;

#ifndef SPLITQ
#define SPLITQ 8
#endif
#ifndef MK_MULTI
#define MK_MULTI 0
#endif

constexpr int D_MODEL = 1024, BATCH = 8, SEQ = 2048, DEC_BATCH = 128, DEC_SEQ = 8;
constexpr int D_INNER = 2048, POOL_BUF = 15, N_HEADS = 32, D_STATE = 128, CONV_DIM = 3072, SSD_IN = 5152;
constexpr int TP = BATCH * SEQ;
constexpr int TS = DEC_BATCH * DEC_SEQ;
constexpr int T = TP + TS;
constexpr int NPANEL = T / 256;
constexpr int SSD_IN_PAD = 5376;
constexpr float EPS = 1e-6f;

constexpr size_t O_YP = 0, O_YS = O_YP + (size_t)TP * D_MODEL, O_POOLP = O_YS + (size_t)TS * D_MODEL,
                 O_POOLS = O_POOLP + (size_t)2 * BATCH * POOL_BUF * D_INNER, O_CONVP = O_POOLS + (size_t)2 * DEC_BATCH * POOL_BUF * D_INNER,
                 O_CONVS = O_CONVP + (size_t)2 * BATCH * 3 * CONV_DIM, O_SSMP = O_CONVS + (size_t)2 * DEC_BATCH * 3 * CONV_DIM,
                 O_SSMS = O_SSMP + (size_t)2 * BATCH * N_HEADS * 64 * D_STATE;

constexpr size_t al(size_t x) { return (x + 4095) & ~(size_t)4095; }
constexpr size_t WS_CTL = 0;
constexpr size_t WS_SS = 16384;
constexpr size_t WS_SS2 = al(WS_SS + (size_t)5 * T * 8);
constexpr size_t WS_WPIN = al(WS_SS2 + (size_t)2 * T * 8);
constexpr size_t WS_WMIX = al(WS_WPIN + (size_t)2 * 4096 * 1024 * 2);
constexpr size_t WS_WPOUT = al(WS_WMIX + (size_t)2 * 2048 * 512 * 2);
constexpr size_t WS_WSIN = al(WS_WPOUT + (size_t)2 * 1024 * 2048 * 2);
constexpr size_t WS_WSOUT = al(WS_WSIN + (size_t)2 * SSD_IN_PAD * 1024 * 2);
constexpr size_t WS_X = al(WS_WSOUT + (size_t)2 * 1024 * 2048 * 2);
constexpr size_t WS_XB = al(WS_X + (size_t)T * 1024 * 4);
constexpr size_t WS_U = al(WS_XB + (size_t)T * 1024 * 2);
constexpr size_t WS_Z = al(WS_U + (size_t)T * 2048 * 2);
constexpr size_t WS_P = al(WS_Z + (size_t)T * 2048 * 2);
constexpr size_t WS_Y = al(WS_P + (size_t)T * 2048 * 2);
constexpr size_t WS_XBC = al(WS_Y + (size_t)T * 2048 * 2);
constexpr size_t WS_XBCC = al(WS_XBC + (size_t)T * 3072 * 2);
constexpr size_t WS_DT = al(WS_XBCC + (size_t)T * 3072 * 2);
constexpr size_t WS_PART = al(WS_DT + (size_t)T * 32 * 4);
constexpr size_t WS_END = al(WS_PART + (size_t)8 * TS * 1024 * 4);

constexpr int LDS_STAGE = 131072 + 20480;
constexpr int LDS_BYTES = LDS_STAGE + 64;
constexpr int NTHREADS = 512;

typedef unsigned short bf16_t;
typedef short bf16x8 __attribute__((ext_vector_type(8)));
typedef float f32x4 __attribute__((ext_vector_type(4)));
typedef float f32x2 __attribute__((ext_vector_type(2)));
typedef unsigned u32x4 __attribute__((ext_vector_type(4)));
typedef unsigned u32x2 __attribute__((ext_vector_type(2)));

struct Params {
    const float *x_prompt, *x_sample, *state_pool, *state_conv, *state_ssm, *norm_w, *pool_in_w, *pool_mix_w, *pool_scale, *pool_out_w,
        *ssd_in_w, *ssd_conv_w, *ssd_conv_b, *ssd_dt_bias, *ssd_A_log, *ssd_D, *ssd_norm_w, *ssd_out_w, *final_norm_w;
    float* out;
    unsigned char* ws;
    int ph_lo, ph_hi;
};

__device__ __forceinline__ unsigned cvt_pk_bf16(float lo, float hi) { unsigned r; asm volatile("v_cvt_pk_bf16_f32 %0, %1, %2" : "=v"(r) : "v"(lo), "v"(hi)); return r; }
__device__ __forceinline__ float bf_lo(unsigned u) { return __uint_as_float(u << 16); }
__device__ __forceinline__ float bf_hi(unsigned u) { return __uint_as_float(u & 0xffff0000u); }
__device__ __forceinline__ float bf1(bf16_t b) { return __uint_as_float(((unsigned)b) << 16); }
__device__ __forceinline__ float shx(float v, int lane, int m) { return __int_as_float(__builtin_amdgcn_ds_bpermute((lane ^ m) << 2, __float_as_int(v))); }
__device__ __forceinline__ float shup(float v, int lane, int d) { const int src = lane >= d ? lane - d : lane; return __int_as_float(__builtin_amdgcn_ds_bpermute(src << 2, __float_as_int(v))); }
typedef unsigned long long u64;
__device__ __forceinline__ u64 fx(float s) { const unsigned hi = (unsigned)s; const unsigned lo = (unsigned)((s - (float)hi) * 4294967296.f); return ((u64)hi << 32) | lo; }
__device__ __forceinline__ float ssf(const u64* p) { const u64 v = *p; return (float)(unsigned)(v >> 32) + (float)(unsigned)v * 2.3283064365386963e-10f; }
__device__ __forceinline__ float silu_f(float v) { return v * __builtin_amdgcn_rcpf(1.f + __expf(-v)); }
__device__ __forceinline__ float softplus_f(float v) { return fmaxf(v, 0.f) + __logf(1.f + __expf(-fabsf(v))); }

namespace pg8 {
#define PG8_LAS __attribute__((address_space(3)))
constexpr int BM = 256, BK = 64, HALF = 128, HTB = HALF * BK * 2, STAGE_BYTES = 8 * HTB, NXCD = 8, WGM = 8;
__host__ __device__ __forceinline__ int lds_byte(int r, int c) { const int st = (r >> 4) * 2 + (c >> 5), rr = r & 15, cc = c & 31, ob = rr * 64 + cc * 2; return st * 1024 + (ob ^ (((ob >> 9) & 1) << 5)); }
__host__ __device__ __forceinline__ void stage_rc(int b, int& R, int& C) { const int st = b / 1024, sb = b % 1024, swz = sb ^ (((sb >> 9) & 1) << 5); R = (st >> 1) * 16 + swz / 64; C = (st & 1) * 32 + (swz % 64) / 2; }
__host__ __device__ __forceinline__ int perm32(int rho) { const int n = rho >> 4, i = rho & 15; return 8 * (i >> 2) + 4 * n + (i & 3); }

struct Unit { int pm, pn, kofs, nt; };
struct Gemm { const bf16_t* A; const bf16_t* Bt; int M, N, K; };

struct Sched {
    int nM, nN, nwg, G, c, grouped, ntf, split;
    __device__ void init(int nM_, int nN_, int G_, int c_, int grouped_, int ntf_, int split_) { nM = nM_; nN = nN_; nwg = nM * nN + (split_ ? 16 * SPLITQ : 0); G = G_; c = c_; grouped = grouped_; ntf = ntf_; split = split_; }
    __device__ bool next(int i, Unit& u) const {
        const long L = (long)i * G + c; if (L >= nwg) return false;
        const int nfull = nM * nN;
        if (L >= nfull) { const int idx = (int)L - nfull, tile = idx / SPLITQ, q = idx % SPLITQ; u.pm = 64 + (tile >> 2); u.pn = tile & 3; u.kofs = q * (ntf / SPLITQ) * BK * 2; u.nt = ntf / SPLITQ; return true; }
        int wgid = (int)L; { const int q = nfull / NXCD, r = nfull % NXCD, xcd = wgid % NXCD, off = wgid / NXCD; wgid = (xcd < r ? xcd * (q + 1) : r * (q + 1) + (xcd - r) * q) + off; }
        const int nig = WGM * nN, gid = wgid / nig, fm = gid * WGM, gsz = (nM - fm) < WGM ? (nM - fm) : WGM;
        u.pm = fm + ((wgid % nig) % gsz); u.pn = (wgid % nig) / gsz; u.kofs = 0; u.nt = ntf;
        if (grouped) u.pm += (u.pn >> 1) * NPANEL;
        return true;
    }
    __device__ __forceinline__ void a_ready(const Unit&) const {}
    __device__ __forceinline__ void done(const Unit&) const {}
};

template <class Epi, class Sch>
__device__ __forceinline__ void gemm_phase(PG8_LAS unsigned char* lds, const Gemm g, const Sch& S, const Epi& E, const int tid) {
    const int wid = __builtin_amdgcn_readfirstlane(tid >> 6), lane = tid & 63, wr = wid >> 2, wc = wid & 3, fr = lane & 15, fq = lane >> 4;
    const int K = g.K;
    unsigned voffA[2], voffB[2];
#pragma unroll
    for (int i = 0; i < 2; ++i) { int R, C; stage_rc(tid * 16 + i * 8192, R, C); const int Rb = Epi::PERM ? ((R & ~31) + perm32(R & 31)) : R;
        voffA[i] = (unsigned)(R * K + C) * 2u; voffB[i] = (unsigned)(Rb * K + C) * 2u; }
    const size_t kstep = (size_t)(BK * 2);
    const size_t hstep = (size_t)HALF * K * 2;
    const size_t tstep = 2 * hstep;
    const unsigned ldsw = (unsigned)wid * 1024u;
    const int aoff = lds_byte(wr * 64 + fr, fq * 8), boff = lds_byte(wc * 32 + fr, fq * 8);
#define PG8_SA(b, h) (((b) * 2 + (h)) * HTB)
#define PG8_SB(b, h) ((4 + (b) * 2 + (h)) * HTB)
#define PG8_STAGE(bufoff, gbase, voff) do { _Pragma("unroll") for (int _i = 0; _i < 2; ++_i) \
        __builtin_amdgcn_global_load_lds((const unsigned*)((const char*)(gbase) + (voff)[_i]), (PG8_LAS unsigned*)(lds + (bufoff) + ldsw + _i * 8192), 16, 0, 0); } while (0)
#define PG8_LDA(dst, b, h) do { _Pragma("unroll") for (int m = 0; m < 4; ++m) _Pragma("unroll") for (int k = 0; k < 2; ++k) dst[m][k] = *(const PG8_LAS bf16x8*)(lds + PG8_SA(b, h) + aoff + m * 2048 + k * 1024); } while (0)
#define PG8_LDB(dst, b, h) do { _Pragma("unroll") for (int n = 0; n < 2; ++n) _Pragma("unroll") for (int k = 0; k < 2; ++k) dst[n][k] = *(const PG8_LAS bf16x8*)(lds + PG8_SB(b, h) + boff + n * 2048 + k * 1024); } while (0)
#define PG8_MMA(ai, bj, At, Bt) do { __builtin_amdgcn_s_setprio(1); _Pragma("unroll") for (int m = 0; m < 4; ++m) _Pragma("unroll") for (int n = 0; n < 2; ++n) _Pragma("unroll") for (int k = 0; k < 2; ++k) \
        acc[ai][bj][m][n] = __builtin_amdgcn_mfma_f32_16x16x32_bf16(Bt[n][k], At[m][k], acc[ai][bj][m][n], 0, 0, 0); __builtin_amdgcn_s_setprio(0); } while (0)
#define PG8_WAIT_V(n) asm volatile("s_waitcnt vmcnt(" #n ")" ::: "memory")
#define PG8_WAIT_L(n) asm volatile("s_waitcnt lgkmcnt(" #n ")" ::: "memory")
#define PG8_BAR __builtin_amdgcn_s_barrier()
#define PG8_SCHED __builtin_amdgcn_sched_barrier(0)
    Unit cur, nxt; int ui = 0;
    if (!S.next(0, cur)) return;
    f32x4 acc[2][2][4][2];
#pragma unroll
    for (int a = 0; a < 2; ++a)
#pragma unroll
        for (int b = 0; b < 2; ++b)
#pragma unroll
            for (int m = 0; m < 4; ++m)
#pragma unroll
                for (int n = 0; n < 2; ++n) acc[a][b][m][n] = (f32x4){0.f, 0.f, 0.f, 0.f};
    bf16x8 At[4][2], B0[2][2], B1[2][2];
    const char* cA = (const char*)g.A + (size_t)cur.pm * tstep + cur.kofs; const char* cB = (const char*)g.Bt + (size_t)cur.pn * tstep + cur.kofs;
    int nt = cur.nt;
    S.a_ready(cur);
    PG8_STAGE(PG8_SB(0, 0), cB, voffB); PG8_STAGE(PG8_SA(0, 0), cA, voffA); PG8_STAGE(PG8_SB(0, 1), cB + hstep, voffB); PG8_STAGE(PG8_SA(0, 1), cA + hstep, voffA);
    if (wr == 1) PG8_BAR;
    PG8_WAIT_V(4); PG8_BAR;
    PG8_STAGE(PG8_SB(1, 0), cB + kstep, voffB); PG8_STAGE(PG8_SA(1, 0), cA + kstep, voffA); PG8_STAGE(PG8_SB(1, 1), cB + hstep + kstep, voffB);
    PG8_WAIT_V(6); PG8_BAR;
    for (;;) {
        const bool has_next = S.next(ui + 1, nxt);
        const char* nA = has_next ? (const char*)g.A + (size_t)nxt.pm * tstep + nxt.kofs : cA; const char* nB = has_next ? (const char*)g.Bt + (size_t)nxt.pn * tstep + nxt.kofs : cB;
        for (int t = 0; t < nt; t += 2) {
            const bool last = (t == nt - 2);
            const char* a1 = cA + (size_t)(t + 1) * kstep;
            const char* a2 = last ? nA : cA + (size_t)(t + 2) * kstep; const char* b2 = last ? nB : cB + (size_t)(t + 2) * kstep;
            const char* a3 = a2 + kstep; const char* b3 = b2 + kstep;
            if (last && has_next) S.a_ready(nxt);
            PG8_LDB(B0, 0, 0); PG8_SCHED; PG8_LDA(At, 0, 0); PG8_STAGE(PG8_SA(1, 1), a1 + hstep, voffA);
            PG8_WAIT_L(8); PG8_BAR; PG8_WAIT_L(0); PG8_MMA(0, 0, At, B0); PG8_BAR; PG8_SCHED;
            PG8_LDB(B1, 0, 1); PG8_STAGE(PG8_SB(0, 0), b2, voffB);
            PG8_BAR; PG8_WAIT_L(0); PG8_MMA(0, 1, At, B1); PG8_BAR;
            PG8_LDA(At, 0, 1); PG8_STAGE(PG8_SA(0, 0), a2, voffA);
            PG8_BAR; PG8_WAIT_L(0); PG8_MMA(1, 0, At, B0); PG8_BAR; PG8_SCHED;
            PG8_STAGE(PG8_SB(0, 1), b2 + hstep, voffB);
            PG8_WAIT_V(6); PG8_BAR; PG8_MMA(1, 1, At, B1); PG8_BAR;
            PG8_LDB(B0, 1, 0); PG8_SCHED; PG8_LDA(At, 1, 0); PG8_STAGE(PG8_SA(0, 1), a2 + hstep, voffA);
            PG8_WAIT_L(8); PG8_BAR; PG8_WAIT_L(0); PG8_MMA(0, 0, At, B0); PG8_BAR; PG8_SCHED;
            PG8_LDB(B1, 1, 1); PG8_STAGE(PG8_SB(1, 0), b3, voffB);
            PG8_BAR; PG8_WAIT_L(0); PG8_MMA(0, 1, At, B1); PG8_BAR;
            PG8_LDA(At, 1, 1); PG8_STAGE(PG8_SA(1, 0), a3, voffA);
            PG8_BAR; PG8_WAIT_L(0); PG8_MMA(1, 0, At, B0); PG8_BAR; PG8_SCHED;
            PG8_STAGE(PG8_SB(1, 1), b3 + hstep, voffB);
            PG8_WAIT_V(6); PG8_BAR; PG8_MMA(1, 1, At, B1); PG8_BAR;
        }
        E(acc, cur, wr, wc, fr, fq); S.done(cur);
        if (!has_next) break;
#pragma unroll
        for (int a = 0; a < 2; ++a)
#pragma unroll
            for (int b = 0; b < 2; ++b)
#pragma unroll
                for (int m = 0; m < 4; ++m)
#pragma unroll
                    for (int n = 0; n < 2; ++n) acc[a][b][m][n] = (f32x4){0.f, 0.f, 0.f, 0.f};
        cur = nxt; cA = nA; cB = nB; nt = cur.nt; ++ui;
    }
    PG8_WAIT_V(0);
    if (wr == 0) PG8_BAR;
    PG8_BAR;
#undef PG8_SA
#undef PG8_SB
#undef PG8_STAGE
#undef PG8_LDA
#undef PG8_LDB
#undef PG8_MMA
#undef PG8_WAIT_V
#undef PG8_WAIT_L
#undef PG8_BAR
#undef PG8_SCHED
}

struct EpiPoolIn {
    static constexpr bool PERM = true;
    bf16_t* U; bf16_t* Z; const u64* ss;
    __device__ __forceinline__ void operator()(const f32x4 (&acc)[2][2][4][2], const Unit& u, int wr, int wc, int fr, int fq) const {
        const int row0 = u.pm * BM + wr * 64 + fr; const bool isz = u.pn >= 8; bf16_t* base = isz ? Z : U;
        const int col0 = (u.pn & 7) * BM + wc * 32 + 8 * fq;
        float rs[2][4];
#pragma unroll
        for (int ai = 0; ai < 2; ++ai)
#pragma unroll
            for (int m = 0; m < 4; ++m) rs[ai][m] = ssf(ss + row0 + ai * HALF + m * 16);
#pragma unroll
        for (int ai = 0; ai < 2; ++ai)
#pragma unroll
            for (int m = 0; m < 4; ++m) { const int row = row0 + ai * HALF + m * 16; const float rstd = rsqrtf(rs[ai][m] * (1.f / D_MODEL) + EPS);
                bf16_t* rowp = base + (size_t)row * D_INNER + col0;
#pragma unroll
                for (int bj = 0; bj < 2; ++bj) { f32x4 v0 = acc[ai][bj][m][0] * rstd, v1 = acc[ai][bj][m][1] * rstd;
                    if (isz) { v0[0] = silu_f(v0[0]); v0[1] = silu_f(v0[1]); v0[2] = silu_f(v0[2]); v0[3] = silu_f(v0[3]); v1[0] = silu_f(v1[0]); v1[1] = silu_f(v1[1]); v1[2] = silu_f(v1[2]); v1[3] = silu_f(v1[3]); }
                    u32x4 o; o[0] = cvt_pk_bf16(v0[0], v0[1]); o[1] = cvt_pk_bf16(v0[2], v0[3]); o[2] = cvt_pk_bf16(v1[0], v1[1]); o[3] = cvt_pk_bf16(v1[2], v1[3]);
                    *(u32x4*)(rowp + bj * HALF) = o; } }
    }
};
struct EpiPoolMix {
    static constexpr bool PERM = true;
    bf16_t* Y; const bf16_t* Z; const float* scale;
    __device__ __forceinline__ void operator()(const f32x4 (&acc)[2][2][4][2], const Unit& u, int wr, int wc, int fr, int fq) const {
        const int pm = u.pm - (u.pn >> 1) * NPANEL;
        const int row0 = pm * BM + wr * 64 + fr; const int col0 = u.pn * BM + wc * 32 + 8 * fq;
        f32x4 sc[2][2];
#pragma unroll
        for (int bj = 0; bj < 2; ++bj) { sc[bj][0] = *(const f32x4*)(scale + col0 + bj * HALF); sc[bj][1] = *(const f32x4*)(scale + col0 + bj * HALF + 4); }
#pragma unroll
        for (int ai = 0; ai < 2; ++ai) {
            u32x4 zz[4][2];
#pragma unroll
            for (int m = 0; m < 4; ++m)
#pragma unroll
                for (int bj = 0; bj < 2; ++bj) zz[m][bj] = *(const u32x4*)(Z + (size_t)(row0 + ai * HALF + m * 16) * D_INNER + col0 + bj * HALF);
#pragma unroll
            for (int m = 0; m < 4; ++m) { const size_t ro = (size_t)(row0 + ai * HALF + m * 16) * D_INNER + col0;
#pragma unroll
                for (int bj = 0; bj < 2; ++bj) { const u32x4 z4 = zz[m][bj];
                    f32x4 v0 = acc[ai][bj][m][0] * sc[bj][0], v1 = acc[ai][bj][m][1] * sc[bj][1];
                    v0[0] *= bf_lo(z4[0]); v0[1] *= bf_hi(z4[0]); v0[2] *= bf_lo(z4[1]); v0[3] *= bf_hi(z4[1]);
                    v1[0] *= bf_lo(z4[2]); v1[1] *= bf_hi(z4[2]); v1[2] *= bf_lo(z4[3]); v1[3] *= bf_hi(z4[3]);
                    u32x4 o; o[0] = cvt_pk_bf16(v0[0], v0[1]); o[1] = cvt_pk_bf16(v0[2], v0[3]); o[2] = cvt_pk_bf16(v1[0], v1[1]); o[3] = cvt_pk_bf16(v1[2], v1[3]);
                    *(u32x4*)(Y + ro + bj * HALF) = o; } } }
    }
};
struct EpiOut {
    static constexpr bool PERM = false;
    const float* xin_p; const float* xin_s;
    float* X; bf16_t* XB; u64* ssn; const u64* ss2; int dry; float* PART;
    __device__ __forceinline__ void operator()(const f32x4 (&acc)[2][2][4][2], const Unit& u, int wr, int wc, int fr, int fq) const {
        const int row0 = u.pm * BM + wr * 64 + fr, col0 = u.pn * BM + wc * 32 + 4 * fq;
        if (u.pm >= 64) {
            float* dst = PART + (size_t)(u.kofs / (u.nt * BK * 2)) * TS * D_MODEL;
            float r2[2][4];
#pragma unroll
            for (int ai = 0; ai < 2; ++ai)
#pragma unroll
                for (int m = 0; m < 4; ++m) r2[ai][m] = ss2 ? ssf(ss2 + row0 + ai * HALF + m * 16) : 0.f;
#pragma unroll
            for (int ai = 0; ai < 2; ++ai)
#pragma unroll
                for (int m = 0; m < 4; ++m) { const int row = row0 + ai * HALF + m * 16; const float rr = ss2 ? rsqrtf(r2[ai][m] * (1.f / D_INNER) + EPS) : 1.f;
#pragma unroll
                    for (int bj = 0; bj < 2; ++bj)
#pragma unroll
                        for (int n = 0; n < 2; ++n) *(f32x4*)(dst + (size_t)(row - TP) * D_MODEL + col0 + bj * HALF + n * 16) = acc[ai][bj][m][n] * rr; }
            return;
        }
#pragma unroll
        for (int ai = 0; ai < 2; ++ai)
#pragma unroll
            for (int mp = 0; mp < 2; ++mp) {
                f32x4 xv[2][2][2]; float r2[2];
#pragma unroll
                for (int mm = 0; mm < 2; ++mm) { const int row = row0 + ai * HALF + (2 * mp + mm) * 16;
                    const float* xo = (row < TP ? xin_p + (size_t)row * D_MODEL : xin_s + (size_t)(row - TP) * D_MODEL) + col0;
                    r2[mm] = ss2 ? ssf(ss2 + row) : 0.f;
#pragma unroll
                    for (int bj = 0; bj < 2; ++bj)
#pragma unroll
                        for (int n = 0; n < 2; ++n) xv[mm][bj][n] = *(const f32x4*)(xo + bj * HALF + n * 16); }
#pragma unroll
                for (int mm = 0; mm < 2; ++mm) { const int m = 2 * mp + mm, row = row0 + ai * HALF + m * 16;
                    const float rr = ss2 ? rsqrtf(r2[mm] * (1.f / D_INNER) + EPS) : 1.f;
                    float s = 0.f;
#pragma unroll
                    for (int bj = 0; bj < 2; ++bj)
#pragma unroll
                        for (int n = 0; n < 2; ++n) { const int co = bj * HALF + n * 16;
                            const f32x4 v = xv[mm][bj][n] + acc[ai][bj][m][n] * rr;
                            if (!dry) { *(f32x4*)(X + (size_t)row * D_MODEL + col0 + co) = v;
                                u32x2 o; o[0] = cvt_pk_bf16(v[0], v[1]); o[1] = cvt_pk_bf16(v[2], v[3]);
                                *(u32x2*)(XB + (size_t)row * D_MODEL + col0 + co) = o; }
                            s += v[0] * v[0] + v[1] * v[1] + v[2] * v[2] + v[3] * v[3]; }
                    { const int ln = fq * 16 + fr; s += shx(s, ln, 16); s += shx(s, ln, 32); }
                    if (fq == 0 && !dry) atomicAdd(ssn + row, fx(s)); } }
    }
};
struct EpiSsdIn {
    static constexpr bool PERM = true;
    bf16_t* Z; bf16_t* XBC; float* DT; const u64* ss; const float* dt_bias;
    __device__ __forceinline__ void operator()(const f32x4 (&acc)[2][2][4][2], const Unit& u, int wr, int wc, int fr, int fq) const {
        const int row0 = u.pm * BM + wr * 64 + fr;
        const int kind = u.pn < 8 ? 0 : (u.pn < 20 ? 1 : 2);
        const int colt = kind == 0 ? u.pn * BM : (u.pn - 8) * BM;
        const int col0 = colt + wc * 32 + 8 * fq;
        float rs[2][4];
#pragma unroll
        for (int ai = 0; ai < 2; ++ai)
#pragma unroll
            for (int m = 0; m < 4; ++m) rs[ai][m] = ssf(ss + row0 + ai * HALF + m * 16);
#pragma unroll
        for (int ai = 0; ai < 2; ++ai)
#pragma unroll
            for (int m = 0; m < 4; ++m) { const int row = row0 + ai * HALF + m * 16; const float rstd = rsqrtf(rs[ai][m] * (1.f / D_MODEL) + EPS);
#pragma unroll
                for (int bj = 0; bj < 2; ++bj) { f32x4 v0 = acc[ai][bj][m][0] * rstd, v1 = acc[ai][bj][m][1] * rstd;
                    if (kind == 2) {
                        if (bj == 0 && wc == 0) { const int c = 8 * fq;
                            f32x4 b0 = *(const f32x4*)(dt_bias + c), b1 = *(const f32x4*)(dt_bias + c + 4);
                            f32x4 o0, o1; o0[0] = softplus_f(v0[0] + b0[0]); o0[1] = softplus_f(v0[1] + b0[1]); o0[2] = softplus_f(v0[2] + b0[2]); o0[3] = softplus_f(v0[3] + b0[3]);
                            o1[0] = softplus_f(v1[0] + b1[0]); o1[1] = softplus_f(v1[1] + b1[1]); o1[2] = softplus_f(v1[2] + b1[2]); o1[3] = softplus_f(v1[3] + b1[3]);
                            *(f32x4*)(DT + (size_t)row * 32 + c) = o0; *(f32x4*)(DT + (size_t)row * 32 + c + 4) = o1; }
                    } else {
                        if (kind == 0) { v0[0] = silu_f(v0[0]); v0[1] = silu_f(v0[1]); v0[2] = silu_f(v0[2]); v0[3] = silu_f(v0[3]); v1[0] = silu_f(v1[0]); v1[1] = silu_f(v1[1]); v1[2] = silu_f(v1[2]); v1[3] = silu_f(v1[3]); }
                        u32x4 o; o[0] = cvt_pk_bf16(v0[0], v0[1]); o[1] = cvt_pk_bf16(v0[2], v0[3]); o[2] = cvt_pk_bf16(v1[0], v1[1]); o[3] = cvt_pk_bf16(v1[2], v1[3]);
                        bf16_t* dst = kind == 0 ? Z + (size_t)row * D_INNER : XBC + (size_t)row * CONV_DIM;
                        *(u32x4*)(dst + col0 + bj * HALF) = o; } } }
    }
};
}

__device__ __forceinline__ void transpose_item(const float* W, int K, int N, bf16_t* WT, const float* kscale, int k0, int n0, float* scr, int lane) {
    const int kr = lane >> 3, n4 = (lane & 7) * 4;
    f32x4 v[8]; float sc[8];
#pragma unroll
    for (int i = 0; i < 8; ++i) { v[i] = *(const f32x4*)(W + (size_t)(k0 + kr + 8 * i) * N + n0 + n4); sc[i] = kscale ? kscale[k0 + kr + 8 * i] : 1.f; }
#pragma unroll
    for (int i = 0; i < 8; ++i) { float* t = scr + (kr + 8 * i) * 33 + n4; t[0] = v[i][0] * sc[i]; t[1] = v[i][1] * sc[i]; t[2] = v[i][2] * sc[i]; t[3] = v[i][3] * sc[i]; }
    asm volatile("s_waitcnt lgkmcnt(0)" ::: "memory");
    const int c = lane & 7;
#pragma unroll
    for (int jn = 0; jn < 4; ++jn) { const int n = (lane >> 3) + 8 * jn; const float* t = scr + (8 * c) * 33 + n;
        u32x4 o; o[0] = cvt_pk_bf16(t[0], t[33]); o[1] = cvt_pk_bf16(t[2 * 33], t[3 * 33]); o[2] = cvt_pk_bf16(t[4 * 33], t[5 * 33]); o[3] = cvt_pk_bf16(t[6 * 33], t[7 * 33]);
        *(u32x4*)(WT + (size_t)(n0 + n) * K + k0 + 8 * c) = o; }
    asm volatile("s_waitcnt lgkmcnt(0)" ::: "memory");
}

constexpr int W_FIRST = 16 * 128, W_PER = 16 * 128 + 4 * 8 * 16 + 32 * 32 + 16 * 161 + 32 * 32;
__device__ __forceinline__ void prep_weights(const Params& p, unsigned char* lds, int vb, int VG, const int tid, int it_lo, int it_hi) {
    const int lane = tid & 63, wid = tid >> 6;
    float* scr = (float*)lds + wid * (64 * 33);
    constexpr int T_PIN = 16 * 128, T_MIX = 4 * 8 * 16, T_POUT = 32 * 32, T_SIN = 16 * 161, T_SOUT = 32 * 32, T_PER = T_PIN + T_MIX + T_POUT + T_SIN + T_SOUT;
    for (int it = it_lo + vb * 8 + wid; it < (it_hi < 0 ? 2 * T_PER : it_hi); it += VG * 8) {
        const int j = it / T_PER; int r = it % T_PER;
        if (r < T_PIN) { const int kb = r / 128, nb = r % 128;
            transpose_item(p.pool_in_w + (size_t)j * 1024 * 4096, 1024, 4096, (bf16_t*)(p.ws + WS_WPIN) + (size_t)j * 4096 * 1024, p.norm_w + (2 * j) * 1024, kb * 64, nb * 32, scr, lane); continue; }
        r -= T_PIN;
        if (r < T_MIX) { const int g = r / 128, kb = (r % 128) / 16, nb = r % 16;
            transpose_item(p.pool_mix_w + ((size_t)j * 4 + g) * 512 * 512, 512, 512, (bf16_t*)(p.ws + WS_WMIX) + ((size_t)j * 2048 + g * 512) * 512, nullptr, kb * 64, nb * 32, scr, lane); continue; }
        r -= T_MIX;
        if (r < T_POUT) { const int kb = r / 32, nb = r % 32;
            transpose_item(p.pool_out_w + (size_t)j * 2048 * 1024, 2048, 1024, (bf16_t*)(p.ws + WS_WPOUT) + (size_t)j * 1024 * 2048, nullptr, kb * 64, nb * 32, scr, lane); continue; }
        r -= T_POUT;
        if (r < T_SIN) { const int kb = r / 161, nb = r % 161;
            transpose_item(p.ssd_in_w + (size_t)j * 1024 * SSD_IN, 1024, SSD_IN, (bf16_t*)(p.ws + WS_WSIN) + (size_t)j * SSD_IN_PAD * 1024, p.norm_w + (2 * j + 1) * 1024, kb * 64, nb * 32, scr, lane); continue; }
        r -= T_SIN;
        { const int kb = r / 32, nb = r % 32;
            transpose_item(p.ssd_out_w + (size_t)j * 2048 * 1024, 2048, 1024, (bf16_t*)(p.ws + WS_WSOUT) + (size_t)j * 1024 * 2048, p.ssd_norm_w + j * 2048, kb * 64, nb * 32, scr, lane); }
    }
}

__device__ __forceinline__ void phase_prep(const Params& p, unsigned char* lds, int bid, int G, const int tid) {
    const int lane = tid & 63, wid = tid >> 6;
    prep_weights(p, lds, bid, G, tid, 0, G > 64 ? W_FIRST : -1);
    { const size_t gt = (size_t)bid * NTHREADS + tid, gn = (size_t)G * NTHREADS;
        for (int j = 0; j < 2; ++j) { u32x4* z = (u32x4*)((bf16_t*)(p.ws + WS_WSIN) + ((size_t)j * SSD_IN_PAD + SSD_IN) * 1024);
            const size_t n16 = (size_t)(SSD_IN_PAD - SSD_IN) * 1024 * 2 / 16;
            for (size_t i = gt; i < n16; i += gn) z[i] = (u32x4){0u, 0u, 0u, 0u}; }
        u64* ss = (u64*)(p.ws + WS_SS) + T; for (size_t i = gt; i < (size_t)4 * T; i += gn) ss[i] = 0ull;
        u64* ss2 = (u64*)(p.ws + WS_SS2); for (size_t i = gt; i < (size_t)2 * T; i += gn) ss2[i] = 0ull; }
    { u64* ss0 = (u64*)(p.ws + WS_SS); bf16_t* XB = (bf16_t*)(p.ws + WS_XB);
        for (int row = bid * 8 + wid; row < T; row += G * 8) {
            const float* xr = row < TP ? p.x_prompt + (size_t)row * D_MODEL : p.x_sample + (size_t)(row - TP) * D_MODEL;
            float s = 0.f; f32x4 v[4];
#pragma unroll
            for (int i = 0; i < 4; ++i) v[i] = *(const f32x4*)(xr + i * 256 + lane * 4);
#pragma unroll
            for (int i = 0; i < 4; ++i) {
                s += v[i][0] * v[i][0] + v[i][1] * v[i][1] + v[i][2] * v[i][2] + v[i][3] * v[i][3];
                u32x2 o; o[0] = cvt_pk_bf16(v[i][0], v[i][1]); o[1] = cvt_pk_bf16(v[i][2], v[i][3]);
                *(u32x2*)(XB + (size_t)row * D_MODEL + i * 256 + lane * 4) = o; }
#pragma unroll
            for (int o = 1; o < 64; o <<= 1) s += shx(s, lane, o);
            if (lane == 0) ss0[row] = fx(s); } }
}

__device__ __forceinline__ void ld8(const bf16_t* p, float (&v)[8]) { const u32x4 u = *(const u32x4*)p;
    v[0] = bf_lo(u[0]); v[1] = bf_hi(u[0]); v[2] = bf_lo(u[1]); v[3] = bf_hi(u[1]); v[4] = bf_lo(u[2]); v[5] = bf_hi(u[2]); v[6] = bf_lo(u[3]); v[7] = bf_hi(u[3]); }
__device__ __forceinline__ void ld8f(const float* p, float (&v)[8]) { const f32x4 a = *(const f32x4*)p, b = *(const f32x4*)(p + 4);
    v[0] = a[0]; v[1] = a[1]; v[2] = a[2]; v[3] = a[3]; v[4] = b[0]; v[5] = b[1]; v[6] = b[2]; v[7] = b[3]; }
__device__ __forceinline__ void st8(bf16_t* p, const float (&v)[8]) { u32x4 o; o[0] = cvt_pk_bf16(v[0], v[1]); o[1] = cvt_pk_bf16(v[2], v[3]); o[2] = cvt_pk_bf16(v[4], v[5]); o[3] = cvt_pk_bf16(v[6], v[7]); *(u32x4*)p = o; }
__device__ __forceinline__ void st8f(float* p, const float (&v)[8]) { *(f32x4*)p = (f32x4){v[0], v[1], v[2], v[3]}; *(f32x4*)(p + 4) = (f32x4){v[4], v[5], v[6], v[7]}; }

__device__ __forceinline__ void up8(const u32x4 u, float (&v)[8]) { v[0] = bf_lo(u[0]); v[1] = bf_hi(u[0]); v[2] = bf_lo(u[1]); v[3] = bf_hi(u[1]); v[4] = bf_lo(u[2]); v[5] = bf_hi(u[2]); v[6] = bf_lo(u[3]); v[7] = bf_hi(u[3]); }
__device__ __forceinline__ u32x4 pk8f(const float* p) { const f32x4 a = *(const f32x4*)p, b = *(const f32x4*)(p + 4); u32x4 o; o[0] = cvt_pk_bf16(a[0], a[1]); o[1] = cvt_pk_bf16(a[2], a[3]); o[2] = cvt_pk_bf16(b[0], b[1]); o[3] = cvt_pk_bf16(b[2], b[3]); return o; }

template <int W, int NR, bool PROMPT>
__device__ __forceinline__ void pool_run(const Params& p, int j, const bf16_t* U, bf16_t* P, int run, int c0, int g) {
    const int cl = c0 - g * 512;
    u32x4 ext[W - 1 + NR];
    int row0, t0 = 0, b = 0, sb = 0;
    if (PROMPT) { row0 = run * NR; t0 = row0 & (SEQ - 1); b = row0 >> 11;
#pragma unroll
        for (int k = 0; k < W - 1; ++k) ext[k] = (t0 - (W - 1 - k) >= 0) ? *(const u32x4*)(U + (size_t)(row0 - (W - 1 - k)) * D_INNER + c0) : (u32x4){0u, 0u, 0u, 0u};
    } else { sb = run; row0 = TP + sb * DEC_SEQ;
        const float* buf = p.state_pool + (((size_t)j * DEC_BATCH + sb) * POOL_BUF) * D_INNER + c0;
#pragma unroll
        for (int k = 0; k < W - 1; ++k) ext[k] = pk8f(buf + (size_t)(POOL_BUF - (W - 1 - k)) * D_INNER); }
#pragma unroll
    for (int t = 0; t < NR; ++t) ext[W - 1 + t] = *(const u32x4*)(U + (size_t)(row0 + t) * D_INNER + c0);
    float sum[8], u[8], o[8];
#pragma unroll
    for (int e = 0; e < 8; ++e) sum[e] = 0.f;
#pragma unroll
    for (int k = 0; k < W - 1; ++k) { up8(ext[k], u);
#pragma unroll
        for (int e = 0; e < 8; ++e) sum[e] += u[e]; }
#pragma unroll
    for (int t = 0; t < NR; ++t) { const int row = row0 + t; up8(ext[W - 1 + t], u);
        const float inv = PROMPT ? 1.f / (float)min(t0 + t + 1, W) : 1.f / (float)W;
#pragma unroll
        for (int e = 0; e < 8; ++e) { sum[e] += u[e]; o[e] = sum[e] * inv - u[e]; }
        st8(P + ((size_t)g * T + row) * 512 + cl, o);
        if (PROMPT) { if (t0 + t >= SEQ - POOL_BUF) st8f(p.out + O_POOLP + (((size_t)j * BATCH + b) * POOL_BUF + (t0 + t - (SEQ - POOL_BUF))) * D_INNER + c0, u); }
        else st8f(p.out + O_POOLS + (((size_t)j * DEC_BATCH + sb) * POOL_BUF + (POOL_BUF - DEC_SEQ + t)) * D_INNER + c0, u);
        up8(ext[t], u);
#pragma unroll
        for (int e = 0; e < 8; ++e) sum[e] -= u[e]; }
}

__device__ __forceinline__ void phase_pool(const Params& p, int j, int bid, int G, const int tid) {
    const bf16_t* U = (const bf16_t*)(p.ws + WS_U); bf16_t* P = (bf16_t*)(p.ws + WS_P);
    const int NPR = (TP / 8) * 256, NSA = DEC_BATCH * 256;
    for (int it = bid * NTHREADS + tid; it < NPR + NSA; it += G * NTHREADS) {
        const int chunk = it & 255, run = it >> 8, c0 = chunk * 8, g = __builtin_amdgcn_readfirstlane(chunk >> 6);
        if (run < TP / 8) {
            if (g == 0) pool_run<2, 8, true>(p, j, U, P, run, c0, 0); else if (g == 1) pool_run<4, 8, true>(p, j, U, P, run, c0, 1);
            else if (g == 2) pool_run<8, 8, true>(p, j, U, P, run, c0, 2); else pool_run<16, 8, true>(p, j, U, P, run, c0, 3);
        } else { const int sb = run - TP / 8;
            if (g == 0) pool_run<2, 8, false>(p, j, U, P, sb, c0, 0); else if (g == 1) pool_run<4, 8, false>(p, j, U, P, sb, c0, 1);
            else if (g == 2) pool_run<8, 8, false>(p, j, U, P, sb, c0, 2); else pool_run<16, 8, false>(p, j, U, P, sb, c0, 3);
            const float* buf = p.state_pool + (((size_t)j * DEC_BATCH + sb) * POOL_BUF) * D_INNER + c0;
            float* po = p.out + O_POOLS + (((size_t)j * DEC_BATCH + sb) * POOL_BUF) * D_INNER + c0;
            f32x4 cp[POOL_BUF - DEC_SEQ][2];
#pragma unroll
            for (int i = 0; i < POOL_BUF - DEC_SEQ; ++i) { cp[i][0] = *(const f32x4*)(buf + (size_t)(DEC_SEQ + i) * D_INNER); cp[i][1] = *(const f32x4*)(buf + (size_t)(DEC_SEQ + i) * D_INNER + 4); }
#pragma unroll
            for (int i = 0; i < POOL_BUF - DEC_SEQ; ++i) { *(f32x4*)(po + (size_t)i * D_INNER) = cp[i][0]; *(f32x4*)(po + (size_t)i * D_INNER + 4) = cp[i][1]; }
        }
    }
}

__device__ __forceinline__ void phase_conv(const Params& p, int j, int bid, int G, const int tid) {
    const bf16_t* R = (const bf16_t*)(p.ws + WS_XBC); bf16_t* O = (bf16_t*)(p.ws + WS_XBCC);
    const int NIT = (T / 8) * 384;
    for (int it = bid * NTHREADS + tid; it < NIT; it += G * NTHREADS) {
        const int chunk = it % 384, run = it / 384, c0 = chunk * 8, row0 = run * 8;
        float w0[8], w1[8], w2[8], w3[8], bs[8], h1[8], h2[8], h3[8], cur[8], o[8];
        const bool prompt = row0 < TP; const int t0 = prompt ? (row0 & (SEQ - 1)) : 0;
        u32x4 rr[8];
#pragma unroll
        for (int t = 0; t < 8; ++t) rr[t] = *(const u32x4*)(R + (size_t)(row0 + t) * CONV_DIM + c0);
        if (prompt) {
            if (t0 > 0) { ld8(R + (size_t)(row0 - 3) * CONV_DIM + c0, h3); ld8(R + (size_t)(row0 - 2) * CONV_DIM + c0, h2); ld8(R + (size_t)(row0 - 1) * CONV_DIM + c0, h1); }
            else {
#pragma unroll
                for (int e = 0; e < 8; ++e) { h1[e] = 0.f; h2[e] = 0.f; h3[e] = 0.f; } }
        } else { const int sb = (row0 - TP) >> 3; const float* sc = p.state_conv + (((size_t)j * DEC_BATCH + sb) * 3) * CONV_DIM + c0;
            ld8f(sc, h3); ld8f(sc + CONV_DIM, h2); ld8f(sc + 2 * CONV_DIM, h1); }
        const float* cw = p.ssd_conv_w + (size_t)j * 4 * CONV_DIM + c0;
        ld8f(cw, w0); ld8f(cw + CONV_DIM, w1); ld8f(cw + 2 * CONV_DIM, w2); ld8f(cw + 3 * CONV_DIM, w3); ld8f(p.ssd_conv_b + (size_t)j * CONV_DIM + c0, bs);
#pragma unroll
        for (int t = 0; t < 8; ++t) { const int row = row0 + t;
            up8(rr[t], cur);
#pragma unroll
            for (int e = 0; e < 8; ++e) { const float v = w0[e] * h3[e] + w1[e] * h2[e] + w2[e] * h1[e] + w3[e] * cur[e] + bs[e]; o[e] = silu_f(v); h3[e] = h2[e]; h2[e] = h1[e]; h1[e] = cur[e]; }
            st8(O + (size_t)row * CONV_DIM + c0, o);
            if (prompt) { const int tt = t0 + t; if (tt >= SEQ - 3) st8f(p.out + O_CONVP + (((size_t)j * BATCH + (row0 >> 11)) * 3 + (tt - (SEQ - 3))) * CONV_DIM + c0, cur); }
            else if (t >= DEC_SEQ - 3) st8f(p.out + O_CONVS + (((size_t)j * DEC_BATCH + ((row0 - TP) >> 3)) * 3 + (t - (DEC_SEQ - 3))) * CONV_DIM + c0, cur);
        }
    }
}

#define LAS __attribute__((address_space(3)))
constexpr int RS = 272;
constexpr int L_CS = 0, L_BS = 128 * RS, L_XT = 2 * 128 * RS, L_XW = L_XT + 64 * RS, L_HS = L_XW + 64 * RS  , L_DT = L_HS + 2 * 64 * RS, L_AC = L_DT + 512,
              L_STK = L_AC + 512  , L_SYS = L_STK + 8 * 320 * 2  , L_SDT = L_SYS + 8 * 64 * 4  , L_END = L_SDT + 64;
static_assert(L_END <= LDS_STAGE, "scan LDS");
typedef const LAS bf16x8* lfrag_t;
#define LFRAG(ptr, off) (*(lfrag_t)((ptr) + (off)))

__device__ __forceinline__ void scan_unit(const Params& p, int j, LAS unsigned char* L, int unit, const int tid, const int dry) {
    const int lane = tid & 63, w = __builtin_amdgcn_readfirstlane(tid >> 6), fr = lane & 15, fq = lane >> 4;
    const int b = unit >> 5, h = unit & 31, g = h >> 3;
    const bf16_t* XC = (const bf16_t*)(p.ws + WS_XBCC); const bf16_t* Z = (const bf16_t*)(p.ws + WS_Z); const float* DT = (const float*)(p.ws + WS_DT);
    bf16_t* YG = (bf16_t*)(p.ws + WS_Y); u64* ss2 = (u64*)(p.ws + WS_SS2) + (size_t)j * T;
    const float A = -__expf(p.ssd_A_log[j * N_HEADS + h]), Dh = p.ssd_D[j * N_HEADS + h];
    LAS unsigned char* const pCf = L + L_CS + (16 * w + fr) * RS + fq * 16;
    LAS unsigned char* const pBf = L + L_BS + fr * RS + fq * 16;
    LAS unsigned char* const pWr = L + L_BS + (16 * w + fr) * RS + fq * 8;
    LAS unsigned char* const pWf = L + L_BS + (16 * w + fr) * RS + fq * 16;
    LAS unsigned char* const pXf = L + L_XT + fr * RS + fq * 16;
    LAS unsigned char* const pBg = L + L_BS + (fq * 8) * RS + (16 * w + fr) * 2;
    LAS unsigned char* const pSt = L + L_CS + (tid >> 4) * RS + (tid & 15) * 16;
    LAS unsigned char* const pSx = L + L_XT + ((tid >> 7) * 8) * RS + (tid & 127) * 2;
    LAS unsigned char* const pXe = L + L_XT + (fq * 4) * RS + (16 * w + fr) * 2;
    LAS unsigned char* const pDq = L + L_DT + fq * 16;
    LAS unsigned char* const pDj = L + L_DT + (tid & 127) * 4;
    LAS unsigned char* const pDi = L + L_AC + (16 * w + fr) * 4;
    LAS unsigned char* const pHw = L + L_HS + fr * RS + (16 * w + fq * 4) * 2;
    f32x4 hacc[4];
#pragma unroll
    for (int i = 0; i < 4; ++i) hacc[i] = (f32x4){0.f, 0.f, 0.f, 0.f};
    for (int i = tid; i < 64 * RS / 16; i += NTHREADS) *(LAS u32x4*)(L + L_HS + i * 16) = (u32x4){0u, 0u, 0u, 0u};
    u32x4 creg[4], breg[4], xreg[2]; float d0 = 0.f, d1 = 0.f;
    const unsigned voffT = (unsigned)((tid >> 4) * CONV_DIM + (tid & 15) * 8) * 2u, voffX = (unsigned)((tid & 127) * CONV_DIM + (tid >> 7) * 8) * 2u;
#define SCAN_PREFETCH(c_) do { const int r0_ = b * SEQ + (c_) * 128; \
        const char* bB_ = (const char*)(XC + (size_t)r0_ * CONV_DIM + D_INNER + g * 128); const char* bX_ = (const char*)(XC + (size_t)r0_ * CONV_DIM + h * 64); \
        _Pragma("unroll") for (int i = 0; i < 4; ++i) { \
            breg[i] = *(const u32x4*)(bB_ + (size_t)i * (32 * CONV_DIM * 2) + voffT); creg[i] = *(const u32x4*)(bB_ + (size_t)i * (32 * CONV_DIM * 2) + 1024 + voffT); } \
        _Pragma("unroll") for (int i = 0; i < 2; ++i) xreg[i] = *(const u32x4*)(bX_ + i * 64 + voffX); \
        if (w == 0) { d0 = DT[(size_t)(r0_ + 2 * lane) * 32 + h]; d1 = DT[(size_t)(r0_ + 2 * lane + 1) * 32 + h]; } } while (0)
    SCAN_PREFETCH(0);
#pragma unroll 1
    for (int c = 0; c < SEQ / 128; ++c) {
        const int r0 = b * SEQ + c * 128;
        const int hb = (c & 1) * (64 * RS), hn = ((c & 1) ^ 1) * (64 * RS);
        if (w == 0) { const float a0 = d0 * A, a1 = d1 * A; float v = a0 + a1;
#pragma unroll
            for (int o = 1; o < 64; o <<= 1) { const float t = shup(v, lane, o); if (lane >= o) v += t; }
            *(LAS f32x2*)(L + L_DT + lane * 8) = (f32x2){d0, d1}; *(LAS f32x2*)(L + L_AC + lane * 8) = (f32x2){v - a1, v}; }
        __syncthreads();
        const float aend = *(const LAS float*)(L + L_AC + 127 * 4);
#pragma unroll
        for (int i = 0; i < 4; ++i) { *(LAS u32x4*)(pSt + 128 * RS + i * 32 * RS) = breg[i]; *(LAS u32x4*)(pSt + i * 32 * RS) = creg[i]; }
        { const float wj = __expf(aend - *(const LAS float*)(pDj + 512)) * *(const LAS float*)pDj;
#pragma unroll
            for (int i = 0; i < 2; ++i)
#pragma unroll
                for (int e2 = 0; e2 < 4; ++e2) { const unsigned u = xreg[i][e2]; const float x0 = bf_lo(u), x1 = bf_hi(u);
                    const int ro = (i * 32 + e2 * 2) * RS;
                    *(LAS bf16_t*)(pSx + ro) = (bf16_t)(u & 0xffffu); *(LAS bf16_t*)(pSx + ro + RS) = (bf16_t)(u >> 16);
                    const unsigned s = cvt_pk_bf16(x0 * wj, x1 * wj);
                    *(LAS bf16_t*)(pSx + 64 * RS + ro) = (bf16_t)(s & 0xffffu); *(LAS bf16_t*)(pSx + 64 * RS + ro + RS) = (bf16_t)(s >> 16); } }
        const int irow = r0 + 16 * w + fr;
        u32x2 zreg[4];
#pragma unroll
        for (int pt = 0; pt < 4; ++pt) zreg[pt] = *(const u32x2*)(Z + (size_t)irow * D_INNER + h * 64 + pt * 16 + fq * 4);
        __syncthreads();
        u32x2 wpk[8]; float ea;
        {
            bf16x8 cf[4];
#pragma unroll
            for (int ks = 0; ks < 4; ++ks) cf[ks] = LFRAG(pCf, ks * 64);
            const int i = 16 * w + fr; const float aci = *(const LAS float*)pDi; ea = __expf(aci);
#pragma unroll
            for (int j2 = 0; j2 < 4; ++j2) {
                wpk[2 * j2] = (u32x2){0u, 0u}; wpk[2 * j2 + 1] = (u32x2){0u, 0u};
                if (2 * j2 <= w) {
                    f32x4 g0 = (f32x4){0.f, 0.f, 0.f, 0.f}, g1 = (f32x4){0.f, 0.f, 0.f, 0.f};
#pragma unroll
                    for (int ks = 0; ks < 4; ++ks) { g0 = __builtin_amdgcn_mfma_f32_16x16x32_bf16(LFRAG(pBf, (2 * j2) * 16 * RS + ks * 64), cf[ks], g0, 0, 0, 0);
                        g1 = __builtin_amdgcn_mfma_f32_16x16x32_bf16(LFRAG(pBf, (2 * j2 + 1) * 16 * RS + ks * 64), cf[ks], g1, 0, 0, 0); }
#pragma unroll
                    for (int hh = 0; hh < 2; ++hh) { const int jt = 2 * j2 + hh, j0 = jt * 16 + fq * 4; const f32x4 gg = hh ? g1 : g0;
                        const f32x4 dtj = *(const LAS f32x4*)(pDq + jt * 64), acj = *(const LAS f32x4*)(pDq + 512 + jt * 64);
                        float v[4];
#pragma unroll
                        for (int r = 0; r < 4; ++r) v[r] = (j0 + r <= i) ? gg[r] * __expf(aci - acj[r]) * dtj[r] : 0.f;
                        wpk[jt][0] = cvt_pk_bf16(v[0], v[1]); wpk[jt][1] = cvt_pk_bf16(v[2], v[3]); }
                }
                __builtin_amdgcn_sched_barrier(0);
            }
        }
        {
            const float dec = __expf(aend);
#pragma unroll
            for (int pt = 0; pt < 4; ++pt) hacc[pt] = hacc[pt] * dec;
#pragma unroll
            for (int ks = 0; ks < 4; ++ks) { bf16x8 bg;
#pragma unroll
                for (int e = 0; e < 8; ++e) bg[e] = *(const LAS short*)(pBg + (ks * 32 + e) * RS);
#pragma unroll
                for (int pt = 0; pt < 4; ++pt) hacc[pt] = __builtin_amdgcn_mfma_f32_16x16x32_bf16(bg, LFRAG(pXf, 64 * RS + pt * 16 * RS + ks * 64), hacc[pt], 0, 0, 0);
                __builtin_amdgcn_sched_barrier(0); }
        }
        __syncthreads();
#pragma unroll
        for (int jt = 0; jt < 8; ++jt) *(LAS u32x2*)(pWr + jt * 32) = wpk[jt];
#pragma unroll
        for (int pt = 0; pt < 4; ++pt) { u32x2 o; o[0] = cvt_pk_bf16(hacc[pt][0], hacc[pt][1]); o[1] = cvt_pk_bf16(hacc[pt][2], hacc[pt][3]);
            *(LAS u32x2*)(pHw + hn + pt * 16 * RS) = o; }
        __syncthreads();
        if (c + 1 < SEQ / 128) SCAN_PREFETCH(c + 1);
        {
            f32x4 yd[4], yoff[4];
#pragma unroll
            for (int pt = 0; pt < 4; ++pt) { yd[pt] = (f32x4){0.f, 0.f, 0.f, 0.f}; yoff[pt] = (f32x4){0.f, 0.f, 0.f, 0.f}; }
            LAS unsigned char* const pHf = pXf + 2 * 64 * RS + hb;
#pragma unroll
            for (int ks = 0; ks < 4; ++ks) { const bf16x8 cfk = LFRAG(pCf, ks * 64);
#pragma unroll
                for (int pt = 0; pt < 4; ++pt) yoff[pt] = __builtin_amdgcn_mfma_f32_16x16x32_bf16(LFRAG(pHf, pt * 16 * RS + ks * 64), cfk, yoff[pt], 0, 0, 0);
                __builtin_amdgcn_sched_barrier(0); }
#pragma unroll
            for (int ks = 0; ks < 4; ++ks) if (2 * ks <= w) { const bf16x8 wf = LFRAG(pWf, ks * 64);
#pragma unroll
                for (int pt = 0; pt < 4; ++pt) yd[pt] = __builtin_amdgcn_mfma_f32_16x16x32_bf16(LFRAG(pXf, pt * 16 * RS + ks * 64), wf, yd[pt], 0, 0, 0);
                __builtin_amdgcn_sched_barrier(0); }
            float s = 0.f;
#pragma unroll
            for (int pt = 0; pt < 4; ++pt) { const int p0 = pt * 16 + fq * 4;
                float y[4];
#pragma unroll
                for (int r = 0; r < 4; ++r) { const float x = bf1(*(const LAS bf16_t*)(pXe + (pt * 16 + r) * RS)); y[r] = yd[pt][r] + ea * yoff[pt][r] + Dh * x; }
                y[0] *= bf_lo(zreg[pt][0]); y[1] *= bf_hi(zreg[pt][0]); y[2] *= bf_lo(zreg[pt][1]); y[3] *= bf_hi(zreg[pt][1]);
                s += y[0] * y[0] + y[1] * y[1] + y[2] * y[2] + y[3] * y[3];
                u32x2 o; o[0] = cvt_pk_bf16(y[0], y[1]); o[1] = cvt_pk_bf16(y[2], y[3]);
                *(u32x2*)(YG + (size_t)irow * D_INNER + h * 64 + p0) = o; }
            s += shx(s, lane, 16); s += shx(s, lane, 32);
            if (fq == 0 && !dry) atomicAdd(ss2 + irow, fx(s));
        }
    }
#undef SCAN_PREFETCH
    float* so = p.out + O_SSMP + (((size_t)j * BATCH + b) * N_HEADS + h) * 64 * D_STATE;
#pragma unroll
    for (int pt = 0; pt < 4; ++pt) *(f32x4*)(so + (size_t)(pt * 16 + fr) * D_STATE + 16 * w + fq * 4) = hacc[pt];
    __syncthreads();
}

__device__ __forceinline__ void phase_scan(const Params& p, int j, unsigned char* lds, int bid, int G, const int tid, const int dry) {
    for (int u = bid; u < BATCH * N_HEADS; u += G) scan_unit(p, j, (LAS unsigned char*)lds, u, tid, dry);
}

constexpr int D_TOK = 0  , D_YS = 8 * 320 * 4  , D_SDT = D_YS + 8 * 64 * 4  ;
__device__ __forceinline__ void decode_units(const Params& p, int j, LAS unsigned char* L, int bid, int G, const int tid, const int dry) {
    const int lane = tid & 63, w = __builtin_amdgcn_readfirstlane(tid >> 6), pp = tid >> 3, n0 = (tid & 7) * 16;
    const bf16_t* R = (const bf16_t*)(p.ws + WS_XBC); const bf16_t* Z = (const bf16_t*)(p.ws + WS_Z); const float* DT = (const float*)(p.ws + WS_DT);
    bf16_t* YG = (bf16_t*)(p.ws + WS_Y); u64* ss2 = (u64*)(p.ws + WS_SS2) + (size_t)j * T;
    const int NU = DEC_BATCH * N_HEADS;
    f32x4 hv[4], hvn[4]; float raw[8], rawn[8], hist[3], histn[3], cw[5], cwn[5]; float sd = 0.f, sdn = 0.f, zs = 0.f, zsn = 0.f;
#pragma unroll
    for (int i = 0; i < 8; ++i) { raw[i] = 0.f; rawn[i] = 0.f; }
#pragma unroll
    for (int i = 0; i < 3; ++i) { hist[i] = 0.f; histn[i] = 0.f; }
#pragma unroll
    for (int i = 0; i < 5; ++i) { cw[i] = 0.f; cwn[i] = 0.f; }
#define DEC_LOAD(u_, HV, RAW, HIST, CW, SD, ZS) do { const int sb_ = (u_) >> 5, h_ = (u_) & 31, g_ = h_ >> 3, row0_ = TP + sb_ * DEC_SEQ; \
        const float* sp_ = p.state_ssm + ((((size_t)j * DEC_BATCH + sb_) * N_HEADS + h_) * 64 + pp) * D_STATE + n0; \
        _Pragma("unroll") for (int i = 0; i < 4; ++i) HV[i] = *(const f32x4*)(sp_ + 4 * i); \
        if (tid < 320) { const int col_ = tid < 64 ? h_ * 64 + tid : (tid < 192 ? D_INNER + g_ * 128 + (tid - 64) : D_INNER + 512 + g_ * 128 + (tid - 192)); \
            _Pragma("unroll") for (int t = 0; t < 8; ++t) RAW[t] = bf1(R[(size_t)(row0_ + t) * CONV_DIM + col_]); \
            const float* sc_ = p.state_conv + (((size_t)j * DEC_BATCH + sb_) * 3) * CONV_DIM + col_; \
            HIST[0] = sc_[0]; HIST[1] = sc_[CONV_DIM]; HIST[2] = sc_[2 * CONV_DIM]; \
            const float* cw_ = p.ssd_conv_w + (size_t)j * 4 * CONV_DIM + col_; \
            CW[0] = cw_[0]; CW[1] = cw_[CONV_DIM]; CW[2] = cw_[2 * CONV_DIM]; CW[3] = cw_[3 * CONV_DIM]; CW[4] = p.ssd_conv_b[(size_t)j * CONV_DIM + col_]; } \
        if (tid >= 504) SD = DT[(size_t)(row0_ + tid - 504) * 32 + h_]; \
        ZS = bf1(Z[(size_t)(row0_ + w) * D_INNER + h_ * 64 + lane]); } while (0)
    int u = bid;
    if (u < NU) DEC_LOAD(u, hv, raw, hist, cw, sd, zs);
    for (; u < NU; u += G) {
        const int sb = u >> 5, h = u & 31, row0 = TP + sb * DEC_SEQ;
        const float A = -__expf(p.ssd_A_log[j * N_HEADS + h]), Dh = p.ssd_D[j * N_HEADS + h];
        if (tid < 320) { float h3 = hist[0], h2 = hist[1], h1 = hist[2];
#pragma unroll
            for (int t = 0; t < 8; ++t) { const float v = cw[0] * h3 + cw[1] * h2 + cw[2] * h1 + cw[3] * raw[t] + cw[4];
                *(LAS float*)(L + D_TOK + (t * 320 + tid) * 4) = silu_f(v); h3 = h2; h2 = h1; h1 = raw[t]; } }
        if (tid >= 504) { *(LAS float*)(L + D_SDT + (tid - 504) * 4) = sd; *(LAS float*)(L + D_SDT + 32 + (tid - 504) * 4) = __expf(sd * A); }
        __syncthreads();
        if (u + G < NU) DEC_LOAD(u + G, hvn, rawn, histn, cwn, sdn, zsn);
        float part[DEC_SEQ];
#pragma unroll
        for (int t = 0; t < DEC_SEQ; ++t) { LAS unsigned char* const tk = L + D_TOK + t * 1280;
            const float dec = *(const LAS float*)(L + D_SDT + 32 + t * 4), xdt = *(const LAS float*)(tk + pp * 4) * *(const LAS float*)(L + D_SDT + t * 4); float pt = 0.f;
#pragma unroll
            for (int i = 0; i < 4; ++i) { const f32x4 bv = *(const LAS f32x4*)(tk + 256 + (n0 + 4 * i) * 4), cv = *(const LAS f32x4*)(tk + 768 + (n0 + 4 * i) * 4);
                hv[i] = hv[i] * dec + bv * xdt;
                pt += hv[i][0] * cv[0] + hv[i][1] * cv[1] + hv[i][2] * cv[2] + hv[i][3] * cv[3]; }
            part[t] = pt; }
#pragma unroll
        for (int m = 1; m < 8; m <<= 1) {
#pragma unroll
            for (int t = 0; t < DEC_SEQ; ++t) part[t] += shx(part[t], lane, m); }
        if ((tid & 7) == 0) {
#pragma unroll
            for (int t = 0; t < DEC_SEQ; ++t) *(LAS float*)(L + D_YS + (t * 64 + pp) * 4) = part[t]; }
        { float* so = p.out + O_SSMS + ((((size_t)j * DEC_BATCH + sb) * N_HEADS + h) * 64 + pp) * D_STATE + n0;
#pragma unroll
            for (int i = 0; i < 4; ++i) *(f32x4*)(so + 4 * i) = hv[i]; }
        __syncthreads();
        { const int t = w, row = row0 + t; const float y = *(const LAS float*)(L + D_YS + (t * 64 + lane) * 4) + Dh * *(const LAS float*)(L + D_TOK + (t * 320 + lane) * 4);
            const float yg = y * zs;
            YG[(size_t)row * D_INNER + h * 64 + lane] = (bf16_t)(cvt_pk_bf16(yg, 0.f) & 0xffffu);
            float s = yg * yg;
#pragma unroll
            for (int o = 1; o < 64; o <<= 1) s += shx(s, lane, o);
            if (lane == 0 && !dry) atomicAdd(ss2 + row, fx(s)); }
        __syncthreads();
#pragma unroll
        for (int i = 0; i < 4; ++i) hv[i] = hvn[i];
#pragma unroll
        for (int i = 0; i < 8; ++i) raw[i] = rawn[i];
#pragma unroll
        for (int i = 0; i < 3; ++i) hist[i] = histn[i];
#pragma unroll
        for (int i = 0; i < 5; ++i) cw[i] = cwn[i];
        sd = sdn; zs = zsn;
    }
#undef DEC_LOAD
}

__device__ __forceinline__ void sample_fix(const Params& p, int L, int bid, int G, const int tid) {
    const int lane = tid & 63, wid = tid >> 6;
    float* X = (float*)(p.ws + WS_X); bf16_t* XB = (bf16_t*)(p.ws + WS_XB); const float* PART = (const float*)(p.ws + WS_PART);
    u64* ssn = (u64*)(p.ws + WS_SS) + (size_t)(L + 1) * T;
    for (int r = bid * 8 + wid; r < TS; r += G * 8) { const int row = TP + r;
        const float* xo = L == 0 ? p.x_sample + (size_t)r * D_MODEL : X + (size_t)row * D_MODEL;
        f32x4 v[4], ps[4];
#pragma unroll
        for (int i = 0; i < 4; ++i) { v[i] = *(const f32x4*)(xo + i * 256 + lane * 4); ps[i] = (f32x4){0.f, 0.f, 0.f, 0.f}; }
#pragma unroll
        for (int kb = 0; kb < SPLITQ; kb += 4) { f32x4 q[4][4];
#pragma unroll
            for (int i = 0; i < 4; ++i)
#pragma unroll
                for (int k = 0; k < 4; ++k) q[k][i] = *(const f32x4*)(PART + ((size_t)(kb + k) * TS + r) * D_MODEL + i * 256 + lane * 4);
#pragma unroll
            for (int i = 0; i < 4; ++i) ps[i] = (((ps[i] + q[0][i]) + q[1][i]) + q[2][i]) + q[3][i]; }
        float s = 0.f;
#pragma unroll
        for (int i = 0; i < 4; ++i) { const f32x4 x = v[i] + ps[i];
            *(f32x4*)(X + (size_t)row * D_MODEL + i * 256 + lane * 4) = x;
            u32x2 o; o[0] = cvt_pk_bf16(x[0], x[1]); o[1] = cvt_pk_bf16(x[2], x[3]);
            *(u32x2*)(XB + (size_t)row * D_MODEL + i * 256 + lane * 4) = o;
            s += x[0] * x[0] + x[1] * x[1] + x[2] * x[2] + x[3] * x[3]; }
#pragma unroll
        for (int o = 1; o < 64; o <<= 1) s += shx(s, lane, o);
        if (lane == 0) ssn[row] = fx(s); }
}

__device__ __forceinline__ void phase_final(const Params& p, int bid, int G, const int tid) {
    const int lane = tid & 63, wid = tid >> 6;
    const float* X = (const float*)(p.ws + WS_X); const u64* ss = (const u64*)(p.ws + WS_SS) + (size_t)4 * T;
    f32x4 wv[4];
#pragma unroll
    for (int i = 0; i < 4; ++i) wv[i] = *(const f32x4*)(p.final_norm_w + i * 256 + lane * 4);
    const float* PART = (const float*)(p.ws + WS_PART);
    for (int row = bid * 8 + wid; row < T; row += G * 8) { f32x4 v[4];
#pragma unroll
        for (int i = 0; i < 4; ++i) v[i] = *(const f32x4*)(X + (size_t)row * D_MODEL + i * 256 + lane * 4);
        float rstd;
        if (row >= TP) {
            f32x4 ps[4];
#pragma unroll
            for (int i = 0; i < 4; ++i) ps[i] = (f32x4){0.f, 0.f, 0.f, 0.f};
#pragma unroll
            for (int kb = 0; kb < SPLITQ; kb += 4) { f32x4 q[4][4];
#pragma unroll
                for (int i = 0; i < 4; ++i)
#pragma unroll
                    for (int k = 0; k < 4; ++k) q[k][i] = *(const f32x4*)(PART + ((size_t)(kb + k) * TS + (row - TP)) * D_MODEL + i * 256 + lane * 4);
#pragma unroll
                for (int i = 0; i < 4; ++i) ps[i] = (((ps[i] + q[0][i]) + q[1][i]) + q[2][i]) + q[3][i]; }
            float s = 0.f;
#pragma unroll
            for (int i = 0; i < 4; ++i) { v[i] = v[i] + ps[i]; s += v[i][0] * v[i][0] + v[i][1] * v[i][1] + v[i][2] * v[i][2] + v[i][3] * v[i][3]; }
#pragma unroll
            for (int o = 1; o < 64; o <<= 1) s += shx(s, lane, o);
            rstd = rsqrtf(s * (1.f / D_MODEL) + EPS);
        } else rstd = rsqrtf(ssf(ss + row) * (1.f / D_MODEL) + EPS);
#pragma unroll
        for (int i = 0; i < 4; ++i) *(f32x4*)(p.out + (size_t)row * D_MODEL + i * 256 + lane * 4) = v[i] * rstd * wv[i]; }
}

#define XB_TMO      128
#define XB_XCNT(j)  (256  + 64 * (j))
#define XB_XSUB(j)  (1280 + 64 * (j))
#define XB_XGEN(j)  (2304 + 64 * (j))
#define XB_TOP      3328
#define XB_TOPGEN   3392
#define XCD_BAR_WORDS 3456
#define XB_SPIN_CAP (1u << 18)
__device__ __forceinline__ unsigned xb_ld(unsigned* p)              { return __hip_atomic_load(p, __ATOMIC_RELAXED, __HIP_MEMORY_SCOPE_AGENT); }
__device__ __forceinline__ unsigned xb_add(unsigned* p, unsigned v) { return __hip_atomic_fetch_add(p, v, __ATOMIC_RELAXED, __HIP_MEMORY_SCOPE_AGENT); }
__device__ __forceinline__ unsigned xb_xcc_id() { return (unsigned)__builtin_amdgcn_s_getreg((3 << 11) | 20) & 0xFu; }
#define XB_SPIN(cond, bar) do { unsigned _sp = 0; while (cond) { __builtin_amdgcn_s_sleep(1); \
    if ((++_sp & 255u) == 0u) { if (xb_ld(&(bar)[XB_TMO])) break; if (_sp > XB_SPIN_CAP) { atomicAdd(&(bar)[XB_TMO], 1u); break; } } } } while (0)
struct XcdBarrier { unsigned* bar; unsigned x; volatile LAS unsigned* st; };
__device__ __forceinline__ XcdBarrier xcd_barrier_post(unsigned* bar, volatile LAS unsigned* st) {
    XcdBarrier b; b.bar = bar; b.x = xb_xcc_id(); b.st = st;
    if (threadIdx.x == 0) (void)xb_add(&bar[XB_XCNT(b.x)], 1u);
    return b;
}
__device__ __forceinline__ void xcd_barrier_complete(unsigned* bar, unsigned x, unsigned& nloc, unsigned& nx) {
    const unsigned G = gridDim.x * gridDim.y * gridDim.z;
    unsigned sum, cnt, mine, sp = 0u;
    for (;;) {
        sum = 0u; cnt = 0u; mine = 0u;
#pragma unroll
        for (unsigned j = 0; j < 16; ++j) { const unsigned c = xb_ld(&bar[XB_XCNT(j)]); sum += c; cnt += (c > 0u) ? 1u : 0u; }
        if (sum == G) { mine = xb_ld(&bar[XB_XCNT(x)]); break; }
        __builtin_amdgcn_s_sleep(1);
        if ((++sp & 255u) == 0u) { if (xb_ld(&bar[XB_TMO])) break; if (sp > XB_SPIN_CAP) { atomicAdd(&bar[XB_TMO], 1u); break; } }
    }
    nloc = mine > 0u ? mine : 1u; nx = cnt > 0u ? cnt : 1u;
}
__device__ __forceinline__ void xcd_barrier(const XcdBarrier& b, const int tid) {
    asm volatile("s_waitcnt vmcnt(0)" ::: "memory");
    __syncthreads();
    if (tid == 0) {
        unsigned* bar = b.bar;
        __builtin_amdgcn_s_waitcnt(0);
        unsigned nloc = b.st[0], nx = b.st[1];
        if (nloc == 0u) { xcd_barrier_complete(bar, b.x, nloc, nx); b.st[0] = nloc; b.st[1] = nx; }
        const unsigned old = xb_add(&bar[XB_XSUB(b.x)], 1u);
        const unsigned gen = old / nloc;
        if (old + 1u == (gen + 1u) * nloc) {
            __builtin_amdgcn_fence(__ATOMIC_RELEASE, "agent");
            asm volatile("s_waitcnt vmcnt(0)" ::: "memory");
            const unsigned og = xb_add(&bar[XB_TOP], 1u);
            const unsigned tg = og / nx;
            if (og + 1u == (tg + 1u) * nx) xb_add(&bar[XB_TOPGEN], 1u);
            else XB_SPIN(xb_ld(&bar[XB_TOPGEN]) == tg, bar);
            __builtin_amdgcn_fence(__ATOMIC_ACQUIRE, "agent");
            xb_add(&bar[XB_XGEN(b.x)], 1u);
            asm volatile("s_waitcnt vmcnt(0)" ::: "memory");
        } else {
            XB_SPIN(xb_ld(&bar[XB_XGEN(b.x)]) == gen, bar);
            __builtin_amdgcn_fence(__ATOMIC_ACQUIRE, "agent");
            asm volatile("s_waitcnt vmcnt(0)" ::: "memory");
        }
    }
    __syncthreads();
}

constexpr int N_PHASES = 18;
#ifndef PH_MASK
#define PH_MASK 0x1ff
#endif
#define PH_ON(k) ((PH_MASK >> (k)) & 1)
#ifndef REP_MASK
#define REP_MASK 0
#endif
#define NREP(k) (((REP_MASK >> (k)) & 1) ? 2 : 1)
#define FRESH_TID(name) int name##_z = 0; asm volatile("" : "+v"(name##_z)); const int name = wid_s * 64 + (int)__builtin_amdgcn_mbcnt_hi(~0u, __builtin_amdgcn_mbcnt_lo(~0u, (unsigned)name##_z))
__global__ void __launch_bounds__(NTHREADS, 2) fwd_kernel(Params pin) {
    extern __shared__ __attribute__((aligned(16))) unsigned char shm[];
    volatile LAS unsigned* bst = (volatile LAS unsigned*)(LAS unsigned char*)(shm + LDS_STAGE);
    if (threadIdx.x == 0) { bst[0] = 0u; bst[1] = 0u; }
    __syncthreads();
    const XcdBarrier xbar = xcd_barrier_post((unsigned*)(pin.ws + WS_CTL), bst);
    const int wid_s = __builtin_amdgcn_readfirstlane((int)threadIdx.x >> 6);
    if (pin.ph_lo == 0) {
        const int bid = (int)blockIdx.x, G = (int)gridDim.x, tid = (int)threadIdx.x;
        if (PH_ON(0)) for (int rep = 0; rep < NREP(0); ++rep) phase_prep(pin, (unsigned char*)shm, bid, G, tid);
        if (pin.ph_hi > 1000) cg::this_grid().sync();
        else if (pin.ph_hi > 1) xcd_barrier(xbar, tid);
    }
    for (int ph = pin.ph_lo > 1 ? pin.ph_lo : 1; ph < pin.ph_hi; ++ph) {
        int sz = 0; asm volatile("" : "+s"(sz));
        const int bid = (int)blockIdx.x + sz, G = (int)gridDim.x + sz;
        Params p = pin; p.ws = pin.ws + sz; p.out = pin.out + sz;
        unsigned lb = (unsigned)(size_t)(LAS unsigned char*)shm; asm volatile("" : "+s"(lb));
        LAS unsigned char* const lds3 = (LAS unsigned char*)(size_t)lb; unsigned char* const ldsg = (unsigned char*)lds3;
        if (false) {}
        else if (ph == N_PHASES - 1) { if (PH_ON(1)) { FRESH_TID(t1); for (int rep = 0; rep < NREP(1); ++rep) phase_final(p, bid, G, t1); } }
        else {
            const int L = (ph - 1) >> 2, sub = (ph - 1) & 3, j = L >> 1; const bool ssd = L & 1;
            u64* SS = (u64*)(p.ws + WS_SS);
            if (sub == 0) {
                pg8::Sched S;
                if (!ssd) { if (PH_ON(2)) { S.init(NPANEL, 16, G, bid, 0, 16, 0);
                    pg8::Gemm g{(const bf16_t*)(p.ws + WS_XB), (const bf16_t*)(p.ws + WS_WPIN) + (size_t)j * 4096 * 1024, T, 4096, 1024};
                    pg8::EpiPoolIn E{(bf16_t*)(p.ws + WS_U), (bf16_t*)(p.ws + WS_Z), SS + (size_t)L * T};
                    FRESH_TID(t2); for (int rep = 0; rep < NREP(2); ++rep) pg8::gemm_phase(lds3, g, S, E, t2);
                    if (L == 0 && G > 64 && bid >= 64) prep_weights(p, ldsg, bid - 64, G - 64, t2, W_FIRST, G > 148 ? W_PER : -1); }
                } else if (PH_ON(3)) { S.init(NPANEL, SSD_IN_PAD / 256, G, bid, 0, 16, 0);
                    pg8::Gemm g{(const bf16_t*)(p.ws + WS_XB), (const bf16_t*)(p.ws + WS_WSIN) + (size_t)j * SSD_IN_PAD * 1024, T, SSD_IN_PAD, 1024};
                    pg8::EpiSsdIn E{(bf16_t*)(p.ws + WS_Z), (bf16_t*)(p.ws + WS_XBC), (float*)(p.ws + WS_DT), SS + (size_t)L * T, p.ssd_dt_bias + j * N_HEADS};
                    FRESH_TID(t3); for (int rep = 0; rep < NREP(3); ++rep) pg8::gemm_phase(lds3, g, S, E, t3);
                    if (L == 1 && G > 148 && bid >= 148) prep_weights(p, ldsg, bid - 148, G - 148, t3, W_PER, -1);
                }
            } else if (sub == 1) {
                if (!ssd) { if (PH_ON(4)) { FRESH_TID(t4); for (int rep = 0; rep < NREP(4); ++rep) phase_pool(p, j, bid, G, t4); } } else if (PH_ON(5)) { FRESH_TID(t5); for (int rep = 0; rep < NREP(5); ++rep) { phase_conv(p, j, bid, G, t5); decode_units(p, j, lds3, bid, G, t5, rep); } }
            } else if (sub == 2) {
                if (!ssd) { if (PH_ON(6)) { pg8::Sched S; S.init(NPANEL, 8, G, bid, 1, 8, 0);
                    pg8::Gemm g{(const bf16_t*)(p.ws + WS_P), (const bf16_t*)(p.ws + WS_WMIX) + (size_t)j * 2048 * 512, 4 * T, 2048, 512};
                    pg8::EpiPoolMix E{(bf16_t*)(p.ws + WS_Y), (const bf16_t*)(p.ws + WS_Z), p.pool_scale + j * D_INNER};
                    FRESH_TID(t6); for (int rep = 0; rep < NREP(6); ++rep) pg8::gemm_phase(lds3, g, S, E, t6); }
                } else if (PH_ON(7)) { FRESH_TID(t7); for (int rep = 0; rep < NREP(7); ++rep) phase_scan(p, j, ldsg, bid, G, t7, rep); }
            } else if (PH_ON(8)) {
                pg8::Sched S; S.init(64, 4, G, bid, 0, 32, 1);
                const bf16_t* Wt = ssd ? (const bf16_t*)(p.ws + WS_WSOUT) + (size_t)j * 1024 * 2048 : (const bf16_t*)(p.ws + WS_WPOUT) + (size_t)j * 1024 * 2048;
                pg8::Gemm g{(const bf16_t*)(p.ws + WS_Y), Wt, T, 1024, 2048};
                float* X = (float*)(p.ws + WS_X);
                pg8::EpiOut E{L == 0 ? p.x_prompt : X, L == 0 ? p.x_sample : X + (size_t)TP * D_MODEL, X, (bf16_t*)(p.ws + WS_XB), SS + (size_t)(L + 1) * T,
                              ssd ? (const u64*)(p.ws + WS_SS2) + (size_t)j * T : nullptr, 0, (float*)(p.ws + WS_PART)};
                FRESH_TID(t8); for (int rep = 0; rep < NREP(8); ++rep) { E.dry = rep; pg8::gemm_phase(lds3, g, S, E, t8); }
                if (L < 3) { xcd_barrier(xbar, t8); sample_fix(p, L, bid, G, t8); }
            }
        }
        if (ph + 1 < pin.ph_hi) { int tz2 = 0; asm volatile("" : "+v"(tz2));
            xcd_barrier(xbar, wid_s * 64 + (int)__builtin_amdgcn_mbcnt_hi(~0u, __builtin_amdgcn_mbcnt_lo(~0u, (unsigned)tz2))); }
    }
}

extern "C" void kernel_launch(void* const* d_in, const int* in_sizes, int n_in, void* d_out, int out_size, void* d_ws, size_t ws_size, hipStream_t stream) {
    static int grid = 0;
    if (grid == 0) {
        if (n_in != 19 || ws_size < WS_END) { fprintf(stderr, "kernel_launch: unexpected n_in %d / ws_size %zu (need %zu)\n", n_in, ws_size, (size_t)WS_END); grid = -1; return; }
        if (hipFuncSetAttribute((const void*)fwd_kernel, hipFuncAttributeMaxDynamicSharedMemorySize, LDS_BYTES) != hipSuccess) { fprintf(stderr, "kernel_launch: hipFuncSetAttribute failed\n"); grid = -1; return; }
        int dev = 0, cus = 0, per_cu = 0;
        hipGetDevice(&dev); hipDeviceGetAttribute(&cus, hipDeviceAttributeMultiprocessorCount, dev);
        hipOccupancyMaxActiveBlocksPerMultiprocessor(&per_cu, (const void*)fwd_kernel, NTHREADS, LDS_BYTES);
        (void)hipGetLastError();
        if (per_cu < 1) per_cu = 1;
        grid = cus;
    }
    if (grid < 0) return;
    Params p{};
    const float** f = (const float**)&p;
    for (int i = 0; i < 19; ++i) f[i] = (const float*)d_in[i];
    p.out = (float*)d_out; p.ws = (unsigned char*)d_ws;
    if (hipMemsetAsync((char*)d_ws + WS_CTL, 0, 16384, stream) != hipSuccess) { fprintf(stderr, "kernel_launch: memset failed\n"); return; }
#if MK_MULTI
    for (int ph = 0; ph < N_PHASES; ++ph) { p.ph_lo = ph; p.ph_hi = ph + 1; hipLaunchKernelGGL(fwd_kernel, dim3(grid), dim3(NTHREADS), LDS_BYTES, stream, p); }
#else
    p.ph_lo = 0; p.ph_hi = N_PHASES;
    void* args[] = {&p};
    hipError_t e = hipLaunchCooperativeKernel((const void*)fwd_kernel, dim3(grid), dim3(NTHREADS), args, LDS_BYTES, stream);
    if (e != hipSuccess) fprintf(stderr, "cooperative launch failed: %s (grid %d)\n", hipGetErrorString(e), grid);
#endif
}
```

```cpp
#include <hip/hip_runtime.h>
#include <hip/hip_cooperative_groups.h>
#include <cstdio>
#include <cstdint>
namespace cg = cooperative_groups;

#ifndef SPLITQ
#define SPLITQ 8
#endif
#ifndef MK_MULTI
#define MK_MULTI 0
#endif

constexpr int D_MODEL = 1024, BATCH = 8, SEQ = 2048, DEC_BATCH = 128, DEC_SEQ = 8;
constexpr int D_INNER = 2048, POOL_BUF = 15, N_HEADS = 32, D_STATE = 128, CONV_DIM = 3072, SSD_IN = 5152;
constexpr int TP = BATCH * SEQ;
constexpr int TS = DEC_BATCH * DEC_SEQ;
constexpr int T = TP + TS;
constexpr int NPANEL = T / 256;
constexpr int SSD_IN_PAD = 5376;
constexpr float EPS = 1e-6f;

constexpr size_t O_YP = 0, O_YS = O_YP + (size_t)TP * D_MODEL, O_POOLP = O_YS + (size_t)TS * D_MODEL,
                 O_POOLS = O_POOLP + (size_t)2 * BATCH * POOL_BUF * D_INNER, O_CONVP = O_POOLS + (size_t)2 * DEC_BATCH * POOL_BUF * D_INNER,
                 O_CONVS = O_CONVP + (size_t)2 * BATCH * 3 * CONV_DIM, O_SSMP = O_CONVS + (size_t)2 * DEC_BATCH * 3 * CONV_DIM,
                 O_SSMS = O_SSMP + (size_t)2 * BATCH * N_HEADS * 64 * D_STATE;

constexpr size_t al(size_t x) { return (x + 4095) & ~(size_t)4095; }
constexpr size_t WS_CTL = 0;
constexpr size_t WS_SS = 16384;
constexpr size_t WS_SS2 = al(WS_SS + (size_t)5 * T * 8);
constexpr size_t WS_WPIN = al(WS_SS2 + (size_t)2 * T * 8);
constexpr size_t WS_WMIX = al(WS_WPIN + (size_t)2 * 4096 * 1024 * 2);
constexpr size_t WS_WPOUT = al(WS_WMIX + (size_t)2 * 2048 * 512 * 2);
constexpr size_t WS_WSIN = al(WS_WPOUT + (size_t)2 * 1024 * 2048 * 2);
constexpr size_t WS_WSOUT = al(WS_WSIN + (size_t)2 * SSD_IN_PAD * 1024 * 2);
constexpr size_t WS_X = al(WS_WSOUT + (size_t)2 * 1024 * 2048 * 2);
constexpr size_t WS_XB = al(WS_X + (size_t)T * 1024 * 4);
constexpr size_t WS_U = al(WS_XB + (size_t)T * 1024 * 2);
constexpr size_t WS_Z = al(WS_U + (size_t)T * 2048 * 2);
constexpr size_t WS_P = al(WS_Z + (size_t)T * 2048 * 2);
constexpr size_t WS_Y = al(WS_P + (size_t)T * 2048 * 2);
constexpr size_t WS_XBC = al(WS_Y + (size_t)T * 2048 * 2);
constexpr size_t WS_XBCC = al(WS_XBC + (size_t)T * 3072 * 2);
constexpr size_t WS_DT = al(WS_XBCC + (size_t)T * 3072 * 2);
constexpr size_t WS_PART = al(WS_DT + (size_t)T * 32 * 4);
constexpr size_t WS_END = al(WS_PART + (size_t)8 * TS * 1024 * 4);

constexpr int LDS_STAGE = 131072 + 20480;
constexpr int LDS_BYTES = LDS_STAGE + 64;
constexpr int NTHREADS = 512;

typedef unsigned short bf16_t;
typedef short bf16x8 __attribute__((ext_vector_type(8)));
typedef float f32x4 __attribute__((ext_vector_type(4)));
typedef float f32x2 __attribute__((ext_vector_type(2)));
typedef unsigned u32x4 __attribute__((ext_vector_type(4)));
typedef unsigned u32x2 __attribute__((ext_vector_type(2)));

struct Params {
    const float *x_prompt, *x_sample, *state_pool, *state_conv, *state_ssm, *norm_w, *pool_in_w, *pool_mix_w, *pool_scale, *pool_out_w,
        *ssd_in_w, *ssd_conv_w, *ssd_conv_b, *ssd_dt_bias, *ssd_A_log, *ssd_D, *ssd_norm_w, *ssd_out_w, *final_norm_w;
    float* out;
    unsigned char* ws;
    int ph_lo, ph_hi;
};

__device__ __forceinline__ unsigned cvt_pk_bf16(float lo, float hi) { unsigned r; asm volatile("v_cvt_pk_bf16_f32 %0, %1, %2" : "=v"(r) : "v"(lo), "v"(hi)); return r; }
__device__ __forceinline__ float bf_lo(unsigned u) { return __uint_as_float(u << 16); }
__device__ __forceinline__ float bf_hi(unsigned u) { return __uint_as_float(u & 0xffff0000u); }
__device__ __forceinline__ float bf1(bf16_t b) { return __uint_as_float(((unsigned)b) << 16); }
__device__ __forceinline__ float shx(float v, int lane, int m) { return __int_as_float(__builtin_amdgcn_ds_bpermute((lane ^ m) << 2, __float_as_int(v))); }
__device__ __forceinline__ float shup(float v, int lane, int d) { const int src = lane >= d ? lane - d : lane; return __int_as_float(__builtin_amdgcn_ds_bpermute(src << 2, __float_as_int(v))); }
typedef unsigned long long u64;
__device__ __forceinline__ u64 fx(float s) { const unsigned hi = (unsigned)s; const unsigned lo = (unsigned)((s - (float)hi) * 4294967296.f); return ((u64)hi << 32) | lo; }
__device__ __forceinline__ float ssf(const u64* p) { const u64 v = *p; return (float)(unsigned)(v >> 32) + (float)(unsigned)v * 2.3283064365386963e-10f; }
__device__ __forceinline__ float silu_f(float v) { return v * __builtin_amdgcn_rcpf(1.f + __expf(-v)); }
__device__ __forceinline__ float softplus_f(float v) { return fmaxf(v, 0.f) + __logf(1.f + __expf(-fabsf(v))); }

namespace pg8 {
#define PG8_LAS __attribute__((address_space(3)))
constexpr int BM = 256, BK = 64, HALF = 128, HTB = HALF * BK * 2, STAGE_BYTES = 8 * HTB, NXCD = 8, WGM = 8;
__host__ __device__ __forceinline__ int lds_byte(int r, int c) { const int st = (r >> 4) * 2 + (c >> 5), rr = r & 15, cc = c & 31, ob = rr * 64 + cc * 2; return st * 1024 + (ob ^ (((ob >> 9) & 1) << 5)); }
__host__ __device__ __forceinline__ void stage_rc(int b, int& R, int& C) { const int st = b / 1024, sb = b % 1024, swz = sb ^ (((sb >> 9) & 1) << 5); R = (st >> 1) * 16 + swz / 64; C = (st & 1) * 32 + (swz % 64) / 2; }
__host__ __device__ __forceinline__ int perm32(int rho) { const int n = rho >> 4, i = rho & 15; return 8 * (i >> 2) + 4 * n + (i & 3); }

struct Unit { int pm, pn, kofs, nt; };
struct Gemm { const bf16_t* A; const bf16_t* Bt; int M, N, K; };

struct Sched {
    int nM, nN, nwg, G, c, grouped, ntf, split;
    __device__ void init(int nM_, int nN_, int G_, int c_, int grouped_, int ntf_, int split_) { nM = nM_; nN = nN_; nwg = nM * nN + (split_ ? 16 * SPLITQ : 0); G = G_; c = c_; grouped = grouped_; ntf = ntf_; split = split_; }
    __device__ bool next(int i, Unit& u) const {
        const long L = (long)i * G + c; if (L >= nwg) return false;
        const int nfull = nM * nN;
        if (L >= nfull) { const int idx = (int)L - nfull, tile = idx / SPLITQ, q = idx % SPLITQ; u.pm = 64 + (tile >> 2); u.pn = tile & 3; u.kofs = q * (ntf / SPLITQ) * BK * 2; u.nt = ntf / SPLITQ; return true; }
        int wgid = (int)L; { const int q = nfull / NXCD, r = nfull % NXCD, xcd = wgid % NXCD, off = wgid / NXCD; wgid = (xcd < r ? xcd * (q + 1) : r * (q + 1) + (xcd - r) * q) + off; }
        const int nig = WGM * nN, gid = wgid / nig, fm = gid * WGM, gsz = (nM - fm) < WGM ? (nM - fm) : WGM;
        u.pm = fm + ((wgid % nig) % gsz); u.pn = (wgid % nig) / gsz; u.kofs = 0; u.nt = ntf;
        if (grouped) u.pm += (u.pn >> 1) * NPANEL;
        return true;
    }
    __device__ __forceinline__ void a_ready(const Unit&) const {}
    __device__ __forceinline__ void done(const Unit&) const {}
};

template <class Epi, class Sch>
__device__ __forceinline__ void gemm_phase(PG8_LAS unsigned char* lds, const Gemm g, const Sch& S, const Epi& E, const int tid) {
    const int wid = __builtin_amdgcn_readfirstlane(tid >> 6), lane = tid & 63, wr = wid >> 2, wc = wid & 3, fr = lane & 15, fq = lane >> 4;
    const int K = g.K;
    unsigned voffA[2], voffB[2];
#pragma unroll
    for (int i = 0; i < 2; ++i) { int R, C; stage_rc(tid * 16 + i * 8192, R, C); const int Rb = Epi::PERM ? ((R & ~31) + perm32(R & 31)) : R;
        voffA[i] = (unsigned)(R * K + C) * 2u; voffB[i] = (unsigned)(Rb * K + C) * 2u; }
    const size_t kstep = (size_t)(BK * 2);
    const size_t hstep = (size_t)HALF * K * 2;
    const size_t tstep = 2 * hstep;
    const unsigned ldsw = (unsigned)wid * 1024u;
    const int aoff = lds_byte(wr * 64 + fr, fq * 8), boff = lds_byte(wc * 32 + fr, fq * 8);
#define PG8_SA(b, h) (((b) * 2 + (h)) * HTB)
#define PG8_SB(b, h) ((4 + (b) * 2 + (h)) * HTB)
#define PG8_STAGE(bufoff, gbase, voff) do { _Pragma("unroll") for (int _i = 0; _i < 2; ++_i) \
        __builtin_amdgcn_global_load_lds((const unsigned*)((const char*)(gbase) + (voff)[_i]), (PG8_LAS unsigned*)(lds + (bufoff) + ldsw + _i * 8192), 16, 0, 0); } while (0)
#define PG8_LDA(dst, b, h) do { _Pragma("unroll") for (int m = 0; m < 4; ++m) _Pragma("unroll") for (int k = 0; k < 2; ++k) dst[m][k] = *(const PG8_LAS bf16x8*)(lds + PG8_SA(b, h) + aoff + m * 2048 + k * 1024); } while (0)
#define PG8_LDB(dst, b, h) do { _Pragma("unroll") for (int n = 0; n < 2; ++n) _Pragma("unroll") for (int k = 0; k < 2; ++k) dst[n][k] = *(const PG8_LAS bf16x8*)(lds + PG8_SB(b, h) + boff + n * 2048 + k * 1024); } while (0)
#define PG8_MMA(ai, bj, At, Bt) do { __builtin_amdgcn_s_setprio(1); _Pragma("unroll") for (int m = 0; m < 4; ++m) _Pragma("unroll") for (int n = 0; n < 2; ++n) _Pragma("unroll") for (int k = 0; k < 2; ++k) \
        acc[ai][bj][m][n] = __builtin_amdgcn_mfma_f32_16x16x32_bf16(Bt[n][k], At[m][k], acc[ai][bj][m][n], 0, 0, 0); __builtin_amdgcn_s_setprio(0); } while (0)
#define PG8_WAIT_V(n) asm volatile("s_waitcnt vmcnt(" #n ")" ::: "memory")
#define PG8_WAIT_L(n) asm volatile("s_waitcnt lgkmcnt(" #n ")" ::: "memory")
#define PG8_BAR __builtin_amdgcn_s_barrier()
#define PG8_SCHED __builtin_amdgcn_sched_barrier(0)
    Unit cur, nxt; int ui = 0;
    if (!S.next(0, cur)) return;
    f32x4 acc[2][2][4][2];
#pragma unroll
    for (int a = 0; a < 2; ++a)
#pragma unroll
        for (int b = 0; b < 2; ++b)
#pragma unroll
            for (int m = 0; m < 4; ++m)
#pragma unroll
                for (int n = 0; n < 2; ++n) acc[a][b][m][n] = (f32x4){0.f, 0.f, 0.f, 0.f};
    bf16x8 At[4][2], B0[2][2], B1[2][2];
    const char* cA = (const char*)g.A + (size_t)cur.pm * tstep + cur.kofs; const char* cB = (const char*)g.Bt + (size_t)cur.pn * tstep + cur.kofs;
    int nt = cur.nt;
    S.a_ready(cur);
    PG8_STAGE(PG8_SB(0, 0), cB, voffB); PG8_STAGE(PG8_SA(0, 0), cA, voffA); PG8_STAGE(PG8_SB(0, 1), cB + hstep, voffB); PG8_STAGE(PG8_SA(0, 1), cA + hstep, voffA);
    if (wr == 1) PG8_BAR;
    PG8_WAIT_V(4); PG8_BAR;
    PG8_STAGE(PG8_SB(1, 0), cB + kstep, voffB); PG8_STAGE(PG8_SA(1, 0), cA + kstep, voffA); PG8_STAGE(PG8_SB(1, 1), cB + hstep + kstep, voffB);
    PG8_WAIT_V(6); PG8_BAR;
    for (;;) {
        const bool has_next = S.next(ui + 1, nxt);
        const char* nA = has_next ? (const char*)g.A + (size_t)nxt.pm * tstep + nxt.kofs : cA; const char* nB = has_next ? (const char*)g.Bt + (size_t)nxt.pn * tstep + nxt.kofs : cB;
        for (int t = 0; t < nt; t += 2) {
            const bool last = (t == nt - 2);
            const char* a1 = cA + (size_t)(t + 1) * kstep;
            const char* a2 = last ? nA : cA + (size_t)(t + 2) * kstep; const char* b2 = last ? nB : cB + (size_t)(t + 2) * kstep;
            const char* a3 = a2 + kstep; const char* b3 = b2 + kstep;
            if (last && has_next) S.a_ready(nxt);
            PG8_LDB(B0, 0, 0); PG8_SCHED; PG8_LDA(At, 0, 0); PG8_STAGE(PG8_SA(1, 1), a1 + hstep, voffA);
            PG8_WAIT_L(8); PG8_BAR; PG8_WAIT_L(0); PG8_MMA(0, 0, At, B0); PG8_BAR; PG8_SCHED;
            PG8_LDB(B1, 0, 1); PG8_STAGE(PG8_SB(0, 0), b2, voffB);
            PG8_BAR; PG8_WAIT_L(0); PG8_MMA(0, 1, At, B1); PG8_BAR;
            PG8_LDA(At, 0, 1); PG8_STAGE(PG8_SA(0, 0), a2, voffA);
            PG8_BAR; PG8_WAIT_L(0); PG8_MMA(1, 0, At, B0); PG8_BAR; PG8_SCHED;
            PG8_STAGE(PG8_SB(0, 1), b2 + hstep, voffB);
            PG8_WAIT_V(6); PG8_BAR; PG8_MMA(1, 1, At, B1); PG8_BAR;
            PG8_LDB(B0, 1, 0); PG8_SCHED; PG8_LDA(At, 1, 0); PG8_STAGE(PG8_SA(0, 1), a2 + hstep, voffA);
            PG8_WAIT_L(8); PG8_BAR; PG8_WAIT_L(0); PG8_MMA(0, 0, At, B0); PG8_BAR; PG8_SCHED;
            PG8_LDB(B1, 1, 1); PG8_STAGE(PG8_SB(1, 0), b3, voffB);
            PG8_BAR; PG8_WAIT_L(0); PG8_MMA(0, 1, At, B1); PG8_BAR;
            PG8_LDA(At, 1, 1); PG8_STAGE(PG8_SA(1, 0), a3, voffA);
            PG8_BAR; PG8_WAIT_L(0); PG8_MMA(1, 0, At, B0); PG8_BAR; PG8_SCHED;
            PG8_STAGE(PG8_SB(1, 1), b3 + hstep, voffB);
            PG8_WAIT_V(6); PG8_BAR; PG8_MMA(1, 1, At, B1); PG8_BAR;
        }
        E(acc, cur, wr, wc, fr, fq); S.done(cur);
        if (!has_next) break;
#pragma unroll
        for (int a = 0; a < 2; ++a)
#pragma unroll
            for (int b = 0; b < 2; ++b)
#pragma unroll
                for (int m = 0; m < 4; ++m)
#pragma unroll
                    for (int n = 0; n < 2; ++n) acc[a][b][m][n] = (f32x4){0.f, 0.f, 0.f, 0.f};
        cur = nxt; cA = nA; cB = nB; nt = cur.nt; ++ui;
    }
    PG8_WAIT_V(0);
    if (wr == 0) PG8_BAR;
    PG8_BAR;
#undef PG8_SA
#undef PG8_SB
#undef PG8_STAGE
#undef PG8_LDA
#undef PG8_LDB
#undef PG8_MMA
#undef PG8_WAIT_V
#undef PG8_WAIT_L
#undef PG8_BAR
#undef PG8_SCHED
}

struct EpiPoolIn {
    static constexpr bool PERM = true;
    bf16_t* U; bf16_t* Z; const u64* ss;
    __device__ __forceinline__ void operator()(const f32x4 (&acc)[2][2][4][2], const Unit& u, int wr, int wc, int fr, int fq) const {
        const int row0 = u.pm * BM + wr * 64 + fr; const bool isz = u.pn >= 8; bf16_t* base = isz ? Z : U;
        const int col0 = (u.pn & 7) * BM + wc * 32 + 8 * fq;
        float rs[2][4];
#pragma unroll
        for (int ai = 0; ai < 2; ++ai)
#pragma unroll
            for (int m = 0; m < 4; ++m) rs[ai][m] = ssf(ss + row0 + ai * HALF + m * 16);
#pragma unroll
        for (int ai = 0; ai < 2; ++ai)
#pragma unroll
            for (int m = 0; m < 4; ++m) { const int row = row0 + ai * HALF + m * 16; const float rstd = rsqrtf(rs[ai][m] * (1.f / D_MODEL) + EPS);
                bf16_t* rowp = base + (size_t)row * D_INNER + col0;
#pragma unroll
                for (int bj = 0; bj < 2; ++bj) { f32x4 v0 = acc[ai][bj][m][0] * rstd, v1 = acc[ai][bj][m][1] * rstd;
                    if (isz) { v0[0] = silu_f(v0[0]); v0[1] = silu_f(v0[1]); v0[2] = silu_f(v0[2]); v0[3] = silu_f(v0[3]); v1[0] = silu_f(v1[0]); v1[1] = silu_f(v1[1]); v1[2] = silu_f(v1[2]); v1[3] = silu_f(v1[3]); }
                    u32x4 o; o[0] = cvt_pk_bf16(v0[0], v0[1]); o[1] = cvt_pk_bf16(v0[2], v0[3]); o[2] = cvt_pk_bf16(v1[0], v1[1]); o[3] = cvt_pk_bf16(v1[2], v1[3]);
                    *(u32x4*)(rowp + bj * HALF) = o; } }
    }
};
struct EpiPoolMix {
    static constexpr bool PERM = true;
    bf16_t* Y; const bf16_t* Z; const float* scale;
    __device__ __forceinline__ void operator()(const f32x4 (&acc)[2][2][4][2], const Unit& u, int wr, int wc, int fr, int fq) const {
        const int pm = u.pm - (u.pn >> 1) * NPANEL;
        const int row0 = pm * BM + wr * 64 + fr; const int col0 = u.pn * BM + wc * 32 + 8 * fq;
        f32x4 sc[2][2];
#pragma unroll
        for (int bj = 0; bj < 2; ++bj) { sc[bj][0] = *(const f32x4*)(scale + col0 + bj * HALF); sc[bj][1] = *(const f32x4*)(scale + col0 + bj * HALF + 4); }
#pragma unroll
        for (int ai = 0; ai < 2; ++ai) {
            u32x4 zz[4][2];
#pragma unroll
            for (int m = 0; m < 4; ++m)
#pragma unroll
                for (int bj = 0; bj < 2; ++bj) zz[m][bj] = *(const u32x4*)(Z + (size_t)(row0 + ai * HALF + m * 16) * D_INNER + col0 + bj * HALF);
#pragma unroll
            for (int m = 0; m < 4; ++m) { const size_t ro = (size_t)(row0 + ai * HALF + m * 16) * D_INNER + col0;
#pragma unroll
                for (int bj = 0; bj < 2; ++bj) { const u32x4 z4 = zz[m][bj];
                    f32x4 v0 = acc[ai][bj][m][0] * sc[bj][0], v1 = acc[ai][bj][m][1] * sc[bj][1];
                    v0[0] *= bf_lo(z4[0]); v0[1] *= bf_hi(z4[0]); v0[2] *= bf_lo(z4[1]); v0[3] *= bf_hi(z4[1]);
                    v1[0] *= bf_lo(z4[2]); v1[1] *= bf_hi(z4[2]); v1[2] *= bf_lo(z4[3]); v1[3] *= bf_hi(z4[3]);
                    u32x4 o; o[0] = cvt_pk_bf16(v0[0], v0[1]); o[1] = cvt_pk_bf16(v0[2], v0[3]); o[2] = cvt_pk_bf16(v1[0], v1[1]); o[3] = cvt_pk_bf16(v1[2], v1[3]);
                    *(u32x4*)(Y + ro + bj * HALF) = o; } } }
    }
};
struct EpiOut {
    static constexpr bool PERM = false;
    const float* xin_p; const float* xin_s;
    float* X; bf16_t* XB; u64* ssn; const u64* ss2; int dry; float* PART;
    __device__ __forceinline__ void operator()(const f32x4 (&acc)[2][2][4][2], const Unit& u, int wr, int wc, int fr, int fq) const {
        const int row0 = u.pm * BM + wr * 64 + fr, col0 = u.pn * BM + wc * 32 + 4 * fq;
        if (u.pm >= 64) {
            float* dst = PART + (size_t)(u.kofs / (u.nt * BK * 2)) * TS * D_MODEL;
            float r2[2][4];
#pragma unroll
            for (int ai = 0; ai < 2; ++ai)
#pragma unroll
                for (int m = 0; m < 4; ++m) r2[ai][m] = ss2 ? ssf(ss2 + row0 + ai * HALF + m * 16) : 0.f;
#pragma unroll
            for (int ai = 0; ai < 2; ++ai)
#pragma unroll
                for (int m = 0; m < 4; ++m) { const int row = row0 + ai * HALF + m * 16; const float rr = ss2 ? rsqrtf(r2[ai][m] * (1.f / D_INNER) + EPS) : 1.f;
#pragma unroll
                    for (int bj = 0; bj < 2; ++bj)
#pragma unroll
                        for (int n = 0; n < 2; ++n) *(f32x4*)(dst + (size_t)(row - TP) * D_MODEL + col0 + bj * HALF + n * 16) = acc[ai][bj][m][n] * rr; }
            return;
        }
#pragma unroll
        for (int ai = 0; ai < 2; ++ai)
#pragma unroll
            for (int mp = 0; mp < 2; ++mp) {
                f32x4 xv[2][2][2]; float r2[2];
#pragma unroll
                for (int mm = 0; mm < 2; ++mm) { const int row = row0 + ai * HALF + (2 * mp + mm) * 16;
                    const float* xo = (row < TP ? xin_p + (size_t)row * D_MODEL : xin_s + (size_t)(row - TP) * D_MODEL) + col0;
                    r2[mm] = ss2 ? ssf(ss2 + row) : 0.f;
#pragma unroll
                    for (int bj = 0; bj < 2; ++bj)
#pragma unroll
                        for (int n = 0; n < 2; ++n) xv[mm][bj][n] = *(const f32x4*)(xo + bj * HALF + n * 16); }
#pragma unroll
                for (int mm = 0; mm < 2; ++mm) { const int m = 2 * mp + mm, row = row0 + ai * HALF + m * 16;
                    const float rr = ss2 ? rsqrtf(r2[mm] * (1.f / D_INNER) + EPS) : 1.f;
                    float s = 0.f;
#pragma unroll
                    for (int bj = 0; bj < 2; ++bj)
#pragma unroll
                        for (int n = 0; n < 2; ++n) { const int co = bj * HALF + n * 16;
                            const f32x4 v = xv[mm][bj][n] + acc[ai][bj][m][n] * rr;
                            if (!dry) { *(f32x4*)(X + (size_t)row * D_MODEL + col0 + co) = v;
                                u32x2 o; o[0] = cvt_pk_bf16(v[0], v[1]); o[1] = cvt_pk_bf16(v[2], v[3]);
                                *(u32x2*)(XB + (size_t)row * D_MODEL + col0 + co) = o; }
                            s += v[0] * v[0] + v[1] * v[1] + v[2] * v[2] + v[3] * v[3]; }
                    { const int ln = fq * 16 + fr; s += shx(s, ln, 16); s += shx(s, ln, 32); }
                    if (fq == 0 && !dry) atomicAdd(ssn + row, fx(s)); } }
    }
};
struct EpiSsdIn {
    static constexpr bool PERM = true;
    bf16_t* Z; bf16_t* XBC; float* DT; const u64* ss; const float* dt_bias;
    __device__ __forceinline__ void operator()(const f32x4 (&acc)[2][2][4][2], const Unit& u, int wr, int wc, int fr, int fq) const {
        const int row0 = u.pm * BM + wr * 64 + fr;
        const int kind = u.pn < 8 ? 0 : (u.pn < 20 ? 1 : 2);
        const int colt = kind == 0 ? u.pn * BM : (u.pn - 8) * BM;
        const int col0 = colt + wc * 32 + 8 * fq;
        float rs[2][4];
#pragma unroll
        for (int ai = 0; ai < 2; ++ai)
#pragma unroll
            for (int m = 0; m < 4; ++m) rs[ai][m] = ssf(ss + row0 + ai * HALF + m * 16);
#pragma unroll
        for (int ai = 0; ai < 2; ++ai)
#pragma unroll
            for (int m = 0; m < 4; ++m) { const int row = row0 + ai * HALF + m * 16; const float rstd = rsqrtf(rs[ai][m] * (1.f / D_MODEL) + EPS);
#pragma unroll
                for (int bj = 0; bj < 2; ++bj) { f32x4 v0 = acc[ai][bj][m][0] * rstd, v1 = acc[ai][bj][m][1] * rstd;
                    if (kind == 2) {
                        if (bj == 0 && wc == 0) { const int c = 8 * fq;
                            f32x4 b0 = *(const f32x4*)(dt_bias + c), b1 = *(const f32x4*)(dt_bias + c + 4);
                            f32x4 o0, o1; o0[0] = softplus_f(v0[0] + b0[0]); o0[1] = softplus_f(v0[1] + b0[1]); o0[2] = softplus_f(v0[2] + b0[2]); o0[3] = softplus_f(v0[3] + b0[3]);
                            o1[0] = softplus_f(v1[0] + b1[0]); o1[1] = softplus_f(v1[1] + b1[1]); o1[2] = softplus_f(v1[2] + b1[2]); o1[3] = softplus_f(v1[3] + b1[3]);
                            *(f32x4*)(DT + (size_t)row * 32 + c) = o0; *(f32x4*)(DT + (size_t)row * 32 + c + 4) = o1; }
                    } else {
                        if (kind == 0) { v0[0] = silu_f(v0[0]); v0[1] = silu_f(v0[1]); v0[2] = silu_f(v0[2]); v0[3] = silu_f(v0[3]); v1[0] = silu_f(v1[0]); v1[1] = silu_f(v1[1]); v1[2] = silu_f(v1[2]); v1[3] = silu_f(v1[3]); }
                        u32x4 o; o[0] = cvt_pk_bf16(v0[0], v0[1]); o[1] = cvt_pk_bf16(v0[2], v0[3]); o[2] = cvt_pk_bf16(v1[0], v1[1]); o[3] = cvt_pk_bf16(v1[2], v1[3]);
                        bf16_t* dst = kind == 0 ? Z + (size_t)row * D_INNER : XBC + (size_t)row * CONV_DIM;
                        *(u32x4*)(dst + col0 + bj * HALF) = o; } } }
    }
};
}

__device__ __forceinline__ void transpose_item(const float* W, int K, int N, bf16_t* WT, const float* kscale, int k0, int n0, float* scr, int lane) {
    const int kr = lane >> 3, n4 = (lane & 7) * 4;
    f32x4 v[8]; float sc[8];
#pragma unroll
    for (int i = 0; i < 8; ++i) { v[i] = *(const f32x4*)(W + (size_t)(k0 + kr + 8 * i) * N + n0 + n4); sc[i] = kscale ? kscale[k0 + kr + 8 * i] : 1.f; }
#pragma unroll
    for (int i = 0; i < 8; ++i) { float* t = scr + (kr + 8 * i) * 33 + n4; t[0] = v[i][0] * sc[i]; t[1] = v[i][1] * sc[i]; t[2] = v[i][2] * sc[i]; t[3] = v[i][3] * sc[i]; }
    asm volatile("s_waitcnt lgkmcnt(0)" ::: "memory");
    const int c = lane & 7;
#pragma unroll
    for (int jn = 0; jn < 4; ++jn) { const int n = (lane >> 3) + 8 * jn; const float* t = scr + (8 * c) * 33 + n;
        u32x4 o; o[0] = cvt_pk_bf16(t[0], t[33]); o[1] = cvt_pk_bf16(t[2 * 33], t[3 * 33]); o[2] = cvt_pk_bf16(t[4 * 33], t[5 * 33]); o[3] = cvt_pk_bf16(t[6 * 33], t[7 * 33]);
        *(u32x4*)(WT + (size_t)(n0 + n) * K + k0 + 8 * c) = o; }
    asm volatile("s_waitcnt lgkmcnt(0)" ::: "memory");
}

constexpr int W_FIRST = 16 * 128, W_PER = 16 * 128 + 4 * 8 * 16 + 32 * 32 + 16 * 161 + 32 * 32;
__device__ __forceinline__ void prep_weights(const Params& p, unsigned char* lds, int vb, int VG, const int tid, int it_lo, int it_hi) {
    const int lane = tid & 63, wid = tid >> 6;
    float* scr = (float*)lds + wid * (64 * 33);
    constexpr int T_PIN = 16 * 128, T_MIX = 4 * 8 * 16, T_POUT = 32 * 32, T_SIN = 16 * 161, T_SOUT = 32 * 32, T_PER = T_PIN + T_MIX + T_POUT + T_SIN + T_SOUT;
    for (int it = it_lo + vb * 8 + wid; it < (it_hi < 0 ? 2 * T_PER : it_hi); it += VG * 8) {
        const int j = it / T_PER; int r = it % T_PER;
        if (r < T_PIN) { const int kb = r / 128, nb = r % 128;
            transpose_item(p.pool_in_w + (size_t)j * 1024 * 4096, 1024, 4096, (bf16_t*)(p.ws + WS_WPIN) + (size_t)j * 4096 * 1024, p.norm_w + (2 * j) * 1024, kb * 64, nb * 32, scr, lane); continue; }
        r -= T_PIN;
        if (r < T_MIX) { const int g = r / 128, kb = (r % 128) / 16, nb = r % 16;
            transpose_item(p.pool_mix_w + ((size_t)j * 4 + g) * 512 * 512, 512, 512, (bf16_t*)(p.ws + WS_WMIX) + ((size_t)j * 2048 + g * 512) * 512, nullptr, kb * 64, nb * 32, scr, lane); continue; }
        r -= T_MIX;
        if (r < T_POUT) { const int kb = r / 32, nb = r % 32;
            transpose_item(p.pool_out_w + (size_t)j * 2048 * 1024, 2048, 1024, (bf16_t*)(p.ws + WS_WPOUT) + (size_t)j * 1024 * 2048, nullptr, kb * 64, nb * 32, scr, lane); continue; }
        r -= T_POUT;
        if (r < T_SIN) { const int kb = r / 161, nb = r % 161;
            transpose_item(p.ssd_in_w + (size_t)j * 1024 * SSD_IN, 1024, SSD_IN, (bf16_t*)(p.ws + WS_WSIN) + (size_t)j * SSD_IN_PAD * 1024, p.norm_w + (2 * j + 1) * 1024, kb * 64, nb * 32, scr, lane); continue; }
        r -= T_SIN;
        { const int kb = r / 32, nb = r % 32;
            transpose_item(p.ssd_out_w + (size_t)j * 2048 * 1024, 2048, 1024, (bf16_t*)(p.ws + WS_WSOUT) + (size_t)j * 1024 * 2048, p.ssd_norm_w + j * 2048, kb * 64, nb * 32, scr, lane); }
    }
}

__device__ __forceinline__ void phase_prep(const Params& p, unsigned char* lds, int bid, int G, const int tid) {
    const int lane = tid & 63, wid = tid >> 6;
    prep_weights(p, lds, bid, G, tid, 0, G > 64 ? W_FIRST : -1);
    { const size_t gt = (size_t)bid * NTHREADS + tid, gn = (size_t)G * NTHREADS;
        for (int j = 0; j < 2; ++j) { u32x4* z = (u32x4*)((bf16_t*)(p.ws + WS_WSIN) + ((size_t)j * SSD_IN_PAD + SSD_IN) * 1024);
            const size_t n16 = (size_t)(SSD_IN_PAD - SSD_IN) * 1024 * 2 / 16;
            for (size_t i = gt; i < n16; i += gn) z[i] = (u32x4){0u, 0u, 0u, 0u}; }
        u64* ss = (u64*)(p.ws + WS_SS) + T; for (size_t i = gt; i < (size_t)4 * T; i += gn) ss[i] = 0ull;
        u64* ss2 = (u64*)(p.ws + WS_SS2); for (size_t i = gt; i < (size_t)2 * T; i += gn) ss2[i] = 0ull; }
    { u64* ss0 = (u64*)(p.ws + WS_SS); bf16_t* XB = (bf16_t*)(p.ws + WS_XB);
        for (int row = bid * 8 + wid; row < T; row += G * 8) {
            const float* xr = row < TP ? p.x_prompt + (size_t)row * D_MODEL : p.x_sample + (size_t)(row - TP) * D_MODEL;
            float s = 0.f; f32x4 v[4];
#pragma unroll
            for (int i = 0; i < 4; ++i) v[i] = *(const f32x4*)(xr + i * 256 + lane * 4);
#pragma unroll
            for (int i = 0; i < 4; ++i) {
                s += v[i][0] * v[i][0] + v[i][1] * v[i][1] + v[i][2] * v[i][2] + v[i][3] * v[i][3];
                u32x2 o; o[0] = cvt_pk_bf16(v[i][0], v[i][1]); o[1] = cvt_pk_bf16(v[i][2], v[i][3]);
                *(u32x2*)(XB + (size_t)row * D_MODEL + i * 256 + lane * 4) = o; }
#pragma unroll
            for (int o = 1; o < 64; o <<= 1) s += shx(s, lane, o);
            if (lane == 0) ss0[row] = fx(s); } }
}

__device__ __forceinline__ void ld8(const bf16_t* p, float (&v)[8]) { const u32x4 u = *(const u32x4*)p;
    v[0] = bf_lo(u[0]); v[1] = bf_hi(u[0]); v[2] = bf_lo(u[1]); v[3] = bf_hi(u[1]); v[4] = bf_lo(u[2]); v[5] = bf_hi(u[2]); v[6] = bf_lo(u[3]); v[7] = bf_hi(u[3]); }
__device__ __forceinline__ void ld8f(const float* p, float (&v)[8]) { const f32x4 a = *(const f32x4*)p, b = *(const f32x4*)(p + 4);
    v[0] = a[0]; v[1] = a[1]; v[2] = a[2]; v[3] = a[3]; v[4] = b[0]; v[5] = b[1]; v[6] = b[2]; v[7] = b[3]; }
__device__ __forceinline__ void st8(bf16_t* p, const float (&v)[8]) { u32x4 o; o[0] = cvt_pk_bf16(v[0], v[1]); o[1] = cvt_pk_bf16(v[2], v[3]); o[2] = cvt_pk_bf16(v[4], v[5]); o[3] = cvt_pk_bf16(v[6], v[7]); *(u32x4*)p = o; }
__device__ __forceinline__ void st8f(float* p, const float (&v)[8]) { *(f32x4*)p = (f32x4){v[0], v[1], v[2], v[3]}; *(f32x4*)(p + 4) = (f32x4){v[4], v[5], v[6], v[7]}; }

__device__ __forceinline__ void up8(const u32x4 u, float (&v)[8]) { v[0] = bf_lo(u[0]); v[1] = bf_hi(u[0]); v[2] = bf_lo(u[1]); v[3] = bf_hi(u[1]); v[4] = bf_lo(u[2]); v[5] = bf_hi(u[2]); v[6] = bf_lo(u[3]); v[7] = bf_hi(u[3]); }
__device__ __forceinline__ u32x4 pk8f(const float* p) { const f32x4 a = *(const f32x4*)p, b = *(const f32x4*)(p + 4); u32x4 o; o[0] = cvt_pk_bf16(a[0], a[1]); o[1] = cvt_pk_bf16(a[2], a[3]); o[2] = cvt_pk_bf16(b[0], b[1]); o[3] = cvt_pk_bf16(b[2], b[3]); return o; }

template <int W, int NR, bool PROMPT>
__device__ __forceinline__ void pool_run(const Params& p, int j, const bf16_t* U, bf16_t* P, int run, int c0, int g) {
    const int cl = c0 - g * 512;
    u32x4 ext[W - 1 + NR];
    int row0, t0 = 0, b = 0, sb = 0;
    if (PROMPT) { row0 = run * NR; t0 = row0 & (SEQ - 1); b = row0 >> 11;
#pragma unroll
        for (int k = 0; k < W - 1; ++k) ext[k] = (t0 - (W - 1 - k) >= 0) ? *(const u32x4*)(U + (size_t)(row0 - (W - 1 - k)) * D_INNER + c0) : (u32x4){0u, 0u, 0u, 0u};
    } else { sb = run; row0 = TP + sb * DEC_SEQ;
        const float* buf = p.state_pool + (((size_t)j * DEC_BATCH + sb) * POOL_BUF) * D_INNER + c0;
#pragma unroll
        for (int k = 0; k < W - 1; ++k) ext[k] = pk8f(buf + (size_t)(POOL_BUF - (W - 1 - k)) * D_INNER); }
#pragma unroll
    for (int t = 0; t < NR; ++t) ext[W - 1 + t] = *(const u32x4*)(U + (size_t)(row0 + t) * D_INNER + c0);
    float sum[8], u[8], o[8];
#pragma unroll
    for (int e = 0; e < 8; ++e) sum[e] = 0.f;
#pragma unroll
    for (int k = 0; k < W - 1; ++k) { up8(ext[k], u);
#pragma unroll
        for (int e = 0; e < 8; ++e) sum[e] += u[e]; }
#pragma unroll
    for (int t = 0; t < NR; ++t) { const int row = row0 + t; up8(ext[W - 1 + t], u);
        const float inv = PROMPT ? 1.f / (float)min(t0 + t + 1, W) : 1.f / (float)W;
#pragma unroll
        for (int e = 0; e < 8; ++e) { sum[e] += u[e]; o[e] = sum[e] * inv - u[e]; }
        st8(P + ((size_t)g * T + row) * 512 + cl, o);
        if (PROMPT) { if (t0 + t >= SEQ - POOL_BUF) st8f(p.out + O_POOLP + (((size_t)j * BATCH + b) * POOL_BUF + (t0 + t - (SEQ - POOL_BUF))) * D_INNER + c0, u); }
        else st8f(p.out + O_POOLS + (((size_t)j * DEC_BATCH + sb) * POOL_BUF + (POOL_BUF - DEC_SEQ + t)) * D_INNER + c0, u);
        up8(ext[t], u);
#pragma unroll
        for (int e = 0; e < 8; ++e) sum[e] -= u[e]; }
}

__device__ __forceinline__ void phase_pool(const Params& p, int j, int bid, int G, const int tid) {
    const bf16_t* U = (const bf16_t*)(p.ws + WS_U); bf16_t* P = (bf16_t*)(p.ws + WS_P);
    const int NPR = (TP / 8) * 256, NSA = DEC_BATCH * 256;
    for (int it = bid * NTHREADS + tid; it < NPR + NSA; it += G * NTHREADS) {
        const int chunk = it & 255, run = it >> 8, c0 = chunk * 8, g = __builtin_amdgcn_readfirstlane(chunk >> 6);
        if (run < TP / 8) {
            if (g == 0) pool_run<2, 8, true>(p, j, U, P, run, c0, 0); else if (g == 1) pool_run<4, 8, true>(p, j, U, P, run, c0, 1);
            else if (g == 2) pool_run<8, 8, true>(p, j, U, P, run, c0, 2); else pool_run<16, 8, true>(p, j, U, P, run, c0, 3);
        } else { const int sb = run - TP / 8;
            if (g == 0) pool_run<2, 8, false>(p, j, U, P, sb, c0, 0); else if (g == 1) pool_run<4, 8, false>(p, j, U, P, sb, c0, 1);
            else if (g == 2) pool_run<8, 8, false>(p, j, U, P, sb, c0, 2); else pool_run<16, 8, false>(p, j, U, P, sb, c0, 3);
            const float* buf = p.state_pool + (((size_t)j * DEC_BATCH + sb) * POOL_BUF) * D_INNER + c0;
            float* po = p.out + O_POOLS + (((size_t)j * DEC_BATCH + sb) * POOL_BUF) * D_INNER + c0;
            f32x4 cp[POOL_BUF - DEC_SEQ][2];
#pragma unroll
            for (int i = 0; i < POOL_BUF - DEC_SEQ; ++i) { cp[i][0] = *(const f32x4*)(buf + (size_t)(DEC_SEQ + i) * D_INNER); cp[i][1] = *(const f32x4*)(buf + (size_t)(DEC_SEQ + i) * D_INNER + 4); }
#pragma unroll
            for (int i = 0; i < POOL_BUF - DEC_SEQ; ++i) { *(f32x4*)(po + (size_t)i * D_INNER) = cp[i][0]; *(f32x4*)(po + (size_t)i * D_INNER + 4) = cp[i][1]; }
        }
    }
}

__device__ __forceinline__ void phase_conv(const Params& p, int j, int bid, int G, const int tid) {
    const bf16_t* R = (const bf16_t*)(p.ws + WS_XBC); bf16_t* O = (bf16_t*)(p.ws + WS_XBCC);
    const int NIT = (T / 8) * 384;
    for (int it = bid * NTHREADS + tid; it < NIT; it += G * NTHREADS) {
        const int chunk = it % 384, run = it / 384, c0 = chunk * 8, row0 = run * 8;
        float w0[8], w1[8], w2[8], w3[8], bs[8], h1[8], h2[8], h3[8], cur[8], o[8];
        const bool prompt = row0 < TP; const int t0 = prompt ? (row0 & (SEQ - 1)) : 0;
        u32x4 rr[8];
#pragma unroll
        for (int t = 0; t < 8; ++t) rr[t] = *(const u32x4*)(R + (size_t)(row0 + t) * CONV_DIM + c0);
        if (prompt) {
            if (t0 > 0) { ld8(R + (size_t)(row0 - 3) * CONV_DIM + c0, h3); ld8(R + (size_t)(row0 - 2) * CONV_DIM + c0, h2); ld8(R + (size_t)(row0 - 1) * CONV_DIM + c0, h1); }
            else {
#pragma unroll
                for (int e = 0; e < 8; ++e) { h1[e] = 0.f; h2[e] = 0.f; h3[e] = 0.f; } }
        } else { const int sb = (row0 - TP) >> 3; const float* sc = p.state_conv + (((size_t)j * DEC_BATCH + sb) * 3) * CONV_DIM + c0;
            ld8f(sc, h3); ld8f(sc + CONV_DIM, h2); ld8f(sc + 2 * CONV_DIM, h1); }
        const float* cw = p.ssd_conv_w + (size_t)j * 4 * CONV_DIM + c0;
        ld8f(cw, w0); ld8f(cw + CONV_DIM, w1); ld8f(cw + 2 * CONV_DIM, w2); ld8f(cw + 3 * CONV_DIM, w3); ld8f(p.ssd_conv_b + (size_t)j * CONV_DIM + c0, bs);
#pragma unroll
        for (int t = 0; t < 8; ++t) { const int row = row0 + t;
            up8(rr[t], cur);
#pragma unroll
            for (int e = 0; e < 8; ++e) { const float v = w0[e] * h3[e] + w1[e] * h2[e] + w2[e] * h1[e] + w3[e] * cur[e] + bs[e]; o[e] = silu_f(v); h3[e] = h2[e]; h2[e] = h1[e]; h1[e] = cur[e]; }
            st8(O + (size_t)row * CONV_DIM + c0, o);
            if (prompt) { const int tt = t0 + t; if (tt >= SEQ - 3) st8f(p.out + O_CONVP + (((size_t)j * BATCH + (row0 >> 11)) * 3 + (tt - (SEQ - 3))) * CONV_DIM + c0, cur); }
            else if (t >= DEC_SEQ - 3) st8f(p.out + O_CONVS + (((size_t)j * DEC_BATCH + ((row0 - TP) >> 3)) * 3 + (t - (DEC_SEQ - 3))) * CONV_DIM + c0, cur);
        }
    }
}

#define LAS __attribute__((address_space(3)))
constexpr int RS = 272;
constexpr int L_CS = 0, L_BS = 128 * RS, L_XT = 2 * 128 * RS, L_XW = L_XT + 64 * RS, L_HS = L_XW + 64 * RS  , L_DT = L_HS + 2 * 64 * RS, L_AC = L_DT + 512,
              L_STK = L_AC + 512  , L_SYS = L_STK + 8 * 320 * 2  , L_SDT = L_SYS + 8 * 64 * 4  , L_END = L_SDT + 64;
static_assert(L_END <= LDS_STAGE, "scan LDS");
typedef const LAS bf16x8* lfrag_t;
#define LFRAG(ptr, off) (*(lfrag_t)((ptr) + (off)))

__device__ __forceinline__ void scan_unit(const Params& p, int j, LAS unsigned char* L, int unit, const int tid, const int dry) {
    const int lane = tid & 63, w = __builtin_amdgcn_readfirstlane(tid >> 6), fr = lane & 15, fq = lane >> 4;
    const int b = unit >> 5, h = unit & 31, g = h >> 3;
    const bf16_t* XC = (const bf16_t*)(p.ws + WS_XBCC); const bf16_t* Z = (const bf16_t*)(p.ws + WS_Z); const float* DT = (const float*)(p.ws + WS_DT);
    bf16_t* YG = (bf16_t*)(p.ws + WS_Y); u64* ss2 = (u64*)(p.ws + WS_SS2) + (size_t)j * T;
    const float A = -__expf(p.ssd_A_log[j * N_HEADS + h]), Dh = p.ssd_D[j * N_HEADS + h];
    LAS unsigned char* const pCf = L + L_CS + (16 * w + fr) * RS + fq * 16;
    LAS unsigned char* const pBf = L + L_BS + fr * RS + fq * 16;
    LAS unsigned char* const pWr = L + L_BS + (16 * w + fr) * RS + fq * 8;
    LAS unsigned char* const pWf = L + L_BS + (16 * w + fr) * RS + fq * 16;
    LAS unsigned char* const pXf = L + L_XT + fr * RS + fq * 16;
    LAS unsigned char* const pBg = L + L_BS + (fq * 8) * RS + (16 * w + fr) * 2;
    LAS unsigned char* const pSt = L + L_CS + (tid >> 4) * RS + (tid & 15) * 16;
    LAS unsigned char* const pSx = L + L_XT + ((tid >> 7) * 8) * RS + (tid & 127) * 2;
    LAS unsigned char* const pXe = L + L_XT + (fq * 4) * RS + (16 * w + fr) * 2;
    LAS unsigned char* const pDq = L + L_DT + fq * 16;
    LAS unsigned char* const pDj = L + L_DT + (tid & 127) * 4;
    LAS unsigned char* const pDi = L + L_AC + (16 * w + fr) * 4;
    LAS unsigned char* const pHw = L + L_HS + fr * RS + (16 * w + fq * 4) * 2;
    f32x4 hacc[4];
#pragma unroll
    for (int i = 0; i < 4; ++i) hacc[i] = (f32x4){0.f, 0.f, 0.f, 0.f};
    for (int i = tid; i < 64 * RS / 16; i += NTHREADS) *(LAS u32x4*)(L + L_HS + i * 16) = (u32x4){0u, 0u, 0u, 0u};
    u32x4 creg[4], breg[4], xreg[2]; float d0 = 0.f, d1 = 0.f;
    const unsigned voffT = (unsigned)((tid >> 4) * CONV_DIM + (tid & 15) * 8) * 2u, voffX = (unsigned)((tid & 127) * CONV_DIM + (tid >> 7) * 8) * 2u;
#define SCAN_PREFETCH(c_) do { const int r0_ = b * SEQ + (c_) * 128; \
        const char* bB_ = (const char*)(XC + (size_t)r0_ * CONV_DIM + D_INNER + g * 128); const char* bX_ = (const char*)(XC + (size_t)r0_ * CONV_DIM + h * 64); \
        _Pragma("unroll") for (int i = 0; i < 4; ++i) { \
            breg[i] = *(const u32x4*)(bB_ + (size_t)i * (32 * CONV_DIM * 2) + voffT); creg[i] = *(const u32x4*)(bB_ + (size_t)i * (32 * CONV_DIM * 2) + 1024 + voffT); } \
        _Pragma("unroll") for (int i = 0; i < 2; ++i) xreg[i] = *(const u32x4*)(bX_ + i * 64 + voffX); \
        if (w == 0) { d0 = DT[(size_t)(r0_ + 2 * lane) * 32 + h]; d1 = DT[(size_t)(r0_ + 2 * lane + 1) * 32 + h]; } } while (0)
    SCAN_PREFETCH(0);
#pragma unroll 1
    for (int c = 0; c < SEQ / 128; ++c) {
        const int r0 = b * SEQ + c * 128;
        const int hb = (c & 1) * (64 * RS), hn = ((c & 1) ^ 1) * (64 * RS);
        if (w == 0) { const float a0 = d0 * A, a1 = d1 * A; float v = a0 + a1;
#pragma unroll
            for (int o = 1; o < 64; o <<= 1) { const float t = shup(v, lane, o); if (lane >= o) v += t; }
            *(LAS f32x2*)(L + L_DT + lane * 8) = (f32x2){d0, d1}; *(LAS f32x2*)(L + L_AC + lane * 8) = (f32x2){v - a1, v}; }
        __syncthreads();
        const float aend = *(const LAS float*)(L + L_AC + 127 * 4);
#pragma unroll
        for (int i = 0; i < 4; ++i) { *(LAS u32x4*)(pSt + 128 * RS + i * 32 * RS) = breg[i]; *(LAS u32x4*)(pSt + i * 32 * RS) = creg[i]; }
        { const float wj = __expf(aend - *(const LAS float*)(pDj + 512)) * *(const LAS float*)pDj;
#pragma unroll
            for (int i = 0; i < 2; ++i)
#pragma unroll
                for (int e2 = 0; e2 < 4; ++e2) { const unsigned u = xreg[i][e2]; const float x0 = bf_lo(u), x1 = bf_hi(u);
                    const int ro = (i * 32 + e2 * 2) * RS;
                    *(LAS bf16_t*)(pSx + ro) = (bf16_t)(u & 0xffffu); *(LAS bf16_t*)(pSx + ro + RS) = (bf16_t)(u >> 16);
                    const unsigned s = cvt_pk_bf16(x0 * wj, x1 * wj);
                    *(LAS bf16_t*)(pSx + 64 * RS + ro) = (bf16_t)(s & 0xffffu); *(LAS bf16_t*)(pSx + 64 * RS + ro + RS) = (bf16_t)(s >> 16); } }
        const int irow = r0 + 16 * w + fr;
        u32x2 zreg[4];
#pragma unroll
        for (int pt = 0; pt < 4; ++pt) zreg[pt] = *(const u32x2*)(Z + (size_t)irow * D_INNER + h * 64 + pt * 16 + fq * 4);
        __syncthreads();
        u32x2 wpk[8]; float ea;
        {
            bf16x8 cf[4];
#pragma unroll
            for (int ks = 0; ks < 4; ++ks) cf[ks] = LFRAG(pCf, ks * 64);
            const int i = 16 * w + fr; const float aci = *(const LAS float*)pDi; ea = __expf(aci);
#pragma unroll
            for (int j2 = 0; j2 < 4; ++j2) {
                wpk[2 * j2] = (u32x2){0u, 0u}; wpk[2 * j2 + 1] = (u32x2){0u, 0u};
                if (2 * j2 <= w) {
                    f32x4 g0 = (f32x4){0.f, 0.f, 0.f, 0.f}, g1 = (f32x4){0.f, 0.f, 0.f, 0.f};
#pragma unroll
                    for (int ks = 0; ks < 4; ++ks) { g0 = __builtin_amdgcn_mfma_f32_16x16x32_bf16(LFRAG(pBf, (2 * j2) * 16 * RS + ks * 64), cf[ks], g0, 0, 0, 0);
                        g1 = __builtin_amdgcn_mfma_f32_16x16x32_bf16(LFRAG(pBf, (2 * j2 + 1) * 16 * RS + ks * 64), cf[ks], g1, 0, 0, 0); }
#pragma unroll
                    for (int hh = 0; hh < 2; ++hh) { const int jt = 2 * j2 + hh, j0 = jt * 16 + fq * 4; const f32x4 gg = hh ? g1 : g0;
                        const f32x4 dtj = *(const LAS f32x4*)(pDq + jt * 64), acj = *(const LAS f32x4*)(pDq + 512 + jt * 64);
                        float v[4];
#pragma unroll
                        for (int r = 0; r < 4; ++r) v[r] = (j0 + r <= i) ? gg[r] * __expf(aci - acj[r]) * dtj[r] : 0.f;
                        wpk[jt][0] = cvt_pk_bf16(v[0], v[1]); wpk[jt][1] = cvt_pk_bf16(v[2], v[3]); }
                }
                __builtin_amdgcn_sched_barrier(0);
            }
        }
        {
            const float dec = __expf(aend);
#pragma unroll
            for (int pt = 0; pt < 4; ++pt) hacc[pt] = hacc[pt] * dec;
#pragma unroll
            for (int ks = 0; ks < 4; ++ks) { bf16x8 bg;
#pragma unroll
                for (int e = 0; e < 8; ++e) bg[e] = *(const LAS short*)(pBg + (ks * 32 + e) * RS);
#pragma unroll
                for (int pt = 0; pt < 4; ++pt) hacc[pt] = __builtin_amdgcn_mfma_f32_16x16x32_bf16(bg, LFRAG(pXf, 64 * RS + pt * 16 * RS + ks * 64), hacc[pt], 0, 0, 0);
                __builtin_amdgcn_sched_barrier(0); }
        }
        __syncthreads();
#pragma unroll
        for (int jt = 0; jt < 8; ++jt) *(LAS u32x2*)(pWr + jt * 32) = wpk[jt];
#pragma unroll
        for (int pt = 0; pt < 4; ++pt) { u32x2 o; o[0] = cvt_pk_bf16(hacc[pt][0], hacc[pt][1]); o[1] = cvt_pk_bf16(hacc[pt][2], hacc[pt][3]);
            *(LAS u32x2*)(pHw + hn + pt * 16 * RS) = o; }
        __syncthreads();
        if (c + 1 < SEQ / 128) SCAN_PREFETCH(c + 1);
        {
            f32x4 yd[4], yoff[4];
#pragma unroll
            for (int pt = 0; pt < 4; ++pt) { yd[pt] = (f32x4){0.f, 0.f, 0.f, 0.f}; yoff[pt] = (f32x4){0.f, 0.f, 0.f, 0.f}; }
            LAS unsigned char* const pHf = pXf + 2 * 64 * RS + hb;
#pragma unroll
            for (int ks = 0; ks < 4; ++ks) { const bf16x8 cfk = LFRAG(pCf, ks * 64);
#pragma unroll
                for (int pt = 0; pt < 4; ++pt) yoff[pt] = __builtin_amdgcn_mfma_f32_16x16x32_bf16(LFRAG(pHf, pt * 16 * RS + ks * 64), cfk, yoff[pt], 0, 0, 0);
                __builtin_amdgcn_sched_barrier(0); }
#pragma unroll
            for (int ks = 0; ks < 4; ++ks) if (2 * ks <= w) { const bf16x8 wf = LFRAG(pWf, ks * 64);
#pragma unroll
                for (int pt = 0; pt < 4; ++pt) yd[pt] = __builtin_amdgcn_mfma_f32_16x16x32_bf16(LFRAG(pXf, pt * 16 * RS + ks * 64), wf, yd[pt], 0, 0, 0);
                __builtin_amdgcn_sched_barrier(0); }
            float s = 0.f;
#pragma unroll
            for (int pt = 0; pt < 4; ++pt) { const int p0 = pt * 16 + fq * 4;
                float y[4];
#pragma unroll
                for (int r = 0; r < 4; ++r) { const float x = bf1(*(const LAS bf16_t*)(pXe + (pt * 16 + r) * RS)); y[r] = yd[pt][r] + ea * yoff[pt][r] + Dh * x; }
                y[0] *= bf_lo(zreg[pt][0]); y[1] *= bf_hi(zreg[pt][0]); y[2] *= bf_lo(zreg[pt][1]); y[3] *= bf_hi(zreg[pt][1]);
                s += y[0] * y[0] + y[1] * y[1] + y[2] * y[2] + y[3] * y[3];
                u32x2 o; o[0] = cvt_pk_bf16(y[0], y[1]); o[1] = cvt_pk_bf16(y[2], y[3]);
                *(u32x2*)(YG + (size_t)irow * D_INNER + h * 64 + p0) = o; }
            s += shx(s, lane, 16); s += shx(s, lane, 32);
            if (fq == 0 && !dry) atomicAdd(ss2 + irow, fx(s));
        }
    }
#undef SCAN_PREFETCH
    float* so = p.out + O_SSMP + (((size_t)j * BATCH + b) * N_HEADS + h) * 64 * D_STATE;
#pragma unroll
    for (int pt = 0; pt < 4; ++pt) *(f32x4*)(so + (size_t)(pt * 16 + fr) * D_STATE + 16 * w + fq * 4) = hacc[pt];
    __syncthreads();
}

__device__ __forceinline__ void phase_scan(const Params& p, int j, unsigned char* lds, int bid, int G, const int tid, const int dry) {
    for (int v = bid; v < BATCH * N_HEADS; v += G) { const int x = v & 7, slot = v >> 3, gi = x * 4 + (slot >> 3);
        const int u = (gi >> 2) * N_HEADS + (gi & 3) * 8 + (slot & 7);
        scan_unit(p, j, (LAS unsigned char*)lds, u, tid, dry); }
}

constexpr int D_TOK = 0  , D_YS = 8 * 320 * 4  , D_SDT = D_YS + 8 * 64 * 4  ;
__device__ __forceinline__ void decode_units(const Params& p, int j, LAS unsigned char* L, int bid, int G, const int tid, const int dry) {
    const int lane = tid & 63, w = __builtin_amdgcn_readfirstlane(tid >> 6), pp = tid >> 3, n0 = (tid & 7) * 16;
    const bf16_t* R = (const bf16_t*)(p.ws + WS_XBC); const bf16_t* Z = (const bf16_t*)(p.ws + WS_Z); const float* DT = (const float*)(p.ws + WS_DT);
    bf16_t* YG = (bf16_t*)(p.ws + WS_Y); u64* ss2 = (u64*)(p.ws + WS_SS2) + (size_t)j * T;
    const int NU = DEC_BATCH * N_HEADS;
    f32x4 hv[4], hvn[4]; float raw[8], rawn[8], hist[3], histn[3], cw[5], cwn[5]; float sd = 0.f, sdn = 0.f, zs = 0.f, zsn = 0.f;
#pragma unroll
    for (int i = 0; i < 8; ++i) { raw[i] = 0.f; rawn[i] = 0.f; }
#pragma unroll
    for (int i = 0; i < 3; ++i) { hist[i] = 0.f; histn[i] = 0.f; }
#pragma unroll
    for (int i = 0; i < 5; ++i) { cw[i] = 0.f; cwn[i] = 0.f; }
#define DEC_LOAD(u_, HV, RAW, HIST, CW, SD, ZS) do { const int sb_ = (u_) >> 5, h_ = (u_) & 31, g_ = h_ >> 3, row0_ = TP + sb_ * DEC_SEQ; \
        const float* sp_ = p.state_ssm + ((((size_t)j * DEC_BATCH + sb_) * N_HEADS + h_) * 64 + pp) * D_STATE + n0; \
        _Pragma("unroll") for (int i = 0; i < 4; ++i) HV[i] = *(const f32x4*)(sp_ + 4 * i); \
        if (tid < 320) { const int col_ = tid < 64 ? h_ * 64 + tid : (tid < 192 ? D_INNER + g_ * 128 + (tid - 64) : D_INNER + 512 + g_ * 128 + (tid - 192)); \
            _Pragma("unroll") for (int t = 0; t < 8; ++t) RAW[t] = bf1(R[(size_t)(row0_ + t) * CONV_DIM + col_]); \
            const float* sc_ = p.state_conv + (((size_t)j * DEC_BATCH + sb_) * 3) * CONV_DIM + col_; \
            HIST[0] = sc_[0]; HIST[1] = sc_[CONV_DIM]; HIST[2] = sc_[2 * CONV_DIM]; \
            const float* cw_ = p.ssd_conv_w + (size_t)j * 4 * CONV_DIM + col_; \
            CW[0] = cw_[0]; CW[1] = cw_[CONV_DIM]; CW[2] = cw_[2 * CONV_DIM]; CW[3] = cw_[3 * CONV_DIM]; CW[4] = p.ssd_conv_b[(size_t)j * CONV_DIM + col_]; } \
        if (tid >= 504) SD = DT[(size_t)(row0_ + tid - 504) * 32 + h_]; \
        ZS = bf1(Z[(size_t)(row0_ + w) * D_INNER + h_ * 64 + lane]); } while (0)
    int u = bid;
    if (u < NU) DEC_LOAD(u, hv, raw, hist, cw, sd, zs);
    for (; u < NU; u += G) {
        const int sb = u >> 5, h = u & 31, row0 = TP + sb * DEC_SEQ;
        const float A = -__expf(p.ssd_A_log[j * N_HEADS + h]), Dh = p.ssd_D[j * N_HEADS + h];
        if (tid < 320) { float h3 = hist[0], h2 = hist[1], h1 = hist[2];
#pragma unroll
            for (int t = 0; t < 8; ++t) { const float v = cw[0] * h3 + cw[1] * h2 + cw[2] * h1 + cw[3] * raw[t] + cw[4];
                *(LAS float*)(L + D_TOK + (t * 320 + tid) * 4) = silu_f(v); h3 = h2; h2 = h1; h1 = raw[t]; } }
        if (tid >= 504) { *(LAS float*)(L + D_SDT + (tid - 504) * 4) = sd; *(LAS float*)(L + D_SDT + 32 + (tid - 504) * 4) = __expf(sd * A); }
        __syncthreads();
        if (u + G < NU) DEC_LOAD(u + G, hvn, rawn, histn, cwn, sdn, zsn);
        float part[DEC_SEQ];
#pragma unroll
        for (int t = 0; t < DEC_SEQ; ++t) { LAS unsigned char* const tk = L + D_TOK + t * 1280;
            const float dec = *(const LAS float*)(L + D_SDT + 32 + t * 4), xdt = *(const LAS float*)(tk + pp * 4) * *(const LAS float*)(L + D_SDT + t * 4); float pt = 0.f;
#pragma unroll
            for (int i = 0; i < 4; ++i) { const f32x4 bv = *(const LAS f32x4*)(tk + 256 + (n0 + 4 * i) * 4), cv = *(const LAS f32x4*)(tk + 768 + (n0 + 4 * i) * 4);
                hv[i] = hv[i] * dec + bv * xdt;
                pt += hv[i][0] * cv[0] + hv[i][1] * cv[1] + hv[i][2] * cv[2] + hv[i][3] * cv[3]; }
            part[t] = pt; }
#pragma unroll
        for (int m = 1; m < 8; m <<= 1) {
#pragma unroll
            for (int t = 0; t < DEC_SEQ; ++t) part[t] += shx(part[t], lane, m); }
        if ((tid & 7) == 0) {
#pragma unroll
            for (int t = 0; t < DEC_SEQ; ++t) *(LAS float*)(L + D_YS + (t * 64 + pp) * 4) = part[t]; }
        { float* so = p.out + O_SSMS + ((((size_t)j * DEC_BATCH + sb) * N_HEADS + h) * 64 + pp) * D_STATE + n0;
#pragma unroll
            for (int i = 0; i < 4; ++i) *(f32x4*)(so + 4 * i) = hv[i]; }
        __syncthreads();
        { const int t = w, row = row0 + t; const float y = *(const LAS float*)(L + D_YS + (t * 64 + lane) * 4) + Dh * *(const LAS float*)(L + D_TOK + (t * 320 + lane) * 4);
            const float yg = y * zs;
            YG[(size_t)row * D_INNER + h * 64 + lane] = (bf16_t)(cvt_pk_bf16(yg, 0.f) & 0xffffu);
            float s = yg * yg;
#pragma unroll
            for (int o = 1; o < 64; o <<= 1) s += shx(s, lane, o);
            if (lane == 0 && !dry) atomicAdd(ss2 + row, fx(s)); }
        __syncthreads();
#pragma unroll
        for (int i = 0; i < 4; ++i) hv[i] = hvn[i];
#pragma unroll
        for (int i = 0; i < 8; ++i) raw[i] = rawn[i];
#pragma unroll
        for (int i = 0; i < 3; ++i) hist[i] = histn[i];
#pragma unroll
        for (int i = 0; i < 5; ++i) cw[i] = cwn[i];
        sd = sdn; zs = zsn;
    }
#undef DEC_LOAD
}

__device__ __forceinline__ void sample_fix(const Params& p, int L, int bid, int G, const int tid) {
    const int lane = tid & 63, wid = tid >> 6;
    float* X = (float*)(p.ws + WS_X); bf16_t* XB = (bf16_t*)(p.ws + WS_XB); const float* PART = (const float*)(p.ws + WS_PART);
    u64* ssn = (u64*)(p.ws + WS_SS) + (size_t)(L + 1) * T;
    for (int r = bid * 8 + wid; r < TS; r += G * 8) { const int row = TP + r;
        const float* xo = L == 0 ? p.x_sample + (size_t)r * D_MODEL : X + (size_t)row * D_MODEL;
        f32x4 v[4], ps[4];
#pragma unroll
        for (int i = 0; i < 4; ++i) { v[i] = *(const f32x4*)(xo + i * 256 + lane * 4); ps[i] = (f32x4){0.f, 0.f, 0.f, 0.f}; }
#pragma unroll
        for (int kb = 0; kb < SPLITQ; kb += 4) { f32x4 q[4][4];
#pragma unroll
            for (int i = 0; i < 4; ++i)
#pragma unroll
                for (int k = 0; k < 4; ++k) q[k][i] = *(const f32x4*)(PART + ((size_t)(kb + k) * TS + r) * D_MODEL + i * 256 + lane * 4);
#pragma unroll
            for (int i = 0; i < 4; ++i) ps[i] = (((ps[i] + q[0][i]) + q[1][i]) + q[2][i]) + q[3][i]; }
        float s = 0.f;
#pragma unroll
        for (int i = 0; i < 4; ++i) { const f32x4 x = v[i] + ps[i];
            *(f32x4*)(X + (size_t)row * D_MODEL + i * 256 + lane * 4) = x;
            u32x2 o; o[0] = cvt_pk_bf16(x[0], x[1]); o[1] = cvt_pk_bf16(x[2], x[3]);
            *(u32x2*)(XB + (size_t)row * D_MODEL + i * 256 + lane * 4) = o;
            s += x[0] * x[0] + x[1] * x[1] + x[2] * x[2] + x[3] * x[3]; }
#pragma unroll
        for (int o = 1; o < 64; o <<= 1) s += shx(s, lane, o);
        if (lane == 0) ssn[row] = fx(s); }
}

__device__ __forceinline__ void phase_final(const Params& p, int bid, int G, const int tid) {
    const int lane = tid & 63, wid = tid >> 6;
    const float* X = (const float*)(p.ws + WS_X); const u64* ss = (const u64*)(p.ws + WS_SS) + (size_t)4 * T;
    f32x4 wv[4];
#pragma unroll
    for (int i = 0; i < 4; ++i) wv[i] = *(const f32x4*)(p.final_norm_w + i * 256 + lane * 4);
    const float* PART = (const float*)(p.ws + WS_PART);
    for (int row = bid * 8 + wid; row < T; row += G * 8) { f32x4 v[4];
#pragma unroll
        for (int i = 0; i < 4; ++i) v[i] = *(const f32x4*)(X + (size_t)row * D_MODEL + i * 256 + lane * 4);
        float rstd;
        if (row >= TP) {
            f32x4 ps[4];
#pragma unroll
            for (int i = 0; i < 4; ++i) ps[i] = (f32x4){0.f, 0.f, 0.f, 0.f};
#pragma unroll
            for (int kb = 0; kb < SPLITQ; kb += 4) { f32x4 q[4][4];
#pragma unroll
                for (int i = 0; i < 4; ++i)
#pragma unroll
                    for (int k = 0; k < 4; ++k) q[k][i] = *(const f32x4*)(PART + ((size_t)(kb + k) * TS + (row - TP)) * D_MODEL + i * 256 + lane * 4);
#pragma unroll
                for (int i = 0; i < 4; ++i) ps[i] = (((ps[i] + q[0][i]) + q[1][i]) + q[2][i]) + q[3][i]; }
            float s = 0.f;
#pragma unroll
            for (int i = 0; i < 4; ++i) { v[i] = v[i] + ps[i]; s += v[i][0] * v[i][0] + v[i][1] * v[i][1] + v[i][2] * v[i][2] + v[i][3] * v[i][3]; }
#pragma unroll
            for (int o = 1; o < 64; o <<= 1) s += shx(s, lane, o);
            rstd = rsqrtf(s * (1.f / D_MODEL) + EPS);
        } else rstd = rsqrtf(ssf(ss + row) * (1.f / D_MODEL) + EPS);
#pragma unroll
        for (int i = 0; i < 4; ++i) *(f32x4*)(p.out + (size_t)row * D_MODEL + i * 256 + lane * 4) = v[i] * rstd * wv[i]; }
}

#define XB_TMO      128
#define XB_XCNT(j)  (256  + 64 * (j))
#define XB_XSUB(j)  (1280 + 64 * (j))
#define XB_XGEN(j)  (2304 + 64 * (j))
#define XB_TOP      3328
#define XB_TOPGEN   3392
#define XCD_BAR_WORDS 3456
#define XB_SPIN_CAP (1u << 18)
__device__ __forceinline__ unsigned xb_ld(unsigned* p)              { return __hip_atomic_load(p, __ATOMIC_RELAXED, __HIP_MEMORY_SCOPE_AGENT); }
__device__ __forceinline__ unsigned xb_add(unsigned* p, unsigned v) { return __hip_atomic_fetch_add(p, v, __ATOMIC_RELAXED, __HIP_MEMORY_SCOPE_AGENT); }
__device__ __forceinline__ unsigned xb_xcc_id() { return (unsigned)__builtin_amdgcn_s_getreg((3 << 11) | 20) & 0xFu; }
#define XB_SPIN(cond, bar) do { unsigned _sp = 0; while (cond) { __builtin_amdgcn_s_sleep(1); \
    if ((++_sp & 255u) == 0u) { if (xb_ld(&(bar)[XB_TMO])) break; if (_sp > XB_SPIN_CAP) { atomicAdd(&(bar)[XB_TMO], 1u); break; } } } } while (0)
struct XcdBarrier { unsigned* bar; unsigned x; volatile LAS unsigned* st; };
__device__ __forceinline__ XcdBarrier xcd_barrier_post(unsigned* bar, volatile LAS unsigned* st) {
    XcdBarrier b; b.bar = bar; b.x = xb_xcc_id(); b.st = st;
    if (threadIdx.x == 0) (void)xb_add(&bar[XB_XCNT(b.x)], 1u);
    return b;
}
__device__ __forceinline__ void xcd_barrier_complete(unsigned* bar, unsigned x, unsigned& nloc, unsigned& nx) {
    const unsigned G = gridDim.x * gridDim.y * gridDim.z;
    unsigned sum, cnt, mine, sp = 0u;
    for (;;) {
        sum = 0u; cnt = 0u; mine = 0u;
#pragma unroll
        for (unsigned j = 0; j < 16; ++j) { const unsigned c = xb_ld(&bar[XB_XCNT(j)]); sum += c; cnt += (c > 0u) ? 1u : 0u; }
        if (sum == G) { mine = xb_ld(&bar[XB_XCNT(x)]); break; }
        __builtin_amdgcn_s_sleep(1);
        if ((++sp & 255u) == 0u) { if (xb_ld(&bar[XB_TMO])) break; if (sp > XB_SPIN_CAP) { atomicAdd(&bar[XB_TMO], 1u); break; } }
    }
    nloc = mine > 0u ? mine : 1u; nx = cnt > 0u ? cnt : 1u;
}
__device__ __forceinline__ void xcd_barrier(const XcdBarrier& b, const int tid) {
    asm volatile("s_waitcnt vmcnt(0)" ::: "memory");
    __syncthreads();
    if (tid == 0) {
        unsigned* bar = b.bar;
        __builtin_amdgcn_s_waitcnt(0);
        unsigned nloc = b.st[0], nx = b.st[1];
        if (nloc == 0u) { xcd_barrier_complete(bar, b.x, nloc, nx); b.st[0] = nloc; b.st[1] = nx; }
        const unsigned old = xb_add(&bar[XB_XSUB(b.x)], 1u);
        const unsigned gen = old / nloc;
        if (old + 1u == (gen + 1u) * nloc) {
            __builtin_amdgcn_fence(__ATOMIC_RELEASE, "agent");
            asm volatile("s_waitcnt vmcnt(0)" ::: "memory");
            const unsigned og = xb_add(&bar[XB_TOP], 1u);
            const unsigned tg = og / nx;
            if (og + 1u == (tg + 1u) * nx) xb_add(&bar[XB_TOPGEN], 1u);
            else XB_SPIN(xb_ld(&bar[XB_TOPGEN]) == tg, bar);
            __builtin_amdgcn_fence(__ATOMIC_ACQUIRE, "agent");
            xb_add(&bar[XB_XGEN(b.x)], 1u);
            asm volatile("s_waitcnt vmcnt(0)" ::: "memory");
        } else {
            XB_SPIN(xb_ld(&bar[XB_XGEN(b.x)]) == gen, bar);
            __builtin_amdgcn_fence(__ATOMIC_ACQUIRE, "agent");
            asm volatile("s_waitcnt vmcnt(0)" ::: "memory");
        }
    }
    __syncthreads();
}

constexpr int N_PHASES = 18;
#ifndef PH_MASK
#define PH_MASK 0x1ff
#endif
#define PH_ON(k) ((PH_MASK >> (k)) & 1)
#ifndef REP_MASK
#define REP_MASK 0
#endif
#define NREP(k) (((REP_MASK >> (k)) & 1) ? 2 : 1)
#define FRESH_TID(name) int name##_z = 0; asm volatile("" : "+v"(name##_z)); const int name = wid_s * 64 + (int)__builtin_amdgcn_mbcnt_hi(~0u, __builtin_amdgcn_mbcnt_lo(~0u, (unsigned)name##_z))
__global__ void __launch_bounds__(NTHREADS, 2) fwd_kernel(Params pin) {
    extern __shared__ __attribute__((aligned(16))) unsigned char shm[];
    volatile LAS unsigned* bst = (volatile LAS unsigned*)(LAS unsigned char*)(shm + LDS_STAGE);
    if (threadIdx.x == 0) { bst[0] = 0u; bst[1] = 0u; }
    __syncthreads();
    const XcdBarrier xbar = xcd_barrier_post((unsigned*)(pin.ws + WS_CTL), bst);
    const int wid_s = __builtin_amdgcn_readfirstlane((int)threadIdx.x >> 6);
    if (pin.ph_lo == 0) {
        const int bid = (int)blockIdx.x, G = (int)gridDim.x, tid = (int)threadIdx.x;
        if (PH_ON(0)) for (int rep = 0; rep < NREP(0); ++rep) phase_prep(pin, (unsigned char*)shm, bid, G, tid);
        if (pin.ph_hi > 1000) cg::this_grid().sync();
        else if (pin.ph_hi > 1) xcd_barrier(xbar, tid);
    }
    for (int ph = pin.ph_lo > 1 ? pin.ph_lo : 1; ph < pin.ph_hi; ++ph) {
        int sz = 0; asm volatile("" : "+s"(sz));
        const int bid = (int)blockIdx.x + sz, G = (int)gridDim.x + sz;
        Params p = pin; p.ws = pin.ws + sz; p.out = pin.out + sz;
        unsigned lb = (unsigned)(size_t)(LAS unsigned char*)shm; asm volatile("" : "+s"(lb));
        LAS unsigned char* const lds3 = (LAS unsigned char*)(size_t)lb; unsigned char* const ldsg = (unsigned char*)lds3;
        if (false) {}
        else if (ph == N_PHASES - 1) { if (PH_ON(1)) { FRESH_TID(t1); for (int rep = 0; rep < NREP(1); ++rep) phase_final(p, bid, G, t1); } }
        else {
            const int L = (ph - 1) >> 2, sub = (ph - 1) & 3, j = L >> 1; const bool ssd = L & 1;
            u64* SS = (u64*)(p.ws + WS_SS);
            if (sub == 0) {
                pg8::Sched S;
                if (!ssd) { if (PH_ON(2)) { S.init(NPANEL, 16, G, bid, 0, 16, 0);
                    pg8::Gemm g{(const bf16_t*)(p.ws + WS_XB), (const bf16_t*)(p.ws + WS_WPIN) + (size_t)j * 4096 * 1024, T, 4096, 1024};
                    pg8::EpiPoolIn E{(bf16_t*)(p.ws + WS_U), (bf16_t*)(p.ws + WS_Z), SS + (size_t)L * T};
                    FRESH_TID(t2); for (int rep = 0; rep < NREP(2); ++rep) pg8::gemm_phase(lds3, g, S, E, t2);
                    if (L == 0 && G > 64 && bid >= 64) prep_weights(p, ldsg, bid - 64, G - 64, t2, W_FIRST, G > 148 ? W_PER : -1); }
                } else if (PH_ON(3)) { S.init(NPANEL, SSD_IN_PAD / 256, G, bid, 0, 16, 0);
                    pg8::Gemm g{(const bf16_t*)(p.ws + WS_XB), (const bf16_t*)(p.ws + WS_WSIN) + (size_t)j * SSD_IN_PAD * 1024, T, SSD_IN_PAD, 1024};
                    pg8::EpiSsdIn E{(bf16_t*)(p.ws + WS_Z), (bf16_t*)(p.ws + WS_XBC), (float*)(p.ws + WS_DT), SS + (size_t)L * T, p.ssd_dt_bias + j * N_HEADS};
                    FRESH_TID(t3); for (int rep = 0; rep < NREP(3); ++rep) pg8::gemm_phase(lds3, g, S, E, t3);
                    if (L == 1 && G > 148 && bid >= 148) prep_weights(p, ldsg, bid - 148, G - 148, t3, W_PER, -1);
                }
            } else if (sub == 1) {
                if (!ssd) { if (PH_ON(4)) { FRESH_TID(t4); for (int rep = 0; rep < NREP(4); ++rep) phase_pool(p, j, bid, G, t4); } } else if (PH_ON(5)) { FRESH_TID(t5); for (int rep = 0; rep < NREP(5); ++rep) { phase_conv(p, j, bid, G, t5); decode_units(p, j, lds3, bid, G, t5, rep); } }
            } else if (sub == 2) {
                if (!ssd) { if (PH_ON(6)) { pg8::Sched S; S.init(NPANEL, 8, G, bid, 1, 8, 0);
                    pg8::Gemm g{(const bf16_t*)(p.ws + WS_P), (const bf16_t*)(p.ws + WS_WMIX) + (size_t)j * 2048 * 512, 4 * T, 2048, 512};
                    pg8::EpiPoolMix E{(bf16_t*)(p.ws + WS_Y), (const bf16_t*)(p.ws + WS_Z), p.pool_scale + j * D_INNER};
                    FRESH_TID(t6); for (int rep = 0; rep < NREP(6); ++rep) pg8::gemm_phase(lds3, g, S, E, t6); }
                } else if (PH_ON(7)) { FRESH_TID(t7); for (int rep = 0; rep < NREP(7); ++rep) phase_scan(p, j, ldsg, bid, G, t7, rep); }
            } else if (PH_ON(8)) {
                pg8::Sched S; S.init(64, 4, G, bid, 0, 32, 1);
                const bf16_t* Wt = ssd ? (const bf16_t*)(p.ws + WS_WSOUT) + (size_t)j * 1024 * 2048 : (const bf16_t*)(p.ws + WS_WPOUT) + (size_t)j * 1024 * 2048;
                pg8::Gemm g{(const bf16_t*)(p.ws + WS_Y), Wt, T, 1024, 2048};
                float* X = (float*)(p.ws + WS_X);
                pg8::EpiOut E{L == 0 ? p.x_prompt : X, L == 0 ? p.x_sample : X + (size_t)TP * D_MODEL, X, (bf16_t*)(p.ws + WS_XB), SS + (size_t)(L + 1) * T,
                              ssd ? (const u64*)(p.ws + WS_SS2) + (size_t)j * T : nullptr, 0, (float*)(p.ws + WS_PART)};
                FRESH_TID(t8); for (int rep = 0; rep < NREP(8); ++rep) { E.dry = rep; pg8::gemm_phase(lds3, g, S, E, t8); }
                if (L < 3) { xcd_barrier(xbar, t8); sample_fix(p, L, bid, G, t8); }
            }
        }
        if (ph + 1 < pin.ph_hi) { int tz2 = 0; asm volatile("" : "+v"(tz2));
            xcd_barrier(xbar, wid_s * 64 + (int)__builtin_amdgcn_mbcnt_hi(~0u, __builtin_amdgcn_mbcnt_lo(~0u, (unsigned)tz2))); }
    }
}

extern "C" void kernel_launch(void* const* d_in, const int* in_sizes, int n_in, void* d_out, int out_size, void* d_ws, size_t ws_size, hipStream_t stream) {
    static int grid = 0;
    if (grid == 0) {
        if (n_in != 19 || ws_size < WS_END) { fprintf(stderr, "kernel_launch: unexpected n_in %d / ws_size %zu (need %zu)\n", n_in, ws_size, (size_t)WS_END); grid = -1; return; }
        if (hipFuncSetAttribute((const void*)fwd_kernel, hipFuncAttributeMaxDynamicSharedMemorySize, LDS_BYTES) != hipSuccess) { fprintf(stderr, "kernel_launch: hipFuncSetAttribute failed\n"); grid = -1; return; }
        int dev = 0, cus = 0, per_cu = 0;
        hipGetDevice(&dev); hipDeviceGetAttribute(&cus, hipDeviceAttributeMultiprocessorCount, dev);
        hipOccupancyMaxActiveBlocksPerMultiprocessor(&per_cu, (const void*)fwd_kernel, NTHREADS, LDS_BYTES);
        (void)hipGetLastError();
        if (per_cu < 1) per_cu = 1;
        grid = cus;
    }
    if (grid < 0) return;
    Params p{};
    const float** f = (const float**)&p;
    for (int i = 0; i < 19; ++i) f[i] = (const float*)d_in[i];
    p.out = (float*)d_out; p.ws = (unsigned char*)d_ws;
    if (hipMemsetAsync((char*)d_ws + WS_CTL, 0, 16384, stream) != hipSuccess) { fprintf(stderr, "kernel_launch: memset failed\n"); return; }
#if MK_MULTI
    for (int ph = 0; ph < N_PHASES; ++ph) { p.ph_lo = ph; p.ph_hi = ph + 1; hipLaunchKernelGGL(fwd_kernel, dim3(grid), dim3(NTHREADS), LDS_BYTES, stream, p); }
#else
    p.ph_lo = 0; p.ph_hi = N_PHASES;
    void* args[] = {&p};
    hipError_t e = hipLaunchCooperativeKernel((const void*)fwd_kernel, dim3(grid), dim3(NTHREADS), args, LDS_BYTES, stream);
    if (e != hipSuccess) fprintf(stderr, "cooperative launch failed: %s (grid %d)\n", hipGetErrorString(e), grid);
#endif
}
```

```cpp
#include <hip/hip_runtime.h>
#include <hip/hip_cooperative_groups.h>
#include <cstdio>
#include <cstdint>
namespace cg = cooperative_groups;

#ifndef SPLITQ
#define SPLITQ 8
#endif
#ifndef MK_MULTI
#define MK_MULTI 0
#endif

constexpr int D_MODEL = 1024, BATCH = 8, SEQ = 2048, DEC_BATCH = 128, DEC_SEQ = 8;
constexpr int D_INNER = 2048, POOL_BUF = 15, N_HEADS = 32, D_STATE = 128, CONV_DIM = 3072, SSD_IN = 5152;
constexpr int TP = BATCH * SEQ;
constexpr int TS = DEC_BATCH * DEC_SEQ;
constexpr int T = TP + TS;
constexpr int NPANEL = T / 256;
constexpr int SSD_IN_PAD = 5376;
constexpr float EPS = 1e-6f;

constexpr size_t O_YP = 0, O_YS = O_YP + (size_t)TP * D_MODEL, O_POOLP = O_YS + (size_t)TS * D_MODEL,
                 O_POOLS = O_POOLP + (size_t)2 * BATCH * POOL_BUF * D_INNER, O_CONVP = O_POOLS + (size_t)2 * DEC_BATCH * POOL_BUF * D_INNER,
                 O_CONVS = O_CONVP + (size_t)2 * BATCH * 3 * CONV_DIM, O_SSMP = O_CONVS + (size_t)2 * DEC_BATCH * 3 * CONV_DIM,
                 O_SSMS = O_SSMP + (size_t)2 * BATCH * N_HEADS * 64 * D_STATE;

constexpr size_t al(size_t x) { return (x + 4095) & ~(size_t)4095; }
constexpr size_t WS_CTL = 0;
constexpr size_t WS_SS = 16384;
constexpr size_t WS_SS2 = al(WS_SS + (size_t)5 * T * 8);
constexpr size_t WS_WPIN = al(WS_SS2 + (size_t)2 * T * 8);
constexpr size_t WS_WMIX = al(WS_WPIN + (size_t)2 * 4096 * 1024 * 2);
constexpr size_t WS_WPOUT = al(WS_WMIX + (size_t)2 * 2048 * 512 * 2);
constexpr size_t WS_WSIN = al(WS_WPOUT + (size_t)2 * 1024 * 2048 * 2);
constexpr size_t WS_WSOUT = al(WS_WSIN + (size_t)2 * SSD_IN_PAD * 1024 * 2);
constexpr size_t WS_X = al(WS_WSOUT + (size_t)2 * 1024 * 2048 * 2);
constexpr size_t WS_XB = al(WS_X + (size_t)T * 1024 * 4);
constexpr size_t WS_U = al(WS_XB + (size_t)T * 1024 * 2);
constexpr size_t WS_Z = al(WS_U + (size_t)T * 2048 * 2);
constexpr size_t WS_P = al(WS_Z + (size_t)T * 2048 * 2);
constexpr size_t WS_Y = al(WS_P + (size_t)T * 2048 * 2);
constexpr size_t WS_XBC = al(WS_Y + (size_t)T * 2048 * 2);
constexpr size_t WS_XBCC = al(WS_XBC + (size_t)T * 3072 * 2);
constexpr size_t WS_DT = al(WS_XBCC + (size_t)T * 3072 * 2);
constexpr size_t WS_PART = al(WS_DT + (size_t)T * 32 * 4);
constexpr size_t WS_END = al(WS_PART + (size_t)8 * TS * 1024 * 4);

constexpr int LDS_STAGE = 158720;
constexpr int LDS_BYTES = LDS_STAGE + 64;
constexpr int NTHREADS = 512;

typedef unsigned short bf16_t;
typedef short bf16x8 __attribute__((ext_vector_type(8)));
typedef float f32x4 __attribute__((ext_vector_type(4)));
typedef float f32x2 __attribute__((ext_vector_type(2)));
typedef unsigned u32x4 __attribute__((ext_vector_type(4)));
typedef unsigned u32x2 __attribute__((ext_vector_type(2)));

struct Params {
    const float *x_prompt, *x_sample, *state_pool, *state_conv, *state_ssm, *norm_w, *pool_in_w, *pool_mix_w, *pool_scale, *pool_out_w,
        *ssd_in_w, *ssd_conv_w, *ssd_conv_b, *ssd_dt_bias, *ssd_A_log, *ssd_D, *ssd_norm_w, *ssd_out_w, *final_norm_w;
    float* out;
    unsigned char* ws;
    int ph_lo, ph_hi;
};

__device__ __forceinline__ unsigned cvt_pk_bf16(float lo, float hi) { unsigned r; asm volatile("v_cvt_pk_bf16_f32 %0, %1, %2" : "=v"(r) : "v"(lo), "v"(hi)); return r; }
__device__ __forceinline__ float bf_lo(unsigned u) { return __uint_as_float(u << 16); }
__device__ __forceinline__ float bf_hi(unsigned u) { return __uint_as_float(u & 0xffff0000u); }
__device__ __forceinline__ float bf1(bf16_t b) { return __uint_as_float(((unsigned)b) << 16); }
__device__ __forceinline__ float shx(float v, int lane, int m) { return __int_as_float(__builtin_amdgcn_ds_bpermute((lane ^ m) << 2, __float_as_int(v))); }
__device__ __forceinline__ float shup(float v, int lane, int d) { const int src = lane >= d ? lane - d : lane; return __int_as_float(__builtin_amdgcn_ds_bpermute(src << 2, __float_as_int(v))); }
typedef unsigned long long u64;
__device__ __forceinline__ u64 fx(float s) { const unsigned hi = (unsigned)s; const unsigned lo = (unsigned)((s - (float)hi) * 4294967296.f); return ((u64)hi << 32) | lo; }
__device__ __forceinline__ float ssf(const u64* p) { const u64 v = *p; return (float)(unsigned)(v >> 32) + (float)(unsigned)v * 2.3283064365386963e-10f; }
__device__ __forceinline__ float silu_f(float v) { return v * __builtin_amdgcn_rcpf(1.f + __expf(-v)); }
__device__ __forceinline__ float softplus_f(float v) { return fmaxf(v, 0.f) + __logf(1.f + __expf(-fabsf(v))); }

namespace pg8 {
#define PG8_LAS __attribute__((address_space(3)))
constexpr int BM = 256, BK = 64, HALF = 128, HTB = HALF * BK * 2, STAGE_BYTES = 8 * HTB, NXCD = 8, WGM = 8;
__host__ __device__ __forceinline__ int lds_byte(int r, int c) { const int st = (r >> 4) * 2 + (c >> 5), rr = r & 15, cc = c & 31, ob = rr * 64 + cc * 2; return st * 1024 + (ob ^ (((ob >> 9) & 1) << 5)); }
__host__ __device__ __forceinline__ void stage_rc(int b, int& R, int& C) { const int st = b / 1024, sb = b % 1024, swz = sb ^ (((sb >> 9) & 1) << 5); R = (st >> 1) * 16 + swz / 64; C = (st & 1) * 32 + (swz % 64) / 2; }
__host__ __device__ __forceinline__ int perm32(int rho) { const int n = rho >> 4, i = rho & 15; return 8 * (i >> 2) + 4 * n + (i & 3); }

struct Unit { int pm, pn, kofs, nt; };
struct Gemm { const bf16_t* A; const bf16_t* Bt; int M, N, K; };

struct Sched {
    int nM, nN, nwg, G, c, grouped, ntf, split;
    __device__ void init(int nM_, int nN_, int G_, int c_, int grouped_, int ntf_, int split_) { nM = nM_; nN = nN_; nwg = nM * nN + (split_ ? 16 * SPLITQ : 0); G = G_; c = c_; grouped = grouped_; ntf = ntf_; split = split_; }
    __device__ bool next(int i, Unit& u) const {
        const long L = (long)i * G + c; if (L >= nwg) return false;
        const int nfull = nM * nN;
        if (L >= nfull) { const int idx = (int)L - nfull, tile = idx / SPLITQ, q = idx % SPLITQ; u.pm = 64 + (tile >> 2); u.pn = tile & 3; u.kofs = q * (ntf / SPLITQ) * BK * 2; u.nt = ntf / SPLITQ; return true; }
        int wgid = (int)L; { const int q = nfull / NXCD, r = nfull % NXCD, xcd = wgid % NXCD, off = wgid / NXCD; wgid = (xcd < r ? xcd * (q + 1) : r * (q + 1) + (xcd - r) * q) + off; }
        const int nig = WGM * nN, gid = wgid / nig, fm = gid * WGM, gsz = (nM - fm) < WGM ? (nM - fm) : WGM;
        u.pm = fm + ((wgid % nig) % gsz); u.pn = (wgid % nig) / gsz; u.kofs = 0; u.nt = ntf;
        if (grouped) u.pm += (u.pn >> 1) * NPANEL;
        return true;
    }
    __device__ __forceinline__ void a_ready(const Unit&) const {}
    __device__ __forceinline__ void done(const Unit&) const {}
};

template <class Epi, class Sch>
__device__ __forceinline__ void gemm_phase(PG8_LAS unsigned char* lds, const Gemm g, const Sch& S, const Epi& E, const int tid) {
    const int wid = __builtin_amdgcn_readfirstlane(tid >> 6), lane = tid & 63, wr = wid >> 2, wc = wid & 3, fr = lane & 15, fq = lane >> 4;
    const int K = g.K;
    unsigned voffA[2], voffB[2];
#pragma unroll
    for (int i = 0; i < 2; ++i) { int R, C; stage_rc(tid * 16 + i * 8192, R, C); const int Rb = Epi::PERM ? ((R & ~31) + perm32(R & 31)) : R;
        voffA[i] = (unsigned)(R * K + C) * 2u; voffB[i] = (unsigned)(Rb * K + C) * 2u; }
    const size_t kstep = (size_t)(BK * 2);
    const size_t hstep = (size_t)HALF * K * 2;
    const size_t tstep = 2 * hstep;
    const unsigned ldsw = (unsigned)wid * 1024u;
    const int aoff = lds_byte(wr * 64 + fr, fq * 8), boff = lds_byte(wc * 32 + fr, fq * 8);
#define PG8_SA(b, h) (((b) * 2 + (h)) * HTB)
#define PG8_SB(b, h) ((4 + (b) * 2 + (h)) * HTB)
#define PG8_STAGE(bufoff, gbase, voff) do { _Pragma("unroll") for (int _i = 0; _i < 2; ++_i) \
        __builtin_amdgcn_global_load_lds((const unsigned*)((const char*)(gbase) + (voff)[_i]), (PG8_LAS unsigned*)(lds + (bufoff) + ldsw + _i * 8192), 16, 0, 0); } while (0)
#define PG8_LDA(dst, b, h) do { _Pragma("unroll") for (int m = 0; m < 4; ++m) _Pragma("unroll") for (int k = 0; k < 2; ++k) dst[m][k] = *(const PG8_LAS bf16x8*)(lds + PG8_SA(b, h) + aoff + m * 2048 + k * 1024); } while (0)
#define PG8_LDB(dst, b, h) do { _Pragma("unroll") for (int n = 0; n < 2; ++n) _Pragma("unroll") for (int k = 0; k < 2; ++k) dst[n][k] = *(const PG8_LAS bf16x8*)(lds + PG8_SB(b, h) + boff + n * 2048 + k * 1024); } while (0)
#define PG8_MMA(ai, bj, At, Bt) do { __builtin_amdgcn_s_setprio(1); _Pragma("unroll") for (int m = 0; m < 4; ++m) _Pragma("unroll") for (int n = 0; n < 2; ++n) _Pragma("unroll") for (int k = 0; k < 2; ++k) \
        acc[ai][bj][m][n] = __builtin_amdgcn_mfma_f32_16x16x32_bf16(Bt[n][k], At[m][k], acc[ai][bj][m][n], 0, 0, 0); __builtin_amdgcn_s_setprio(0); } while (0)
#define PG8_WAIT_V(n) asm volatile("s_waitcnt vmcnt(" #n ")" ::: "memory")
#define PG8_WAIT_L(n) asm volatile("s_waitcnt lgkmcnt(" #n ")" ::: "memory")
#define PG8_BAR __builtin_amdgcn_s_barrier()
#define PG8_SCHED __builtin_amdgcn_sched_barrier(0)
    Unit cur, nxt; int ui = 0;
    if (!S.next(0, cur)) return;
    f32x4 acc[2][2][4][2];
#pragma unroll
    for (int a = 0; a < 2; ++a)
#pragma unroll
        for (int b = 0; b < 2; ++b)
#pragma unroll
            for (int m = 0; m < 4; ++m)
#pragma unroll
                for (int n = 0; n < 2; ++n) acc[a][b][m][n] = (f32x4){0.f, 0.f, 0.f, 0.f};
    bf16x8 At[4][2], B0[2][2], B1[2][2];
    const char* cA = (const char*)g.A + (size_t)cur.pm * tstep + cur.kofs; const char* cB = (const char*)g.Bt + (size_t)cur.pn * tstep + cur.kofs;
    int nt = cur.nt;
    S.a_ready(cur);
    PG8_STAGE(PG8_SB(0, 0), cB, voffB); PG8_STAGE(PG8_SA(0, 0), cA, voffA); PG8_STAGE(PG8_SB(0, 1), cB + hstep, voffB); PG8_STAGE(PG8_SA(0, 1), cA + hstep, voffA);
    if (wr == 1) PG8_BAR;
    PG8_WAIT_V(4); PG8_BAR;
    PG8_STAGE(PG8_SB(1, 0), cB + kstep, voffB); PG8_STAGE(PG8_SA(1, 0), cA + kstep, voffA); PG8_STAGE(PG8_SB(1, 1), cB + hstep + kstep, voffB);
    PG8_WAIT_V(6); PG8_BAR;
    for (;;) {
        const bool has_next = S.next(ui + 1, nxt);
        const char* nA = has_next ? (const char*)g.A + (size_t)nxt.pm * tstep + nxt.kofs : cA; const char* nB = has_next ? (const char*)g.Bt + (size_t)nxt.pn * tstep + nxt.kofs : cB;
        for (int t = 0; t < nt; t += 2) {
            const bool last = (t == nt - 2);
            const char* a1 = cA + (size_t)(t + 1) * kstep;
            const char* a2 = last ? nA : cA + (size_t)(t + 2) * kstep; const char* b2 = last ? nB : cB + (size_t)(t + 2) * kstep;
            const char* a3 = a2 + kstep; const char* b3 = b2 + kstep;
            if (last && has_next) S.a_ready(nxt);
            PG8_LDB(B0, 0, 0); PG8_SCHED; PG8_LDA(At, 0, 0); PG8_STAGE(PG8_SA(1, 1), a1 + hstep, voffA);
            PG8_WAIT_L(8); PG8_BAR; PG8_WAIT_L(0); PG8_MMA(0, 0, At, B0); PG8_BAR; PG8_SCHED;
            PG8_LDB(B1, 0, 1); PG8_STAGE(PG8_SB(0, 0), b2, voffB);
            PG8_BAR; PG8_WAIT_L(0); PG8_MMA(0, 1, At, B1); PG8_BAR;
            PG8_LDA(At, 0, 1); PG8_STAGE(PG8_SA(0, 0), a2, voffA);
            PG8_BAR; PG8_WAIT_L(0); PG8_MMA(1, 0, At, B0); PG8_BAR; PG8_SCHED;
            PG8_STAGE(PG8_SB(0, 1), b2 + hstep, voffB);
            PG8_WAIT_V(6); PG8_BAR; PG8_MMA(1, 1, At, B1); PG8_BAR;
            PG8_LDB(B0, 1, 0); PG8_SCHED; PG8_LDA(At, 1, 0); PG8_STAGE(PG8_SA(0, 1), a2 + hstep, voffA);
            PG8_WAIT_L(8); PG8_BAR; PG8_WAIT_L(0); PG8_MMA(0, 0, At, B0); PG8_BAR; PG8_SCHED;
            PG8_LDB(B1, 1, 1); PG8_STAGE(PG8_SB(1, 0), b3, voffB);
            PG8_BAR; PG8_WAIT_L(0); PG8_MMA(0, 1, At, B1); PG8_BAR;
            PG8_LDA(At, 1, 1); PG8_STAGE(PG8_SA(1, 0), a3, voffA);
            PG8_BAR; PG8_WAIT_L(0); PG8_MMA(1, 0, At, B0); PG8_BAR; PG8_SCHED;
            PG8_STAGE(PG8_SB(1, 1), b3 + hstep, voffB);
            PG8_WAIT_V(6); PG8_BAR; PG8_MMA(1, 1, At, B1); PG8_BAR;
        }
        E(acc, cur, wr, wc, fr, fq); S.done(cur);
        if (!has_next) break;
#pragma unroll
        for (int a = 0; a < 2; ++a)
#pragma unroll
            for (int b = 0; b < 2; ++b)
#pragma unroll
                for (int m = 0; m < 4; ++m)
#pragma unroll
                    for (int n = 0; n < 2; ++n) acc[a][b][m][n] = (f32x4){0.f, 0.f, 0.f, 0.f};
        cur = nxt; cA = nA; cB = nB; nt = cur.nt; ++ui;
    }
    PG8_WAIT_V(0);
    if (wr == 0) PG8_BAR;
    PG8_BAR;
#undef PG8_SA
#undef PG8_SB
#undef PG8_STAGE
#undef PG8_LDA
#undef PG8_LDB
#undef PG8_MMA
#undef PG8_WAIT_V
#undef PG8_WAIT_L
#undef PG8_BAR
#undef PG8_SCHED
}

struct EpiPoolIn {
    static constexpr bool PERM = true;
    bf16_t* U; bf16_t* Z; const u64* ss;
    __device__ __forceinline__ void operator()(const f32x4 (&acc)[2][2][4][2], const Unit& u, int wr, int wc, int fr, int fq) const {
        const int row0 = u.pm * BM + wr * 64 + fr; const bool isz = u.pn >= 8; bf16_t* base = isz ? Z : U;
        const int col0 = (u.pn & 7) * BM + wc * 32 + 8 * fq;
        float rs[2][4];
#pragma unroll
        for (int ai = 0; ai < 2; ++ai)
#pragma unroll
            for (int m = 0; m < 4; ++m) rs[ai][m] = ssf(ss + row0 + ai * HALF + m * 16);
#pragma unroll
        for (int ai = 0; ai < 2; ++ai)
#pragma unroll
            for (int m = 0; m < 4; ++m) { const int row = row0 + ai * HALF + m * 16; const float rstd = rsqrtf(rs[ai][m] * (1.f / D_MODEL) + EPS);
                bf16_t* rowp = base + (size_t)row * D_INNER + col0;
#pragma unroll
                for (int bj = 0; bj < 2; ++bj) { f32x4 v0 = acc[ai][bj][m][0] * rstd, v1 = acc[ai][bj][m][1] * rstd;
                    if (isz) { v0[0] = silu_f(v0[0]); v0[1] = silu_f(v0[1]); v0[2] = silu_f(v0[2]); v0[3] = silu_f(v0[3]); v1[0] = silu_f(v1[0]); v1[1] = silu_f(v1[1]); v1[2] = silu_f(v1[2]); v1[3] = silu_f(v1[3]); }
                    u32x4 o; o[0] = cvt_pk_bf16(v0[0], v0[1]); o[1] = cvt_pk_bf16(v0[2], v0[3]); o[2] = cvt_pk_bf16(v1[0], v1[1]); o[3] = cvt_pk_bf16(v1[2], v1[3]);
                    *(u32x4*)(rowp + bj * HALF) = o; } }
    }
};
struct EpiPoolMix {
    static constexpr bool PERM = true;
    bf16_t* Y; const bf16_t* Z; const float* scale;
    __device__ __forceinline__ void operator()(const f32x4 (&acc)[2][2][4][2], const Unit& u, int wr, int wc, int fr, int fq) const {
        const int pm = u.pm - (u.pn >> 1) * NPANEL;
        const int row0 = pm * BM + wr * 64 + fr; const int col0 = u.pn * BM + wc * 32 + 8 * fq;
        f32x4 sc[2][2];
#pragma unroll
        for (int bj = 0; bj < 2; ++bj) { sc[bj][0] = *(const f32x4*)(scale + col0 + bj * HALF); sc[bj][1] = *(const f32x4*)(scale + col0 + bj * HALF + 4); }
#pragma unroll
        for (int ai = 0; ai < 2; ++ai) {
            u32x4 zz[4][2];
#pragma unroll
            for (int m = 0; m < 4; ++m)
#pragma unroll
                for (int bj = 0; bj < 2; ++bj) zz[m][bj] = *(const u32x4*)(Z + (size_t)(row0 + ai * HALF + m * 16) * D_INNER + col0 + bj * HALF);
#pragma unroll
            for (int m = 0; m < 4; ++m) { const size_t ro = (size_t)(row0 + ai * HALF + m * 16) * D_INNER + col0;
#pragma unroll
                for (int bj = 0; bj < 2; ++bj) { const u32x4 z4 = zz[m][bj];
                    f32x4 v0 = acc[ai][bj][m][0] * sc[bj][0], v1 = acc[ai][bj][m][1] * sc[bj][1];
                    v0[0] *= bf_lo(z4[0]); v0[1] *= bf_hi(z4[0]); v0[2] *= bf_lo(z4[1]); v0[3] *= bf_hi(z4[1]);
                    v1[0] *= bf_lo(z4[2]); v1[1] *= bf_hi(z4[2]); v1[2] *= bf_lo(z4[3]); v1[3] *= bf_hi(z4[3]);
                    u32x4 o; o[0] = cvt_pk_bf16(v0[0], v0[1]); o[1] = cvt_pk_bf16(v0[2], v0[3]); o[2] = cvt_pk_bf16(v1[0], v1[1]); o[3] = cvt_pk_bf16(v1[2], v1[3]);
                    *(u32x4*)(Y + ro + bj * HALF) = o; } } }
    }
};
struct EpiOut {
    static constexpr bool PERM = false;
    const float* xin_p; const float* xin_s;
    float* X; bf16_t* XB; u64* ssn; const u64* ss2; int dry; float* PART;
    __device__ __forceinline__ void operator()(const f32x4 (&acc)[2][2][4][2], const Unit& u, int wr, int wc, int fr, int fq) const {
        const int row0 = u.pm * BM + wr * 64 + fr, col0 = u.pn * BM + wc * 32 + 4 * fq;
        if (u.pm >= 64) {
            float* dst = PART + (size_t)(u.kofs / (u.nt * BK * 2)) * TS * D_MODEL;
            float r2[2][4];
#pragma unroll
            for (int ai = 0; ai < 2; ++ai)
#pragma unroll
                for (int m = 0; m < 4; ++m) r2[ai][m] = ss2 ? ssf(ss2 + row0 + ai * HALF + m * 16) : 0.f;
#pragma unroll
            for (int ai = 0; ai < 2; ++ai)
#pragma unroll
                for (int m = 0; m < 4; ++m) { const int row = row0 + ai * HALF + m * 16; const float rr = ss2 ? rsqrtf(r2[ai][m] * (1.f / D_INNER) + EPS) : 1.f;
#pragma unroll
                    for (int bj = 0; bj < 2; ++bj)
#pragma unroll
                        for (int n = 0; n < 2; ++n) *(f32x4*)(dst + (size_t)(row - TP) * D_MODEL + col0 + bj * HALF + n * 16) = acc[ai][bj][m][n] * rr; }
            return;
        }
#pragma unroll
        for (int ai = 0; ai < 2; ++ai)
#pragma unroll
            for (int mp = 0; mp < 2; ++mp) {
                f32x4 xv[2][2][2]; float r2[2];
#pragma unroll
                for (int mm = 0; mm < 2; ++mm) { const int row = row0 + ai * HALF + (2 * mp + mm) * 16;
                    const float* xo = (row < TP ? xin_p + (size_t)row * D_MODEL : xin_s + (size_t)(row - TP) * D_MODEL) + col0;
                    r2[mm] = ss2 ? ssf(ss2 + row) : 0.f;
#pragma unroll
                    for (int bj = 0; bj < 2; ++bj)
#pragma unroll
                        for (int n = 0; n < 2; ++n) xv[mm][bj][n] = *(const f32x4*)(xo + bj * HALF + n * 16); }
#pragma unroll
                for (int mm = 0; mm < 2; ++mm) { const int m = 2 * mp + mm, row = row0 + ai * HALF + m * 16;
                    const float rr = ss2 ? rsqrtf(r2[mm] * (1.f / D_INNER) + EPS) : 1.f;
                    float s = 0.f;
#pragma unroll
                    for (int bj = 0; bj < 2; ++bj)
#pragma unroll
                        for (int n = 0; n < 2; ++n) { const int co = bj * HALF + n * 16;
                            const f32x4 v = xv[mm][bj][n] + acc[ai][bj][m][n] * rr;
                            if (!dry) { *(f32x4*)(X + (size_t)row * D_MODEL + col0 + co) = v;
                                u32x2 o; o[0] = cvt_pk_bf16(v[0], v[1]); o[1] = cvt_pk_bf16(v[2], v[3]);
                                *(u32x2*)(XB + (size_t)row * D_MODEL + col0 + co) = o; }
                            s += v[0] * v[0] + v[1] * v[1] + v[2] * v[2] + v[3] * v[3]; }
                    { const int ln = fq * 16 + fr; s += shx(s, ln, 16); s += shx(s, ln, 32); }
                    if (fq == 0 && !dry) atomicAdd(ssn + row, fx(s)); } }
    }
};
struct EpiSsdIn {
    static constexpr bool PERM = true;
    bf16_t* Z; bf16_t* XBC; float* DT; const u64* ss; const float* dt_bias;
    __device__ __forceinline__ void operator()(const f32x4 (&acc)[2][2][4][2], const Unit& u, int wr, int wc, int fr, int fq) const {
        const int row0 = u.pm * BM + wr * 64 + fr;
        const int kind = u.pn < 8 ? 0 : (u.pn < 20 ? 1 : 2);
        const int colt = kind == 0 ? u.pn * BM : (u.pn - 8) * BM;
        const int col0 = colt + wc * 32 + 8 * fq;
        float rs[2][4];
#pragma unroll
        for (int ai = 0; ai < 2; ++ai)
#pragma unroll
            for (int m = 0; m < 4; ++m) rs[ai][m] = ssf(ss + row0 + ai * HALF + m * 16);
#pragma unroll
        for (int ai = 0; ai < 2; ++ai)
#pragma unroll
            for (int m = 0; m < 4; ++m) { const int row = row0 + ai * HALF + m * 16; const float rstd = rsqrtf(rs[ai][m] * (1.f / D_MODEL) + EPS);
#pragma unroll
                for (int bj = 0; bj < 2; ++bj) { f32x4 v0 = acc[ai][bj][m][0] * rstd, v1 = acc[ai][bj][m][1] * rstd;
                    if (kind == 2) {
                        if (bj == 0 && wc == 0) { const int c = 8 * fq;
                            f32x4 b0 = *(const f32x4*)(dt_bias + c), b1 = *(const f32x4*)(dt_bias + c + 4);
                            f32x4 o0, o1; o0[0] = softplus_f(v0[0] + b0[0]); o0[1] = softplus_f(v0[1] + b0[1]); o0[2] = softplus_f(v0[2] + b0[2]); o0[3] = softplus_f(v0[3] + b0[3]);
                            o1[0] = softplus_f(v1[0] + b1[0]); o1[1] = softplus_f(v1[1] + b1[1]); o1[2] = softplus_f(v1[2] + b1[2]); o1[3] = softplus_f(v1[3] + b1[3]);
                            *(f32x4*)(DT + (size_t)row * 32 + c) = o0; *(f32x4*)(DT + (size_t)row * 32 + c + 4) = o1; }
                    } else {
                        if (kind == 0) { v0[0] = silu_f(v0[0]); v0[1] = silu_f(v0[1]); v0[2] = silu_f(v0[2]); v0[3] = silu_f(v0[3]); v1[0] = silu_f(v1[0]); v1[1] = silu_f(v1[1]); v1[2] = silu_f(v1[2]); v1[3] = silu_f(v1[3]); }
                        u32x4 o; o[0] = cvt_pk_bf16(v0[0], v0[1]); o[1] = cvt_pk_bf16(v0[2], v0[3]); o[2] = cvt_pk_bf16(v1[0], v1[1]); o[3] = cvt_pk_bf16(v1[2], v1[3]);
                        bf16_t* dst = kind == 0 ? Z + (size_t)row * D_INNER : XBC + (size_t)row * CONV_DIM;
                        *(u32x4*)(dst + col0 + bj * HALF) = o; } } }
    }
};
}

__device__ __forceinline__ void transpose_item(const float* W, int K, int N, bf16_t* WT, const float* kscale, int k0, int n0, float* scr, int lane) {
    const int kr = lane >> 3, n4 = (lane & 7) * 4;
    f32x4 v[8]; float sc[8];
#pragma unroll
    for (int i = 0; i < 8; ++i) { v[i] = *(const f32x4*)(W + (size_t)(k0 + kr + 8 * i) * N + n0 + n4); sc[i] = kscale ? kscale[k0 + kr + 8 * i] : 1.f; }
#pragma unroll
    for (int i = 0; i < 8; ++i) { float* t = scr + (kr + 8 * i) * 33 + n4; t[0] = v[i][0] * sc[i]; t[1] = v[i][1] * sc[i]; t[2] = v[i][2] * sc[i]; t[3] = v[i][3] * sc[i]; }
    asm volatile("s_waitcnt lgkmcnt(0)" ::: "memory");
    const int c = lane & 7;
#pragma unroll
    for (int jn = 0; jn < 4; ++jn) { const int n = (lane >> 3) + 8 * jn; const float* t = scr + (8 * c) * 33 + n;
        u32x4 o; o[0] = cvt_pk_bf16(t[0], t[33]); o[1] = cvt_pk_bf16(t[2 * 33], t[3 * 33]); o[2] = cvt_pk_bf16(t[4 * 33], t[5 * 33]); o[3] = cvt_pk_bf16(t[6 * 33], t[7 * 33]);
        *(u32x4*)(WT + (size_t)(n0 + n) * K + k0 + 8 * c) = o; }
    asm volatile("s_waitcnt lgkmcnt(0)" ::: "memory");
}

constexpr int W_FIRST = 16 * 128, W_PER = 16 * 128 + 4 * 8 * 16 + 32 * 32 + 16 * 161 + 32 * 32;
__device__ __forceinline__ void prep_weights(const Params& p, unsigned char* lds, int vb, int VG, const int tid, int it_lo, int it_hi) {
    const int lane = tid & 63, wid = tid >> 6;
    float* scr = (float*)lds + wid * (64 * 33);
    constexpr int T_PIN = 16 * 128, T_MIX = 4 * 8 * 16, T_POUT = 32 * 32, T_SIN = 16 * 161, T_SOUT = 32 * 32, T_PER = T_PIN + T_MIX + T_POUT + T_SIN + T_SOUT;
    for (int it = it_lo + vb * 8 + wid; it < (it_hi < 0 ? 2 * T_PER : it_hi); it += VG * 8) {
        const int j = it / T_PER; int r = it % T_PER;
        if (r < T_PIN) { const int kb = r / 128, nb = r % 128;
            transpose_item(p.pool_in_w + (size_t)j * 1024 * 4096, 1024, 4096, (bf16_t*)(p.ws + WS_WPIN) + (size_t)j * 4096 * 1024, p.norm_w + (2 * j) * 1024, kb * 64, nb * 32, scr, lane); continue; }
        r -= T_PIN;
        if (r < T_MIX) { const int g = r / 128, kb = (r % 128) / 16, nb = r % 16;
            transpose_item(p.pool_mix_w + ((size_t)j * 4 + g) * 512 * 512, 512, 512, (bf16_t*)(p.ws + WS_WMIX) + ((size_t)j * 2048 + g * 512) * 512, nullptr, kb * 64, nb * 32, scr, lane); continue; }
        r -= T_MIX;
        if (r < T_POUT) { const int kb = r / 32, nb = r % 32;
            transpose_item(p.pool_out_w + (size_t)j * 2048 * 1024, 2048, 1024, (bf16_t*)(p.ws + WS_WPOUT) + (size_t)j * 1024 * 2048, nullptr, kb * 64, nb * 32, scr, lane); continue; }
        r -= T_POUT;
        if (r < T_SIN) { const int kb = r / 161, nb = r % 161;
            transpose_item(p.ssd_in_w + (size_t)j * 1024 * SSD_IN, 1024, SSD_IN, (bf16_t*)(p.ws + WS_WSIN) + (size_t)j * SSD_IN_PAD * 1024, p.norm_w + (2 * j + 1) * 1024, kb * 64, nb * 32, scr, lane); continue; }
        r -= T_SIN;
        { const int kb = r / 32, nb = r % 32;
            transpose_item(p.ssd_out_w + (size_t)j * 2048 * 1024, 2048, 1024, (bf16_t*)(p.ws + WS_WSOUT) + (size_t)j * 1024 * 2048, p.ssd_norm_w + j * 2048, kb * 64, nb * 32, scr, lane); }
    }
}

__device__ __forceinline__ void phase_prep(const Params& p, unsigned char* lds, int bid, int G, const int tid) {
    const int lane = tid & 63, wid = tid >> 6;
    prep_weights(p, lds, bid, G, tid, 0, G > 64 ? W_FIRST : -1);
    { const size_t gt = (size_t)bid * NTHREADS + tid, gn = (size_t)G * NTHREADS;
        for (int j = 0; j < 2; ++j) { u32x4* z = (u32x4*)((bf16_t*)(p.ws + WS_WSIN) + ((size_t)j * SSD_IN_PAD + SSD_IN) * 1024);
            const size_t n16 = (size_t)(SSD_IN_PAD - SSD_IN) * 1024 * 2 / 16;
            for (size_t i = gt; i < n16; i += gn) z[i] = (u32x4){0u, 0u, 0u, 0u}; }
        u64* ss = (u64*)(p.ws + WS_SS) + T; for (size_t i = gt; i < (size_t)4 * T; i += gn) ss[i] = 0ull;
        u64* ss2 = (u64*)(p.ws + WS_SS2); for (size_t i = gt; i < (size_t)2 * T; i += gn) ss2[i] = 0ull; }
    { u64* ss0 = (u64*)(p.ws + WS_SS); bf16_t* XB = (bf16_t*)(p.ws + WS_XB);
        for (int row = bid * 8 + wid; row < T; row += G * 8) {
            const float* xr = row < TP ? p.x_prompt + (size_t)row * D_MODEL : p.x_sample + (size_t)(row - TP) * D_MODEL;
            float s = 0.f; f32x4 v[4];
#pragma unroll
            for (int i = 0; i < 4; ++i) v[i] = *(const f32x4*)(xr + i * 256 + lane * 4);
#pragma unroll
            for (int i = 0; i < 4; ++i) {
                s += v[i][0] * v[i][0] + v[i][1] * v[i][1] + v[i][2] * v[i][2] + v[i][3] * v[i][3];
                u32x2 o; o[0] = cvt_pk_bf16(v[i][0], v[i][1]); o[1] = cvt_pk_bf16(v[i][2], v[i][3]);
                *(u32x2*)(XB + (size_t)row * D_MODEL + i * 256 + lane * 4) = o; }
#pragma unroll
            for (int o = 1; o < 64; o <<= 1) s += shx(s, lane, o);
            if (lane == 0) ss0[row] = fx(s); } }
}

__device__ __forceinline__ void ld8(const bf16_t* p, float (&v)[8]) { const u32x4 u = *(const u32x4*)p;
    v[0] = bf_lo(u[0]); v[1] = bf_hi(u[0]); v[2] = bf_lo(u[1]); v[3] = bf_hi(u[1]); v[4] = bf_lo(u[2]); v[5] = bf_hi(u[2]); v[6] = bf_lo(u[3]); v[7] = bf_hi(u[3]); }
__device__ __forceinline__ void ld8f(const float* p, float (&v)[8]) { const f32x4 a = *(const f32x4*)p, b = *(const f32x4*)(p + 4);
    v[0] = a[0]; v[1] = a[1]; v[2] = a[2]; v[3] = a[3]; v[4] = b[0]; v[5] = b[1]; v[6] = b[2]; v[7] = b[3]; }
__device__ __forceinline__ void st8(bf16_t* p, const float (&v)[8]) { u32x4 o; o[0] = cvt_pk_bf16(v[0], v[1]); o[1] = cvt_pk_bf16(v[2], v[3]); o[2] = cvt_pk_bf16(v[4], v[5]); o[3] = cvt_pk_bf16(v[6], v[7]); *(u32x4*)p = o; }
__device__ __forceinline__ void st8f(float* p, const float (&v)[8]) { *(f32x4*)p = (f32x4){v[0], v[1], v[2], v[3]}; *(f32x4*)(p + 4) = (f32x4){v[4], v[5], v[6], v[7]}; }

__device__ __forceinline__ void up8(const u32x4 u, float (&v)[8]) { v[0] = bf_lo(u[0]); v[1] = bf_hi(u[0]); v[2] = bf_lo(u[1]); v[3] = bf_hi(u[1]); v[4] = bf_lo(u[2]); v[5] = bf_hi(u[2]); v[6] = bf_lo(u[3]); v[7] = bf_hi(u[3]); }
__device__ __forceinline__ u32x4 pk8f(const float* p) { const f32x4 a = *(const f32x4*)p, b = *(const f32x4*)(p + 4); u32x4 o; o[0] = cvt_pk_bf16(a[0], a[1]); o[1] = cvt_pk_bf16(a[2], a[3]); o[2] = cvt_pk_bf16(b[0], b[1]); o[3] = cvt_pk_bf16(b[2], b[3]); return o; }

template <int W, int NR, bool PROMPT>
__device__ __forceinline__ void pool_run(const Params& p, int j, const bf16_t* U, bf16_t* P, int run, int c0, int g) {
    const int cl = c0 - g * 512;
    u32x4 ext[W - 1 + NR];
    int row0, t0 = 0, b = 0, sb = 0;
    if (PROMPT) { row0 = run * NR; t0 = row0 & (SEQ - 1); b = row0 >> 11;
#pragma unroll
        for (int k = 0; k < W - 1; ++k) ext[k] = (t0 - (W - 1 - k) >= 0) ? *(const u32x4*)(U + (size_t)(row0 - (W - 1 - k)) * D_INNER + c0) : (u32x4){0u, 0u, 0u, 0u};
    } else { sb = run; row0 = TP + sb * DEC_SEQ;
        const float* buf = p.state_pool + (((size_t)j * DEC_BATCH + sb) * POOL_BUF) * D_INNER + c0;
#pragma unroll
        for (int k = 0; k < W - 1; ++k) ext[k] = pk8f(buf + (size_t)(POOL_BUF - (W - 1 - k)) * D_INNER); }
#pragma unroll
    for (int t = 0; t < NR; ++t) ext[W - 1 + t] = *(const u32x4*)(U + (size_t)(row0 + t) * D_INNER + c0);
    float sum[8], u[8], o[8];
#pragma unroll
    for (int e = 0; e < 8; ++e) sum[e] = 0.f;
#pragma unroll
    for (int k = 0; k < W - 1; ++k) { up8(ext[k], u);
#pragma unroll
        for (int e = 0; e < 8; ++e) sum[e] += u[e]; }
#pragma unroll
    for (int t = 0; t < NR; ++t) { const int row = row0 + t; up8(ext[W - 1 + t], u);
        const float inv = PROMPT ? 1.f / (float)min(t0 + t + 1, W) : 1.f / (float)W;
#pragma unroll
        for (int e = 0; e < 8; ++e) { sum[e] += u[e]; o[e] = sum[e] * inv - u[e]; }
        st8(P + ((size_t)g * T + row) * 512 + cl, o);
        if (PROMPT) { if (t0 + t >= SEQ - POOL_BUF) st8f(p.out + O_POOLP + (((size_t)j * BATCH + b) * POOL_BUF + (t0 + t - (SEQ - POOL_BUF))) * D_INNER + c0, u); }
        else st8f(p.out + O_POOLS + (((size_t)j * DEC_BATCH + sb) * POOL_BUF + (POOL_BUF - DEC_SEQ + t)) * D_INNER + c0, u);
        up8(ext[t], u);
#pragma unroll
        for (int e = 0; e < 8; ++e) sum[e] -= u[e]; }
}

__device__ __forceinline__ void phase_pool(const Params& p, int j, int bid, int G, const int tid) {
    const bf16_t* U = (const bf16_t*)(p.ws + WS_U); bf16_t* P = (bf16_t*)(p.ws + WS_P);
    const int NPR = (TP / 8) * 256, NSA = DEC_BATCH * 256;
    for (int it = bid * NTHREADS + tid; it < NPR + NSA; it += G * NTHREADS) {
        const int chunk = it & 255, run = it >> 8, c0 = chunk * 8, g = __builtin_amdgcn_readfirstlane(chunk >> 6);
        if (run < TP / 8) {
            if (g == 0) pool_run<2, 8, true>(p, j, U, P, run, c0, 0); else if (g == 1) pool_run<4, 8, true>(p, j, U, P, run, c0, 1);
            else if (g == 2) pool_run<8, 8, true>(p, j, U, P, run, c0, 2); else pool_run<16, 8, true>(p, j, U, P, run, c0, 3);
        } else { const int sb = run - TP / 8;
            if (g == 0) pool_run<2, 8, false>(p, j, U, P, sb, c0, 0); else if (g == 1) pool_run<4, 8, false>(p, j, U, P, sb, c0, 1);
            else if (g == 2) pool_run<8, 8, false>(p, j, U, P, sb, c0, 2); else pool_run<16, 8, false>(p, j, U, P, sb, c0, 3);
            const float* buf = p.state_pool + (((size_t)j * DEC_BATCH + sb) * POOL_BUF) * D_INNER + c0;
            float* po = p.out + O_POOLS + (((size_t)j * DEC_BATCH + sb) * POOL_BUF) * D_INNER + c0;
            f32x4 cp[POOL_BUF - DEC_SEQ][2];
#pragma unroll
            for (int i = 0; i < POOL_BUF - DEC_SEQ; ++i) { cp[i][0] = *(const f32x4*)(buf + (size_t)(DEC_SEQ + i) * D_INNER); cp[i][1] = *(const f32x4*)(buf + (size_t)(DEC_SEQ + i) * D_INNER + 4); }
#pragma unroll
            for (int i = 0; i < POOL_BUF - DEC_SEQ; ++i) { *(f32x4*)(po + (size_t)i * D_INNER) = cp[i][0]; *(f32x4*)(po + (size_t)i * D_INNER + 4) = cp[i][1]; }
        }
    }
}

__device__ __forceinline__ void phase_conv(const Params& p, int j, int bid, int G, const int tid) {
    const bf16_t* R = (const bf16_t*)(p.ws + WS_XBC); bf16_t* O = (bf16_t*)(p.ws + WS_XBCC);
    const int NIT = (T / 8) * 384;
    for (int it = bid * NTHREADS + tid; it < NIT; it += G * NTHREADS) {
        const int chunk = it % 384, run = it / 384, c0 = chunk * 8, row0 = run * 8;
        float w0[8], w1[8], w2[8], w3[8], bs[8], h1[8], h2[8], h3[8], cur[8], o[8];
        const bool prompt = row0 < TP; const int t0 = prompt ? (row0 & (SEQ - 1)) : 0;
        u32x4 rr[8];
#pragma unroll
        for (int t = 0; t < 8; ++t) rr[t] = *(const u32x4*)(R + (size_t)(row0 + t) * CONV_DIM + c0);
        if (prompt) {
            if (t0 > 0) { ld8(R + (size_t)(row0 - 3) * CONV_DIM + c0, h3); ld8(R + (size_t)(row0 - 2) * CONV_DIM + c0, h2); ld8(R + (size_t)(row0 - 1) * CONV_DIM + c0, h1); }
            else {
#pragma unroll
                for (int e = 0; e < 8; ++e) { h1[e] = 0.f; h2[e] = 0.f; h3[e] = 0.f; } }
        } else { const int sb = (row0 - TP) >> 3; const float* sc = p.state_conv + (((size_t)j * DEC_BATCH + sb) * 3) * CONV_DIM + c0;
            ld8f(sc, h3); ld8f(sc + CONV_DIM, h2); ld8f(sc + 2 * CONV_DIM, h1); }
        const float* cw = p.ssd_conv_w + (size_t)j * 4 * CONV_DIM + c0;
        ld8f(cw, w0); ld8f(cw + CONV_DIM, w1); ld8f(cw + 2 * CONV_DIM, w2); ld8f(cw + 3 * CONV_DIM, w3); ld8f(p.ssd_conv_b + (size_t)j * CONV_DIM + c0, bs);
#pragma unroll
        for (int t = 0; t < 8; ++t) { const int row = row0 + t;
            up8(rr[t], cur);
#pragma unroll
            for (int e = 0; e < 8; ++e) { const float v = w0[e] * h3[e] + w1[e] * h2[e] + w2[e] * h1[e] + w3[e] * cur[e] + bs[e]; o[e] = silu_f(v); h3[e] = h2[e]; h2[e] = h1[e]; h1[e] = cur[e]; }
            st8(O + (size_t)row * CONV_DIM + c0, o);
            if (prompt) { const int tt = t0 + t; if (tt >= SEQ - 3) st8f(p.out + O_CONVP + (((size_t)j * BATCH + (row0 >> 11)) * 3 + (tt - (SEQ - 3))) * CONV_DIM + c0, cur); }
            else if (t >= DEC_SEQ - 3) st8f(p.out + O_CONVS + (((size_t)j * DEC_BATCH + ((row0 - TP) >> 3)) * 3 + (t - (DEC_SEQ - 3))) * CONV_DIM + c0, cur);
        }
    }
}

#define LAS __attribute__((address_space(3)))
constexpr int RS = 272;
constexpr int L_CS = 0, L_BS = 128 * RS, L_WS = 2 * 128 * RS, L_XT = 3 * 128 * RS, L_XW = L_XT + 64 * RS, L_HS = L_XW + 64 * RS, L_DT = L_HS + 64 * RS  ,
              L_AC = L_DT + 1024  , L_END = L_AC + 1024;
static_assert(L_END <= LDS_STAGE, "scan LDS");
typedef const LAS bf16x8* lfrag_t;
#define LFRAG(ptr, off) (*(lfrag_t)((ptr) + (off)))

__device__ __forceinline__ void scan_unit(const Params& p, int j, LAS unsigned char* L, int unit, const int tid, const int dry) {
    const int lane = tid & 63, w = __builtin_amdgcn_readfirstlane(tid >> 6), fr = lane & 15, fq = lane >> 4;
    const int b = unit >> 5, h = unit & 31, g = h >> 3;
    const bf16_t* XC = (const bf16_t*)(p.ws + WS_XBCC); const bf16_t* Z = (const bf16_t*)(p.ws + WS_Z); const float* DT = (const float*)(p.ws + WS_DT);
    bf16_t* YG = (bf16_t*)(p.ws + WS_Y); u64* ss2 = (u64*)(p.ws + WS_SS2) + (size_t)j * T;
    const float A = -__expf(p.ssd_A_log[j * N_HEADS + h]), Dh = p.ssd_D[j * N_HEADS + h];
    LAS unsigned char* const pCf = L + L_CS + (16 * w + fr) * RS + fq * 16;
    LAS unsigned char* const pBf = L + L_BS + fr * RS + fq * 16;
    LAS unsigned char* const pWr = L + L_WS + (16 * w + fr) * RS + fq * 8;
    LAS unsigned char* const pWf = L + L_WS + (16 * w + fr) * RS + fq * 16;
    LAS unsigned char* const pXf = L + L_XT + fr * RS + fq * 16;
    LAS unsigned char* const pBg = L + L_BS + (fq * 8) * RS + (16 * w + fr) * 2;
    LAS unsigned char* const pSt = L + L_CS + (tid >> 4) * RS + (tid & 15) * 16;
    LAS unsigned char* const pSx = L + L_XT + ((tid >> 7) * 8) * RS + (tid & 127) * 2;
    LAS unsigned char* const pXe = L + L_XT + (fq * 4) * RS + (16 * w + fr) * 2;
    LAS unsigned char* const pDq = L + L_DT + fq * 16;
    LAS unsigned char* const pDj = L + L_DT + (tid & 127) * 4;
    LAS unsigned char* const pDi = L + L_AC + (16 * w + fr) * 4;
    LAS unsigned char* const pHw = L + L_HS + fr * RS + (16 * w + fq * 4) * 2;
    f32x4 hacc[4];
#pragma unroll
    for (int i = 0; i < 4; ++i) hacc[i] = (f32x4){0.f, 0.f, 0.f, 0.f};
    for (int i = tid; i < 64 * RS / 16; i += NTHREADS) *(LAS u32x4*)(L + L_HS + i * 16) = (u32x4){0u, 0u, 0u, 0u};
    u32x4 creg[4], breg[4], xreg[2]; float d0 = 0.f, d1 = 0.f;
    const unsigned voffT = (unsigned)((tid >> 4) * CONV_DIM + (tid & 15) * 8) * 2u, voffX = (unsigned)((tid & 127) * CONV_DIM + (tid >> 7) * 8) * 2u;
#define SCAN_PREFETCH(c_) do { const int r0_ = b * SEQ + (c_) * 128; \
        const char* bB_ = (const char*)(XC + (size_t)r0_ * CONV_DIM + D_INNER + g * 128); const char* bX_ = (const char*)(XC + (size_t)r0_ * CONV_DIM + h * 64); \
        _Pragma("unroll") for (int i = 0; i < 4; ++i) { \
            breg[i] = *(const u32x4*)(bB_ + (size_t)i * (32 * CONV_DIM * 2) + voffT); creg[i] = *(const u32x4*)(bB_ + (size_t)i * (32 * CONV_DIM * 2) + 1024 + voffT); } \
        _Pragma("unroll") for (int i = 0; i < 2; ++i) xreg[i] = *(const u32x4*)(bX_ + i * 64 + voffX); \
        if (w == 0) { d0 = DT[(size_t)(r0_ + 2 * lane) * 32 + h]; d1 = DT[(size_t)(r0_ + 2 * lane + 1) * 32 + h]; } } while (0)
    SCAN_PREFETCH(0);
#pragma unroll 1
    for (int c = 0; c < SEQ / 128; ++c) {
        const int r0 = b * SEQ + c * 128;
        const int po = (c & 1) * 512;
        if (w == 0) { const float a0 = d0 * A, a1 = d1 * A; float v = a0 + a1;
#pragma unroll
            for (int o = 1; o < 64; o <<= 1) { const float t = shup(v, lane, o); if (lane >= o) v += t; }
            *(LAS f32x2*)(L + L_DT + po + lane * 8) = (f32x2){d0, d1}; *(LAS f32x2*)(L + L_AC + po + lane * 8) = (f32x2){v - a1, v}; }
        __syncthreads();
        const float aend = *(const LAS float*)(L + L_AC + po + 127 * 4);
#pragma unroll
        for (int i = 0; i < 4; ++i) { *(LAS u32x4*)(pSt + 128 * RS + i * 32 * RS) = breg[i]; *(LAS u32x4*)(pSt + i * 32 * RS) = creg[i]; }
        { const float wj = __expf(aend - *(const LAS float*)(pDj + 1024 + po)) * *(const LAS float*)(pDj + po);
#pragma unroll
            for (int i = 0; i < 2; ++i)
#pragma unroll
                for (int e2 = 0; e2 < 4; ++e2) { const unsigned u = xreg[i][e2]; const float x0 = bf_lo(u), x1 = bf_hi(u);
                    const int ro = (i * 32 + e2 * 2) * RS;
                    *(LAS bf16_t*)(pSx + ro) = (bf16_t)(u & 0xffffu); *(LAS bf16_t*)(pSx + ro + RS) = (bf16_t)(u >> 16);
                    const unsigned s = cvt_pk_bf16(x0 * wj, x1 * wj);
                    *(LAS bf16_t*)(pSx + 64 * RS + ro) = (bf16_t)(s & 0xffffu); *(LAS bf16_t*)(pSx + 64 * RS + ro + RS) = (bf16_t)(s >> 16); } }
#pragma unroll
        for (int pt = 0; pt < 4; ++pt) { u32x2 o; o[0] = cvt_pk_bf16(hacc[pt][0], hacc[pt][1]); o[1] = cvt_pk_bf16(hacc[pt][2], hacc[pt][3]);
            *(LAS u32x2*)(pHw + pt * 16 * RS) = o; }
        const int irow = r0 + 16 * w + fr;
        u32x2 zreg[4];
#pragma unroll
        for (int pt = 0; pt < 4; ++pt) zreg[pt] = *(const u32x2*)(Z + (size_t)irow * D_INNER + h * 64 + pt * 16 + fq * 4);
        __syncthreads();
        u32x2 wpk[8]; float ea;
        {
            bf16x8 cf[4];
#pragma unroll
            for (int ks = 0; ks < 4; ++ks) cf[ks] = LFRAG(pCf, ks * 64);
            const int i = 16 * w + fr; const float aci = *(const LAS float*)(pDi + po); ea = __expf(aci);
#pragma unroll
            for (int j2 = 0; j2 < 4; ++j2) {
                wpk[2 * j2] = (u32x2){0u, 0u}; wpk[2 * j2 + 1] = (u32x2){0u, 0u};
                if (2 * j2 <= w) {
                    f32x4 g0 = (f32x4){0.f, 0.f, 0.f, 0.f}, g1 = (f32x4){0.f, 0.f, 0.f, 0.f};
#pragma unroll
                    for (int ks = 0; ks < 4; ++ks) { g0 = __builtin_amdgcn_mfma_f32_16x16x32_bf16(LFRAG(pBf, (2 * j2) * 16 * RS + ks * 64), cf[ks], g0, 0, 0, 0);
                        g1 = __builtin_amdgcn_mfma_f32_16x16x32_bf16(LFRAG(pBf, (2 * j2 + 1) * 16 * RS + ks * 64), cf[ks], g1, 0, 0, 0); }
#pragma unroll
                    for (int hh = 0; hh < 2; ++hh) { const int jt = 2 * j2 + hh, j0 = jt * 16 + fq * 4; const f32x4 gg = hh ? g1 : g0;
                        const f32x4 dtj = *(const LAS f32x4*)(pDq + po + jt * 64), acj = *(const LAS f32x4*)(pDq + 1024 + po + jt * 64);
                        float v[4];
#pragma unroll
                        for (int r = 0; r < 4; ++r) v[r] = (j0 + r <= i) ? gg[r] * __expf(aci - acj[r]) * dtj[r] : 0.f;
                        wpk[jt][0] = cvt_pk_bf16(v[0], v[1]); wpk[jt][1] = cvt_pk_bf16(v[2], v[3]); }
                }
                __builtin_amdgcn_sched_barrier(0);
            }
        }
        {
            const float dec = __expf(aend);
#pragma unroll
            for (int pt = 0; pt < 4; ++pt) hacc[pt] = hacc[pt] * dec;
#pragma unroll
            for (int ks = 0; ks < 4; ++ks) { bf16x8 bg;
#pragma unroll
                for (int e = 0; e < 8; ++e) bg[e] = *(const LAS short*)(pBg + (ks * 32 + e) * RS);
#pragma unroll
                for (int pt = 0; pt < 4; ++pt) hacc[pt] = __builtin_amdgcn_mfma_f32_16x16x32_bf16(bg, LFRAG(pXf, 64 * RS + pt * 16 * RS + ks * 64), hacc[pt], 0, 0, 0);
                __builtin_amdgcn_sched_barrier(0); }
        }
        if (c + 1 < SEQ / 128) SCAN_PREFETCH(c + 1);
#pragma unroll
        for (int jt = 0; jt < 8; ++jt) *(LAS u32x2*)(pWr + jt * 32) = wpk[jt];
        asm volatile("s_waitcnt lgkmcnt(0)" ::: "memory");
        {
            f32x4 yd[4], yoff[4];
#pragma unroll
            for (int pt = 0; pt < 4; ++pt) { yd[pt] = (f32x4){0.f, 0.f, 0.f, 0.f}; yoff[pt] = (f32x4){0.f, 0.f, 0.f, 0.f}; }
            LAS unsigned char* const pHf = pXf + 2 * 64 * RS;
#pragma unroll
            for (int ks = 0; ks < 4; ++ks) { const bf16x8 cfk = LFRAG(pCf, ks * 64);
#pragma unroll
                for (int pt = 0; pt < 4; ++pt) yoff[pt] = __builtin_amdgcn_mfma_f32_16x16x32_bf16(LFRAG(pHf, pt * 16 * RS + ks * 64), cfk, yoff[pt], 0, 0, 0);
                __builtin_amdgcn_sched_barrier(0); }
#pragma unroll
            for (int ks = 0; ks < 4; ++ks) if (2 * ks <= w) { const bf16x8 wf = LFRAG(pWf, ks * 64);
#pragma unroll
                for (int pt = 0; pt < 4; ++pt) yd[pt] = __builtin_amdgcn_mfma_f32_16x16x32_bf16(LFRAG(pXf, pt * 16 * RS + ks * 64), wf, yd[pt], 0, 0, 0);
                __builtin_amdgcn_sched_barrier(0); }
            float s = 0.f;
#pragma unroll
            for (int pt = 0; pt < 4; ++pt) { const int p0 = pt * 16 + fq * 4;
                float y[4];
#pragma unroll
                for (int r = 0; r < 4; ++r) { const float x = bf1(*(const LAS bf16_t*)(pXe + (pt * 16 + r) * RS)); y[r] = yd[pt][r] + ea * yoff[pt][r] + Dh * x; }
                y[0] *= bf_lo(zreg[pt][0]); y[1] *= bf_hi(zreg[pt][0]); y[2] *= bf_lo(zreg[pt][1]); y[3] *= bf_hi(zreg[pt][1]);
                s += y[0] * y[0] + y[1] * y[1] + y[2] * y[2] + y[3] * y[3];
                u32x2 o; o[0] = cvt_pk_bf16(y[0], y[1]); o[1] = cvt_pk_bf16(y[2], y[3]);
                *(u32x2*)(YG + (size_t)irow * D_INNER + h * 64 + p0) = o; }
            s += shx(s, lane, 16); s += shx(s, lane, 32);
            if (fq == 0 && !dry) atomicAdd(ss2 + irow, fx(s));
        }
    }
#undef SCAN_PREFETCH
    float* so = p.out + O_SSMP + (((size_t)j * BATCH + b) * N_HEADS + h) * 64 * D_STATE;
#pragma unroll
    for (int pt = 0; pt < 4; ++pt) *(f32x4*)(so + (size_t)(pt * 16 + fr) * D_STATE + 16 * w + fq * 4) = hacc[pt];
    __syncthreads();
}

__device__ __forceinline__ void phase_scan(const Params& p, int j, unsigned char* lds, int bid, int G, const int tid, const int dry) {
    for (int v = bid; v < BATCH * N_HEADS; v += G) { const int x = v & 7, slot = v >> 3, gi = x * 4 + (slot >> 3);
        const int u = (gi >> 2) * N_HEADS + (gi & 3) * 8 + (slot & 7);
        scan_unit(p, j, (LAS unsigned char*)lds, u, tid, dry); }
}

constexpr int D_TOK = 0  , D_YS = 8 * 320 * 4  , D_SDT = D_YS + 8 * 64 * 4  ;
__device__ __forceinline__ void decode_units(const Params& p, int j, LAS unsigned char* L, int bid, int G, const int tid, const int dry) {
    const int lane = tid & 63, w = __builtin_amdgcn_readfirstlane(tid >> 6), pp = tid >> 3, n0 = (tid & 7) * 16;
    const bf16_t* R = (const bf16_t*)(p.ws + WS_XBC); const bf16_t* Z = (const bf16_t*)(p.ws + WS_Z); const float* DT = (const float*)(p.ws + WS_DT);
    bf16_t* YG = (bf16_t*)(p.ws + WS_Y); u64* ss2 = (u64*)(p.ws + WS_SS2) + (size_t)j * T;
    const int NU = DEC_BATCH * N_HEADS;
    f32x4 hv[4], hvn[4]; float raw[8], rawn[8], hist[3], histn[3], cw[5], cwn[5]; float sd = 0.f, sdn = 0.f, zs = 0.f, zsn = 0.f;
#pragma unroll
    for (int i = 0; i < 8; ++i) { raw[i] = 0.f; rawn[i] = 0.f; }
#pragma unroll
    for (int i = 0; i < 3; ++i) { hist[i] = 0.f; histn[i] = 0.f; }
#pragma unroll
    for (int i = 0; i < 5; ++i) { cw[i] = 0.f; cwn[i] = 0.f; }
#define DEC_LOAD(u_, HV, RAW, HIST, CW, SD, ZS) do { const int sb_ = (u_) >> 5, h_ = (u_) & 31, g_ = h_ >> 3, row0_ = TP + sb_ * DEC_SEQ; \
        const float* sp_ = p.state_ssm + ((((size_t)j * DEC_BATCH + sb_) * N_HEADS + h_) * 64 + pp) * D_STATE + n0; \
        _Pragma("unroll") for (int i = 0; i < 4; ++i) HV[i] = *(const f32x4*)(sp_ + 4 * i); \
        if (tid < 320) { const int col_ = tid < 64 ? h_ * 64 + tid : (tid < 192 ? D_INNER + g_ * 128 + (tid - 64) : D_INNER + 512 + g_ * 128 + (tid - 192)); \
            _Pragma("unroll") for (int t = 0; t < 8; ++t) RAW[t] = bf1(R[(size_t)(row0_ + t) * CONV_DIM + col_]); \
            const float* sc_ = p.state_conv + (((size_t)j * DEC_BATCH + sb_) * 3) * CONV_DIM + col_; \
            HIST[0] = sc_[0]; HIST[1] = sc_[CONV_DIM]; HIST[2] = sc_[2 * CONV_DIM]; \
            const float* cw_ = p.ssd_conv_w + (size_t)j * 4 * CONV_DIM + col_; \
            CW[0] = cw_[0]; CW[1] = cw_[CONV_DIM]; CW[2] = cw_[2 * CONV_DIM]; CW[3] = cw_[3 * CONV_DIM]; CW[4] = p.ssd_conv_b[(size_t)j * CONV_DIM + col_]; } \
        if (tid >= 504) SD = DT[(size_t)(row0_ + tid - 504) * 32 + h_]; \
        ZS = bf1(Z[(size_t)(row0_ + w) * D_INNER + h_ * 64 + lane]); } while (0)
    int u = bid;
    if (u < NU) DEC_LOAD(u, hv, raw, hist, cw, sd, zs);
    for (; u < NU; u += G) {
        const int sb = u >> 5, h = u & 31, row0 = TP + sb * DEC_SEQ;
        const float A = -__expf(p.ssd_A_log[j * N_HEADS + h]), Dh = p.ssd_D[j * N_HEADS + h];
        if (tid < 320) { float h3 = hist[0], h2 = hist[1], h1 = hist[2];
#pragma unroll
            for (int t = 0; t < 8; ++t) { const float v = cw[0] * h3 + cw[1] * h2 + cw[2] * h1 + cw[3] * raw[t] + cw[4];
                *(LAS float*)(L + D_TOK + (t * 320 + tid) * 4) = silu_f(v); h3 = h2; h2 = h1; h1 = raw[t]; } }
        if (tid >= 504) { *(LAS float*)(L + D_SDT + (tid - 504) * 4) = sd; *(LAS float*)(L + D_SDT + 32 + (tid - 504) * 4) = __expf(sd * A); }
        __syncthreads();
        if (u + G < NU) DEC_LOAD(u + G, hvn, rawn, histn, cwn, sdn, zsn);
        float part[DEC_SEQ];
#pragma unroll
        for (int t = 0; t < DEC_SEQ; ++t) { LAS unsigned char* const tk = L + D_TOK + t * 1280;
            const float dec = *(const LAS float*)(L + D_SDT + 32 + t * 4), xdt = *(const LAS float*)(tk + pp * 4) * *(const LAS float*)(L + D_SDT + t * 4); float pt = 0.f;
#pragma unroll
            for (int i = 0; i < 4; ++i) { const f32x4 bv = *(const LAS f32x4*)(tk + 256 + (n0 + 4 * i) * 4), cv = *(const LAS f32x4*)(tk + 768 + (n0 + 4 * i) * 4);
                hv[i] = hv[i] * dec + bv * xdt;
                pt += hv[i][0] * cv[0] + hv[i][1] * cv[1] + hv[i][2] * cv[2] + hv[i][3] * cv[3]; }
            part[t] = pt; }
#pragma unroll
        for (int m = 1; m < 8; m <<= 1) {
#pragma unroll
            for (int t = 0; t < DEC_SEQ; ++t) part[t] += shx(part[t], lane, m); }
        if ((tid & 7) == 0) {
#pragma unroll
            for (int t = 0; t < DEC_SEQ; ++t) *(LAS float*)(L + D_YS + (t * 64 + pp) * 4) = part[t]; }
        { float* so = p.out + O_SSMS + ((((size_t)j * DEC_BATCH + sb) * N_HEADS + h) * 64 + pp) * D_STATE + n0;
#pragma unroll
            for (int i = 0; i < 4; ++i) *(f32x4*)(so + 4 * i) = hv[i]; }
        __syncthreads();
        { const int t = w, row = row0 + t; const float y = *(const LAS float*)(L + D_YS + (t * 64 + lane) * 4) + Dh * *(const LAS float*)(L + D_TOK + (t * 320 + lane) * 4);
            const float yg = y * zs;
            YG[(size_t)row * D_INNER + h * 64 + lane] = (bf16_t)(cvt_pk_bf16(yg, 0.f) & 0xffffu);
            float s = yg * yg;
#pragma unroll
            for (int o = 1; o < 64; o <<= 1) s += shx(s, lane, o);
            if (lane == 0 && !dry) atomicAdd(ss2 + row, fx(s)); }
        __syncthreads();
#pragma unroll
        for (int i = 0; i < 4; ++i) hv[i] = hvn[i];
#pragma unroll
        for (int i = 0; i < 8; ++i) raw[i] = rawn[i];
#pragma unroll
        for (int i = 0; i < 3; ++i) hist[i] = histn[i];
#pragma unroll
        for (int i = 0; i < 5; ++i) cw[i] = cwn[i];
        sd = sdn; zs = zsn;
    }
#undef DEC_LOAD
}

__device__ __forceinline__ void sample_fix(const Params& p, int L, int bid, int G, const int tid) {
    const int lane = tid & 63, wid = tid >> 6;
    float* X = (float*)(p.ws + WS_X); bf16_t* XB = (bf16_t*)(p.ws + WS_XB); const float* PART = (const float*)(p.ws + WS_PART);
    u64* ssn = (u64*)(p.ws + WS_SS) + (size_t)(L + 1) * T;
    for (int r = bid * 8 + wid; r < TS; r += G * 8) { const int row = TP + r;
        const float* xo = L == 0 ? p.x_sample + (size_t)r * D_MODEL : X + (size_t)row * D_MODEL;
        f32x4 v[4], ps[4];
#pragma unroll
        for (int i = 0; i < 4; ++i) { v[i] = *(const f32x4*)(xo + i * 256 + lane * 4); ps[i] = (f32x4){0.f, 0.f, 0.f, 0.f}; }
#pragma unroll
        for (int kb = 0; kb < SPLITQ; kb += 4) { f32x4 q[4][4];
#pragma unroll
            for (int i = 0; i < 4; ++i)
#pragma unroll
                for (int k = 0; k < 4; ++k) q[k][i] = *(const f32x4*)(PART + ((size_t)(kb + k) * TS + r) * D_MODEL + i * 256 + lane * 4);
#pragma unroll
            for (int i = 0; i < 4; ++i) ps[i] = (((ps[i] + q[0][i]) + q[1][i]) + q[2][i]) + q[3][i]; }
        float s = 0.f;
#pragma unroll
        for (int i = 0; i < 4; ++i) { const f32x4 x = v[i] + ps[i];
            *(f32x4*)(X + (size_t)row * D_MODEL + i * 256 + lane * 4) = x;
            u32x2 o; o[0] = cvt_pk_bf16(x[0], x[1]); o[1] = cvt_pk_bf16(x[2], x[3]);
            *(u32x2*)(XB + (size_t)row * D_MODEL + i * 256 + lane * 4) = o;
            s += x[0] * x[0] + x[1] * x[1] + x[2] * x[2] + x[3] * x[3]; }
#pragma unroll
        for (int o = 1; o < 64; o <<= 1) s += shx(s, lane, o);
        if (lane == 0) ssn[row] = fx(s); }
}

__device__ __forceinline__ void phase_final(const Params& p, int bid, int G, const int tid) {
    const int lane = tid & 63, wid = tid >> 6;
    const float* X = (const float*)(p.ws + WS_X); const u64* ss = (const u64*)(p.ws + WS_SS) + (size_t)4 * T;
    f32x4 wv[4];
#pragma unroll
    for (int i = 0; i < 4; ++i) wv[i] = *(const f32x4*)(p.final_norm_w + i * 256 + lane * 4);
    const float* PART = (const float*)(p.ws + WS_PART);
    for (int row = bid * 8 + wid; row < T; row += G * 8) { f32x4 v[4];
#pragma unroll
        for (int i = 0; i < 4; ++i) v[i] = *(const f32x4*)(X + (size_t)row * D_MODEL + i * 256 + lane * 4);
        float rstd;
        if (row >= TP) {
            f32x4 ps[4];
#pragma unroll
            for (int i = 0; i < 4; ++i) ps[i] = (f32x4){0.f, 0.f, 0.f, 0.f};
#pragma unroll
            for (int kb = 0; kb < SPLITQ; kb += 4) { f32x4 q[4][4];
#pragma unroll
                for (int i = 0; i < 4; ++i)
#pragma unroll
                    for (int k = 0; k < 4; ++k) q[k][i] = *(const f32x4*)(PART + ((size_t)(kb + k) * TS + (row - TP)) * D_MODEL + i * 256 + lane * 4);
#pragma unroll
                for (int i = 0; i < 4; ++i) ps[i] = (((ps[i] + q[0][i]) + q[1][i]) + q[2][i]) + q[3][i]; }
            float s = 0.f;
#pragma unroll
            for (int i = 0; i < 4; ++i) { v[i] = v[i] + ps[i]; s += v[i][0] * v[i][0] + v[i][1] * v[i][1] + v[i][2] * v[i][2] + v[i][3] * v[i][3]; }
#pragma unroll
            for (int o = 1; o < 64; o <<= 1) s += shx(s, lane, o);
            rstd = rsqrtf(s * (1.f / D_MODEL) + EPS);
        } else rstd = rsqrtf(ssf(ss + row) * (1.f / D_MODEL) + EPS);
#pragma unroll
        for (int i = 0; i < 4; ++i) *(f32x4*)(p.out + (size_t)row * D_MODEL + i * 256 + lane * 4) = v[i] * rstd * wv[i]; }
}

#define XB_TMO      128
#define XB_XCNT(j)  (256  + 64 * (j))
#define XB_XSUB(j)  (1280 + 64 * (j))
#define XB_XGEN(j)  (2304 + 64 * (j))
#define XB_TOP      3328
#define XB_TOPGEN   3392
#define XCD_BAR_WORDS 3456
#define XB_SPIN_CAP (1u << 18)
__device__ __forceinline__ unsigned xb_ld(unsigned* p)              { return __hip_atomic_load(p, __ATOMIC_RELAXED, __HIP_MEMORY_SCOPE_AGENT); }
__device__ __forceinline__ unsigned xb_add(unsigned* p, unsigned v) { return __hip_atomic_fetch_add(p, v, __ATOMIC_RELAXED, __HIP_MEMORY_SCOPE_AGENT); }
__device__ __forceinline__ unsigned xb_xcc_id() { return (unsigned)__builtin_amdgcn_s_getreg((3 << 11) | 20) & 0xFu; }
#define XB_SPIN(cond, bar) do { unsigned _sp = 0; while (cond) { __builtin_amdgcn_s_sleep(1); \
    if ((++_sp & 255u) == 0u) { if (xb_ld(&(bar)[XB_TMO])) break; if (_sp > XB_SPIN_CAP) { atomicAdd(&(bar)[XB_TMO], 1u); break; } } } } while (0)
struct XcdBarrier { unsigned* bar; unsigned x; volatile LAS unsigned* st; };
__device__ __forceinline__ XcdBarrier xcd_barrier_post(unsigned* bar, volatile LAS unsigned* st) {
    XcdBarrier b; b.bar = bar; b.x = xb_xcc_id(); b.st = st;
    if (threadIdx.x == 0) (void)xb_add(&bar[XB_XCNT(b.x)], 1u);
    return b;
}
__device__ __forceinline__ void xcd_barrier_complete(unsigned* bar, unsigned x, unsigned& nloc, unsigned& nx) {
    const unsigned G = gridDim.x * gridDim.y * gridDim.z;
    unsigned sum, cnt, mine, sp = 0u;
    for (;;) {
        sum = 0u; cnt = 0u; mine = 0u;
#pragma unroll
        for (unsigned j = 0; j < 16; ++j) { const unsigned c = xb_ld(&bar[XB_XCNT(j)]); sum += c; cnt += (c > 0u) ? 1u : 0u; }
        if (sum == G) { mine = xb_ld(&bar[XB_XCNT(x)]); break; }
        __builtin_amdgcn_s_sleep(1);
        if ((++sp & 255u) == 0u) { if (xb_ld(&bar[XB_TMO])) break; if (sp > XB_SPIN_CAP) { atomicAdd(&bar[XB_TMO], 1u); break; } }
    }
    nloc = mine > 0u ? mine : 1u; nx = cnt > 0u ? cnt : 1u;
}
__device__ __forceinline__ void xcd_barrier(const XcdBarrier& b, const int tid) {
    asm volatile("s_waitcnt vmcnt(0)" ::: "memory");
    __syncthreads();
    if (tid == 0) {
        unsigned* bar = b.bar;
        __builtin_amdgcn_s_waitcnt(0);
        unsigned nloc = b.st[0], nx = b.st[1];
        if (nloc == 0u) { xcd_barrier_complete(bar, b.x, nloc, nx); b.st[0] = nloc; b.st[1] = nx; }
        const unsigned old = xb_add(&bar[XB_XSUB(b.x)], 1u);
        const unsigned gen = old / nloc;
        if (old + 1u == (gen + 1u) * nloc) {
            __builtin_amdgcn_fence(__ATOMIC_RELEASE, "agent");
            asm volatile("s_waitcnt vmcnt(0)" ::: "memory");
            const unsigned og = xb_add(&bar[XB_TOP], 1u);
            const unsigned tg = og / nx;
            if (og + 1u == (tg + 1u) * nx) xb_add(&bar[XB_TOPGEN], 1u);
            else XB_SPIN(xb_ld(&bar[XB_TOPGEN]) == tg, bar);
            __builtin_amdgcn_fence(__ATOMIC_ACQUIRE, "agent");
            xb_add(&bar[XB_XGEN(b.x)], 1u);
            asm volatile("s_waitcnt vmcnt(0)" ::: "memory");
        } else {
            XB_SPIN(xb_ld(&bar[XB_XGEN(b.x)]) == gen, bar);
            __builtin_amdgcn_fence(__ATOMIC_ACQUIRE, "agent");
            asm volatile("s_waitcnt vmcnt(0)" ::: "memory");
        }
    }
    __syncthreads();
}

constexpr int N_PHASES = 18;
#ifndef PH_MASK
#define PH_MASK 0x1ff
#endif
#define PH_ON(k) ((PH_MASK >> (k)) & 1)
#ifndef REP_MASK
#define REP_MASK 0
#endif
#define NREP(k) (((REP_MASK >> (k)) & 1) ? 2 : 1)
#define FRESH_TID(name) int name##_z = 0; asm volatile("" : "+v"(name##_z)); const int name = wid_s * 64 + (int)__builtin_amdgcn_mbcnt_hi(~0u, __builtin_amdgcn_mbcnt_lo(~0u, (unsigned)name##_z))
__global__ void __launch_bounds__(NTHREADS, 2) fwd_kernel(Params pin) {
    extern __shared__ __attribute__((aligned(16))) unsigned char shm[];
    volatile LAS unsigned* bst = (volatile LAS unsigned*)(LAS unsigned char*)(shm + LDS_STAGE);
    if (threadIdx.x == 0) { bst[0] = 0u; bst[1] = 0u; }
    __syncthreads();
    const XcdBarrier xbar = xcd_barrier_post((unsigned*)(pin.ws + WS_CTL), bst);
    const int wid_s = __builtin_amdgcn_readfirstlane((int)threadIdx.x >> 6);
    if (pin.ph_lo == 0) {
        const int bid = (int)blockIdx.x, G = (int)gridDim.x, tid = (int)threadIdx.x;
        if (PH_ON(0)) for (int rep = 0; rep < NREP(0); ++rep) phase_prep(pin, (unsigned char*)shm, bid, G, tid);
        if (pin.ph_hi > 1000) cg::this_grid().sync();
        else if (pin.ph_hi > 1) xcd_barrier(xbar, tid);
    }
    for (int ph = pin.ph_lo > 1 ? pin.ph_lo : 1; ph < pin.ph_hi; ++ph) {
        int sz = 0; asm volatile("" : "+s"(sz));
        const int bid = (int)blockIdx.x + sz, G = (int)gridDim.x + sz;
        Params p = pin; p.ws = pin.ws + sz; p.out = pin.out + sz;
        unsigned lb = (unsigned)(size_t)(LAS unsigned char*)shm; asm volatile("" : "+s"(lb));
        LAS unsigned char* const lds3 = (LAS unsigned char*)(size_t)lb; unsigned char* const ldsg = (unsigned char*)lds3;
        if (false) {}
        else if (ph == N_PHASES - 1) { if (PH_ON(1)) { FRESH_TID(t1); for (int rep = 0; rep < NREP(1); ++rep) phase_final(p, bid, G, t1); } }
        else {
            const int L = (ph - 1) >> 2, sub = (ph - 1) & 3, j = L >> 1; const bool ssd = L & 1;
            u64* SS = (u64*)(p.ws + WS_SS);
            if (sub == 0) {
                pg8::Sched S;
                if (!ssd) { if (PH_ON(2)) { S.init(NPANEL, 16, G, bid, 0, 16, 0);
                    pg8::Gemm g{(const bf16_t*)(p.ws + WS_XB), (const bf16_t*)(p.ws + WS_WPIN) + (size_t)j * 4096 * 1024, T, 4096, 1024};
                    pg8::EpiPoolIn E{(bf16_t*)(p.ws + WS_U), (bf16_t*)(p.ws + WS_Z), SS + (size_t)L * T};
                    FRESH_TID(t2); for (int rep = 0; rep < NREP(2); ++rep) pg8::gemm_phase(lds3, g, S, E, t2);
                    if (L == 0 && G > 64 && bid >= 64) prep_weights(p, ldsg, bid - 64, G - 64, t2, W_FIRST, G > 148 ? W_PER : -1); }
                } else if (PH_ON(3)) { S.init(NPANEL, SSD_IN_PAD / 256, G, bid, 0, 16, 0);
                    pg8::Gemm g{(const bf16_t*)(p.ws + WS_XB), (const bf16_t*)(p.ws + WS_WSIN) + (size_t)j * SSD_IN_PAD * 1024, T, SSD_IN_PAD, 1024};
                    pg8::EpiSsdIn E{(bf16_t*)(p.ws + WS_Z), (bf16_t*)(p.ws + WS_XBC), (float*)(p.ws + WS_DT), SS + (size_t)L * T, p.ssd_dt_bias + j * N_HEADS};
                    FRESH_TID(t3); for (int rep = 0; rep < NREP(3); ++rep) pg8::gemm_phase(lds3, g, S, E, t3);
                    if (L == 1 && G > 148 && bid >= 148) prep_weights(p, ldsg, bid - 148, G - 148, t3, W_PER, -1);
                }
            } else if (sub == 1) {
                if (!ssd) { if (PH_ON(4)) { FRESH_TID(t4); for (int rep = 0; rep < NREP(4); ++rep) phase_pool(p, j, bid, G, t4); } } else if (PH_ON(5)) { FRESH_TID(t5); for (int rep = 0; rep < NREP(5); ++rep) { phase_conv(p, j, bid, G, t5); decode_units(p, j, lds3, bid, G, t5, rep); } }
            } else if (sub == 2) {
                if (!ssd) { if (PH_ON(6)) { pg8::Sched S; S.init(NPANEL, 8, G, bid, 1, 8, 0);
                    pg8::Gemm g{(const bf16_t*)(p.ws + WS_P), (const bf16_t*)(p.ws + WS_WMIX) + (size_t)j * 2048 * 512, 4 * T, 2048, 512};
                    pg8::EpiPoolMix E{(bf16_t*)(p.ws + WS_Y), (const bf16_t*)(p.ws + WS_Z), p.pool_scale + j * D_INNER};
                    FRESH_TID(t6); for (int rep = 0; rep < NREP(6); ++rep) pg8::gemm_phase(lds3, g, S, E, t6); }
                } else if (PH_ON(7)) { FRESH_TID(t7); for (int rep = 0; rep < NREP(7); ++rep) phase_scan(p, j, ldsg, bid, G, t7, rep); }
            } else if (PH_ON(8)) {
                pg8::Sched S; S.init(64, 4, G, bid, 0, 32, 1);
                const bf16_t* Wt = ssd ? (const bf16_t*)(p.ws + WS_WSOUT) + (size_t)j * 1024 * 2048 : (const bf16_t*)(p.ws + WS_WPOUT) + (size_t)j * 1024 * 2048;
                pg8::Gemm g{(const bf16_t*)(p.ws + WS_Y), Wt, T, 1024, 2048};
                float* X = (float*)(p.ws + WS_X);
                pg8::EpiOut E{L == 0 ? p.x_prompt : X, L == 0 ? p.x_sample : X + (size_t)TP * D_MODEL, X, (bf16_t*)(p.ws + WS_XB), SS + (size_t)(L + 1) * T,
                              ssd ? (const u64*)(p.ws + WS_SS2) + (size_t)j * T : nullptr, 0, (float*)(p.ws + WS_PART)};
                FRESH_TID(t8); for (int rep = 0; rep < NREP(8); ++rep) { E.dry = rep; pg8::gemm_phase(lds3, g, S, E, t8); }
                if (L < 3) { xcd_barrier(xbar, t8); sample_fix(p, L, bid, G, t8); }
            }
        }
        if (ph + 1 < pin.ph_hi) { int tz2 = 0; asm volatile("" : "+v"(tz2));
            xcd_barrier(xbar, wid_s * 64 + (int)__builtin_amdgcn_mbcnt_hi(~0u, __builtin_amdgcn_mbcnt_lo(~0u, (unsigned)tz2))); }
    }
}

extern "C" void kernel_launch(void* const* d_in, const int* in_sizes, int n_in, void* d_out, int out_size, void* d_ws, size_t ws_size, hipStream_t stream) {
    static int grid = 0;
    if (grid == 0) {
        if (n_in != 19 || ws_size < WS_END) { fprintf(stderr, "kernel_launch: unexpected n_in %d / ws_size %zu (need %zu)\n", n_in, ws_size, (size_t)WS_END); grid = -1; return; }
        if (hipFuncSetAttribute((const void*)fwd_kernel, hipFuncAttributeMaxDynamicSharedMemorySize, LDS_BYTES) != hipSuccess) { fprintf(stderr, "kernel_launch: hipFuncSetAttribute failed\n"); grid = -1; return; }
        int dev = 0, cus = 0, per_cu = 0;
        hipGetDevice(&dev); hipDeviceGetAttribute(&cus, hipDeviceAttributeMultiprocessorCount, dev);
        hipOccupancyMaxActiveBlocksPerMultiprocessor(&per_cu, (const void*)fwd_kernel, NTHREADS, LDS_BYTES);
        (void)hipGetLastError();
        if (per_cu < 1) per_cu = 1;
        grid = cus;
    }
    if (grid < 0) return;
    Params p{};
    const float** f = (const float**)&p;
    for (int i = 0; i < 19; ++i) f[i] = (const float*)d_in[i];
    p.out = (float*)d_out; p.ws = (unsigned char*)d_ws;
    if (hipMemsetAsync((char*)d_ws + WS_CTL, 0, 16384, stream) != hipSuccess) { fprintf(stderr, "kernel_launch: memset failed\n"); return; }
#if MK_MULTI
    for (int ph = 0; ph < N_PHASES; ++ph) { p.ph_lo = ph; p.ph_hi = ph + 1; hipLaunchKernelGGL(fwd_kernel, dim3(grid), dim3(NTHREADS), LDS_BYTES, stream, p); }
#else
    p.ph_lo = 0; p.ph_hi = N_PHASES;
    void* args[] = {&p};
    hipError_t e = hipLaunchCooperativeKernel((const void*)fwd_kernel, dim3(grid), dim3(NTHREADS), args, LDS_BYTES, stream);
    if (e != hipSuccess) fprintf(stderr, "cooperative launch failed: %s (grid %d)\n", hipGetErrorString(e), grid);
#endif
}
```

```cpp
#include <hip/hip_runtime.h>
#include <hip/hip_cooperative_groups.h>
#include <cstdio>
#include <cstdint>
namespace cg = cooperative_groups;

#ifndef SPLITQ
#define SPLITQ 8
#endif
#ifndef MK_MULTI
#define MK_MULTI 0
#endif

constexpr int D_MODEL = 1024, BATCH = 8, SEQ = 2048, DEC_BATCH = 128, DEC_SEQ = 8;
constexpr int D_INNER = 2048, POOL_BUF = 15, N_HEADS = 32, D_STATE = 128, CONV_DIM = 3072, SSD_IN = 5152;
constexpr int TP = BATCH * SEQ;
constexpr int TS = DEC_BATCH * DEC_SEQ;
constexpr int T = TP + TS;
constexpr int NPANEL = T / 256;
constexpr int SSD_IN_PAD = 5376;
constexpr float EPS = 1e-6f;

constexpr size_t O_YP = 0, O_YS = O_YP + (size_t)TP * D_MODEL, O_POOLP = O_YS + (size_t)TS * D_MODEL,
                 O_POOLS = O_POOLP + (size_t)2 * BATCH * POOL_BUF * D_INNER, O_CONVP = O_POOLS + (size_t)2 * DEC_BATCH * POOL_BUF * D_INNER,
                 O_CONVS = O_CONVP + (size_t)2 * BATCH * 3 * CONV_DIM, O_SSMP = O_CONVS + (size_t)2 * DEC_BATCH * 3 * CONV_DIM,
                 O_SSMS = O_SSMP + (size_t)2 * BATCH * N_HEADS * 64 * D_STATE;

constexpr size_t al(size_t x) { return (x + 4095) & ~(size_t)4095; }
constexpr size_t WS_CTL = 0;
constexpr size_t WS_SS = 16384;
constexpr size_t WS_SS2 = al(WS_SS + (size_t)5 * T * 8);
constexpr size_t WS_WPIN = al(WS_SS2 + (size_t)2 * T * 8);
constexpr size_t WS_WMIX = al(WS_WPIN + (size_t)2 * 4096 * 1024 * 2);
constexpr size_t WS_WPOUT = al(WS_WMIX + (size_t)2 * 2048 * 512 * 2);
constexpr size_t WS_WSIN = al(WS_WPOUT + (size_t)2 * 1024 * 2048 * 2);
constexpr size_t WS_WSOUT = al(WS_WSIN + (size_t)2 * SSD_IN_PAD * 1024 * 2);
constexpr size_t WS_X = al(WS_WSOUT + (size_t)2 * 1024 * 2048 * 2);
constexpr size_t WS_XB = al(WS_X + (size_t)T * 1024 * 4);
constexpr size_t WS_U = al(WS_XB + (size_t)T * 1024 * 2);
constexpr size_t WS_Z = al(WS_U + (size_t)T * 2048 * 2);
constexpr size_t WS_P = al(WS_Z + (size_t)T * 2048 * 2);
constexpr size_t WS_Y = al(WS_P + (size_t)T * 2048 * 2);
constexpr size_t WS_XBC = al(WS_Y + (size_t)T * 2048 * 2);
constexpr size_t WS_XBCC = al(WS_XBC + (size_t)T * 3072 * 2);
constexpr size_t WS_DT = al(WS_XBCC + (size_t)T * 3072 * 2);
constexpr size_t WS_PART = al(WS_DT + (size_t)T * 32 * 4);
constexpr size_t WS_END = al(WS_PART + (size_t)8 * TS * 1024 * 4);

constexpr int LDS_STAGE = 158720;
constexpr int LDS_BYTES = LDS_STAGE + 64;
constexpr int NTHREADS = 512;

typedef unsigned short bf16_t;
typedef short bf16x8 __attribute__((ext_vector_type(8)));
typedef float f32x4 __attribute__((ext_vector_type(4)));
typedef float f32x2 __attribute__((ext_vector_type(2)));
typedef unsigned u32x4 __attribute__((ext_vector_type(4)));
typedef unsigned u32x2 __attribute__((ext_vector_type(2)));

struct Params {
    const float *x_prompt, *x_sample, *state_pool, *state_conv, *state_ssm, *norm_w, *pool_in_w, *pool_mix_w, *pool_scale, *pool_out_w,
        *ssd_in_w, *ssd_conv_w, *ssd_conv_b, *ssd_dt_bias, *ssd_A_log, *ssd_D, *ssd_norm_w, *ssd_out_w, *final_norm_w;
    float* out;
    unsigned char* ws;
    int ph_lo, ph_hi;
};

__device__ __forceinline__ unsigned cvt_pk_bf16(float lo, float hi) { unsigned r; asm volatile("v_cvt_pk_bf16_f32 %0, %1, %2" : "=v"(r) : "v"(lo), "v"(hi)); return r; }
__device__ __forceinline__ float bf_lo(unsigned u) { return __uint_as_float(u << 16); }
__device__ __forceinline__ float bf_hi(unsigned u) { return __uint_as_float(u & 0xffff0000u); }
__device__ __forceinline__ float bf1(bf16_t b) { return __uint_as_float(((unsigned)b) << 16); }
__device__ __forceinline__ float shx(float v, int lane, int m) { return __int_as_float(__builtin_amdgcn_ds_bpermute((lane ^ m) << 2, __float_as_int(v))); }
__device__ __forceinline__ float shup(float v, int lane, int d) { const int src = lane >= d ? lane - d : lane; return __int_as_float(__builtin_amdgcn_ds_bpermute(src << 2, __float_as_int(v))); }
typedef unsigned long long u64;
__device__ __forceinline__ u64 fx(float s) { const unsigned hi = (unsigned)s; const unsigned lo = (unsigned)((s - (float)hi) * 4294967296.f); return ((u64)hi << 32) | lo; }
__device__ __forceinline__ float ssf(const u64* p) { const u64 v = *p; return (float)(unsigned)(v >> 32) + (float)(unsigned)v * 2.3283064365386963e-10f; }
__device__ __forceinline__ float silu_f(float v) { return v * __builtin_amdgcn_rcpf(1.f + __expf(-v)); }
__device__ __forceinline__ float softplus_f(float v) { return fmaxf(v, 0.f) + __logf(1.f + __expf(-fabsf(v))); }

namespace pg8 {
#define PG8_LAS __attribute__((address_space(3)))
constexpr int BM = 256, BK = 64, HALF = 128, HTB = HALF * BK * 2, STAGE_BYTES = 8 * HTB, NXCD = 8, WGM = 8;
__host__ __device__ __forceinline__ int lds_byte(int r, int c) { const int st = (r >> 4) * 2 + (c >> 5), rr = r & 15, cc = c & 31, ob = rr * 64 + cc * 2; return st * 1024 + (ob ^ (((ob >> 9) & 1) << 5)); }
__host__ __device__ __forceinline__ void stage_rc(int b, int& R, int& C) { const int st = b / 1024, sb = b % 1024, swz = sb ^ (((sb >> 9) & 1) << 5); R = (st >> 1) * 16 + swz / 64; C = (st & 1) * 32 + (swz % 64) / 2; }
__host__ __device__ __forceinline__ int perm32(int rho) { const int n = rho >> 4, i = rho & 15; return 8 * (i >> 2) + 4 * n + (i & 3); }

struct Unit { int pm, pn, kofs, nt; };
struct Gemm { const bf16_t* A; const bf16_t* Bt; int M, N, K; };

struct Sched {
    int nM, nN, nwg, G, c, grouped, ntf, split;
    __device__ void init(int nM_, int nN_, int G_, int c_, int grouped_, int ntf_, int split_) { nM = nM_; nN = nN_; nwg = nM * nN + (split_ ? 16 * SPLITQ : 0); G = G_; c = c_; grouped = grouped_; ntf = ntf_; split = split_; }
    __device__ bool next(int i, Unit& u) const {
        const long L = (long)i * G + c; if (L >= nwg) return false;
        const int nfull = nM * nN;
        if (L >= nfull) { const int idx = (int)L - nfull, tile = idx / SPLITQ, q = idx % SPLITQ; u.pm = 64 + (tile >> 2); u.pn = tile & 3; u.kofs = q * (ntf / SPLITQ) * BK * 2; u.nt = ntf / SPLITQ; return true; }
        int wgid = (int)L; { const int q = nfull / NXCD, r = nfull % NXCD, xcd = wgid % NXCD, off = wgid / NXCD; wgid = (xcd < r ? xcd * (q + 1) : r * (q + 1) + (xcd - r) * q) + off; }
        const int nig = WGM * nN, gid = wgid / nig, fm = gid * WGM, gsz = (nM - fm) < WGM ? (nM - fm) : WGM;
        u.pm = fm + ((wgid % nig) % gsz); u.pn = (wgid % nig) / gsz; u.kofs = 0; u.nt = ntf;
        if (grouped) u.pm += (u.pn >> 1) * NPANEL;
        return true;
    }
    __device__ __forceinline__ void a_ready(const Unit&) const {}
    __device__ __forceinline__ void done(const Unit&) const {}
};

template <class Epi, class Sch>
__device__ __forceinline__ void gemm_phase(PG8_LAS unsigned char* lds, const Gemm g, const Sch& S, const Epi& E, const int tid) {
    const int wid = __builtin_amdgcn_readfirstlane(tid >> 6), lane = tid & 63, wr = wid >> 2, wc = wid & 3, fr = lane & 15, fq = lane >> 4;
    const int K = g.K;
    unsigned voffA[2], voffB[2];
#pragma unroll
    for (int i = 0; i < 2; ++i) { int R, C; stage_rc(tid * 16 + i * 8192, R, C); const int Rb = Epi::PERM ? ((R & ~31) + perm32(R & 31)) : R;
        voffA[i] = (unsigned)(R * K + C) * 2u; voffB[i] = (unsigned)(Rb * K + C) * 2u; }
    const size_t kstep = (size_t)(BK * 2);
    const size_t hstep = (size_t)HALF * K * 2;
    const size_t tstep = 2 * hstep;
    const unsigned ldsw = (unsigned)wid * 1024u;
    const int aoff = lds_byte(wr * 64 + fr, fq * 8), boff = lds_byte(wc * 32 + fr, fq * 8);
#define PG8_SA(b, h) (((b) * 2 + (h)) * HTB)
#define PG8_SB(b, h) ((4 + (b) * 2 + (h)) * HTB)
#define PG8_STAGE(bufoff, gbase, voff) do { _Pragma("unroll") for (int _i = 0; _i < 2; ++_i) \
        __builtin_amdgcn_global_load_lds((const unsigned*)((const char*)(gbase) + (voff)[_i]), (PG8_LAS unsigned*)(lds + (bufoff) + ldsw + _i * 8192), 16, 0, 0); } while (0)
#define PG8_LDA(dst, b, h) do { _Pragma("unroll") for (int m = 0; m < 4; ++m) _Pragma("unroll") for (int k = 0; k < 2; ++k) dst[m][k] = *(const PG8_LAS bf16x8*)(lds + PG8_SA(b, h) + aoff + m * 2048 + k * 1024); } while (0)
#define PG8_LDB(dst, b, h) do { _Pragma("unroll") for (int n = 0; n < 2; ++n) _Pragma("unroll") for (int k = 0; k < 2; ++k) dst[n][k] = *(const PG8_LAS bf16x8*)(lds + PG8_SB(b, h) + boff + n * 2048 + k * 1024); } while (0)
#define PG8_MMA(ai, bj, At, Bt) do { __builtin_amdgcn_s_setprio(1); _Pragma("unroll") for (int m = 0; m < 4; ++m) _Pragma("unroll") for (int n = 0; n < 2; ++n) _Pragma("unroll") for (int k = 0; k < 2; ++k) \
        acc[ai][bj][m][n] = __builtin_amdgcn_mfma_f32_16x16x32_bf16(Bt[n][k], At[m][k], acc[ai][bj][m][n], 0, 0, 0); __builtin_amdgcn_s_setprio(0); } while (0)
#define PG8_WAIT_V(n) asm volatile("s_waitcnt vmcnt(" #n ")" ::: "memory")
#define PG8_WAIT_L(n) asm volatile("s_waitcnt lgkmcnt(" #n ")" ::: "memory")
#define PG8_BAR __builtin_amdgcn_s_barrier()
#define PG8_SCHED __builtin_amdgcn_sched_barrier(0)
    Unit cur, nxt; int ui = 0;
    if (!S.next(0, cur)) return;
    f32x4 acc[2][2][4][2];
#pragma unroll
    for (int a = 0; a < 2; ++a)
#pragma unroll
        for (int b = 0; b < 2; ++b)
#pragma unroll
            for (int m = 0; m < 4; ++m)
#pragma unroll
                for (int n = 0; n < 2; ++n) acc[a][b][m][n] = (f32x4){0.f, 0.f, 0.f, 0.f};
    bf16x8 At[4][2], B0[2][2], B1[2][2];
    const char* cA = (const char*)g.A + (size_t)cur.pm * tstep + cur.kofs; const char* cB = (const char*)g.Bt + (size_t)cur.pn * tstep + cur.kofs;
    int nt = cur.nt;
    S.a_ready(cur);
    PG8_STAGE(PG8_SB(0, 0), cB, voffB); PG8_STAGE(PG8_SA(0, 0), cA, voffA); PG8_STAGE(PG8_SB(0, 1), cB + hstep, voffB); PG8_STAGE(PG8_SA(0, 1), cA + hstep, voffA);
    if (wr == 1) PG8_BAR;
    PG8_WAIT_V(4); PG8_BAR;
    PG8_STAGE(PG8_SB(1, 0), cB + kstep, voffB); PG8_STAGE(PG8_SA(1, 0), cA + kstep, voffA); PG8_STAGE(PG8_SB(1, 1), cB + hstep + kstep, voffB);
    PG8_WAIT_V(6); PG8_BAR;
    for (;;) {
        const bool has_next = S.next(ui + 1, nxt);
        const char* nA = has_next ? (const char*)g.A + (size_t)nxt.pm * tstep + nxt.kofs : cA; const char* nB = has_next ? (const char*)g.Bt + (size_t)nxt.pn * tstep + nxt.kofs : cB;
        for (int t = 0; t < nt; t += 2) {
            const bool last = (t == nt - 2);
            const char* a1 = cA + (size_t)(t + 1) * kstep;
            const char* a2 = last ? nA : cA + (size_t)(t + 2) * kstep; const char* b2 = last ? nB : cB + (size_t)(t + 2) * kstep;
            const char* a3 = a2 + kstep; const char* b3 = b2 + kstep;
            if (last && has_next) S.a_ready(nxt);
            PG8_LDB(B0, 0, 0); PG8_SCHED; PG8_LDA(At, 0, 0); PG8_STAGE(PG8_SA(1, 1), a1 + hstep, voffA);
            PG8_WAIT_L(8); PG8_BAR; PG8_WAIT_L(0); PG8_MMA(0, 0, At, B0); PG8_BAR; PG8_SCHED;
            PG8_LDB(B1, 0, 1); PG8_STAGE(PG8_SB(0, 0), b2, voffB);
            PG8_BAR; PG8_WAIT_L(0); PG8_MMA(0, 1, At, B1); PG8_BAR;
            PG8_LDA(At, 0, 1); PG8_STAGE(PG8_SA(0, 0), a2, voffA);
            PG8_BAR; PG8_WAIT_L(0); PG8_MMA(1, 0, At, B0); PG8_BAR; PG8_SCHED;
            PG8_STAGE(PG8_SB(0, 1), b2 + hstep, voffB);
            PG8_WAIT_V(6); PG8_BAR; PG8_MMA(1, 1, At, B1); PG8_BAR;
            PG8_LDB(B0, 1, 0); PG8_SCHED; PG8_LDA(At, 1, 0); PG8_STAGE(PG8_SA(0, 1), a2 + hstep, voffA);
            PG8_WAIT_L(8); PG8_BAR; PG8_WAIT_L(0); PG8_MMA(0, 0, At, B0); PG8_BAR; PG8_SCHED;
            PG8_LDB(B1, 1, 1); PG8_STAGE(PG8_SB(1, 0), b3, voffB);
            PG8_BAR; PG8_WAIT_L(0); PG8_MMA(0, 1, At, B1); PG8_BAR;
            PG8_LDA(At, 1, 1); PG8_STAGE(PG8_SA(1, 0), a3, voffA);
            PG8_BAR; PG8_WAIT_L(0); PG8_MMA(1, 0, At, B0); PG8_BAR; PG8_SCHED;
            PG8_STAGE(PG8_SB(1, 1), b3 + hstep, voffB);
            PG8_WAIT_V(6); PG8_BAR; PG8_MMA(1, 1, At, B1); PG8_BAR;
        }
        E(acc, cur, wr, wc, fr, fq); S.done(cur);
        if (!has_next) break;
#pragma unroll
        for (int a = 0; a < 2; ++a)
#pragma unroll
            for (int b = 0; b < 2; ++b)
#pragma unroll
                for (int m = 0; m < 4; ++m)
#pragma unroll
                    for (int n = 0; n < 2; ++n) acc[a][b][m][n] = (f32x4){0.f, 0.f, 0.f, 0.f};
        cur = nxt; cA = nA; cB = nB; nt = cur.nt; ++ui;
    }
    PG8_WAIT_V(0);
    if (wr == 0) PG8_BAR;
    PG8_BAR;
#undef PG8_SA
#undef PG8_SB
#undef PG8_STAGE
#undef PG8_LDA
#undef PG8_LDB
#undef PG8_MMA
#undef PG8_WAIT_V
#undef PG8_WAIT_L
#undef PG8_BAR
#undef PG8_SCHED
}

struct EpiPoolIn {
    static constexpr bool PERM = true;
    bf16_t* U; bf16_t* Z; const u64* ss;
    __device__ __forceinline__ void operator()(const f32x4 (&acc)[2][2][4][2], const Unit& u, int wr, int wc, int fr, int fq) const {
        const int row0 = u.pm * BM + wr * 64 + fr; const bool isz = u.pn >= 8; bf16_t* base = isz ? Z : U;
        const int col0 = (u.pn & 7) * BM + wc * 32 + 8 * fq;
        float rs[2][4];
#pragma unroll
        for (int ai = 0; ai < 2; ++ai)
#pragma unroll
            for (int m = 0; m < 4; ++m) rs[ai][m] = ssf(ss + row0 + ai * HALF + m * 16);
#pragma unroll
        for (int ai = 0; ai < 2; ++ai)
#pragma unroll
            for (int m = 0; m < 4; ++m) { const int row = row0 + ai * HALF + m * 16; const float rstd = rsqrtf(rs[ai][m] * (1.f / D_MODEL) + EPS);
                bf16_t* rowp = base + (size_t)row * D_INNER + col0;
#pragma unroll
                for (int bj = 0; bj < 2; ++bj) { f32x4 v0 = acc[ai][bj][m][0] * rstd, v1 = acc[ai][bj][m][1] * rstd;
                    if (isz) { v0[0] = silu_f(v0[0]); v0[1] = silu_f(v0[1]); v0[2] = silu_f(v0[2]); v0[3] = silu_f(v0[3]); v1[0] = silu_f(v1[0]); v1[1] = silu_f(v1[1]); v1[2] = silu_f(v1[2]); v1[3] = silu_f(v1[3]); }
                    u32x4 o; o[0] = cvt_pk_bf16(v0[0], v0[1]); o[1] = cvt_pk_bf16(v0[2], v0[3]); o[2] = cvt_pk_bf16(v1[0], v1[1]); o[3] = cvt_pk_bf16(v1[2], v1[3]);
                    *(u32x4*)(rowp + bj * HALF) = o; } }
    }
};
struct EpiPoolMix {
    static constexpr bool PERM = true;
    bf16_t* Y; const bf16_t* Z; const float* scale;
    __device__ __forceinline__ void operator()(const f32x4 (&acc)[2][2][4][2], const Unit& u, int wr, int wc, int fr, int fq) const {
        const int pm = u.pm - (u.pn >> 1) * NPANEL;
        const int row0 = pm * BM + wr * 64 + fr; const int col0 = u.pn * BM + wc * 32 + 8 * fq;
        f32x4 sc[2][2];
#pragma unroll
        for (int bj = 0; bj < 2; ++bj) { sc[bj][0] = *(const f32x4*)(scale + col0 + bj * HALF); sc[bj][1] = *(const f32x4*)(scale + col0 + bj * HALF + 4); }
#pragma unroll
        for (int ai = 0; ai < 2; ++ai) {
            u32x4 zz[4][2];
#pragma unroll
            for (int m = 0; m < 4; ++m)
#pragma unroll
                for (int bj = 0; bj < 2; ++bj) zz[m][bj] = *(const u32x4*)(Z + (size_t)(row0 + ai * HALF + m * 16) * D_INNER + col0 + bj * HALF);
#pragma unroll
            for (int m = 0; m < 4; ++m) { const size_t ro = (size_t)(row0 + ai * HALF + m * 16) * D_INNER + col0;
#pragma unroll
                for (int bj = 0; bj < 2; ++bj) { const u32x4 z4 = zz[m][bj];
                    f32x4 v0 = acc[ai][bj][m][0] * sc[bj][0], v1 = acc[ai][bj][m][1] * sc[bj][1];
                    v0[0] *= bf_lo(z4[0]); v0[1] *= bf_hi(z4[0]); v0[2] *= bf_lo(z4[1]); v0[3] *= bf_hi(z4[1]);
                    v1[0] *= bf_lo(z4[2]); v1[1] *= bf_hi(z4[2]); v1[2] *= bf_lo(z4[3]); v1[3] *= bf_hi(z4[3]);
                    u32x4 o; o[0] = cvt_pk_bf16(v0[0], v0[1]); o[1] = cvt_pk_bf16(v0[2], v0[3]); o[2] = cvt_pk_bf16(v1[0], v1[1]); o[3] = cvt_pk_bf16(v1[2], v1[3]);
                    *(u32x4*)(Y + ro + bj * HALF) = o; } } }
    }
};
struct EpiOut {
    static constexpr bool PERM = false;
    const float* xin_p; const float* xin_s;
    float* X; bf16_t* XB; u64* ssn; const u64* ss2; int dry; float* PART;
    __device__ __forceinline__ void operator()(const f32x4 (&acc)[2][2][4][2], const Unit& u, int wr, int wc, int fr, int fq) const {
        const int row0 = u.pm * BM + wr * 64 + fr, col0 = u.pn * BM + wc * 32 + 4 * fq;
        if (u.pm >= 64) {
            float* dst = PART + (size_t)(u.kofs / (u.nt * BK * 2)) * TS * D_MODEL;
            float r2[2][4];
#pragma unroll
            for (int ai = 0; ai < 2; ++ai)
#pragma unroll
                for (int m = 0; m < 4; ++m) r2[ai][m] = ss2 ? ssf(ss2 + row0 + ai * HALF + m * 16) : 0.f;
#pragma unroll
            for (int ai = 0; ai < 2; ++ai)
#pragma unroll
                for (int m = 0; m < 4; ++m) { const int row = row0 + ai * HALF + m * 16; const float rr = ss2 ? rsqrtf(r2[ai][m] * (1.f / D_INNER) + EPS) : 1.f;
#pragma unroll
                    for (int bj = 0; bj < 2; ++bj)
#pragma unroll
                        for (int n = 0; n < 2; ++n) *(f32x4*)(dst + (size_t)(row - TP) * D_MODEL + col0 + bj * HALF + n * 16) = acc[ai][bj][m][n] * rr; }
            return;
        }
#pragma unroll
        for (int ai = 0; ai < 2; ++ai)
#pragma unroll
            for (int mp = 0; mp < 2; ++mp) {
                f32x4 xv[2][2][2]; float r2[2];
#pragma unroll
                for (int mm = 0; mm < 2; ++mm) { const int row = row0 + ai * HALF + (2 * mp + mm) * 16;
                    const float* xo = (row < TP ? xin_p + (size_t)row * D_MODEL : xin_s + (size_t)(row - TP) * D_MODEL) + col0;
                    r2[mm] = ss2 ? ssf(ss2 + row) : 0.f;
#pragma unroll
                    for (int bj = 0; bj < 2; ++bj)
#pragma unroll
                        for (int n = 0; n < 2; ++n) xv[mm][bj][n] = *(const f32x4*)(xo + bj * HALF + n * 16); }
#pragma unroll
                for (int mm = 0; mm < 2; ++mm) { const int m = 2 * mp + mm, row = row0 + ai * HALF + m * 16;
                    const float rr = ss2 ? rsqrtf(r2[mm] * (1.f / D_INNER) + EPS) : 1.f;
                    float s = 0.f;
#pragma unroll
                    for (int bj = 0; bj < 2; ++bj)
#pragma unroll
                        for (int n = 0; n < 2; ++n) { const int co = bj * HALF + n * 16;
                            const f32x4 v = xv[mm][bj][n] + acc[ai][bj][m][n] * rr;
                            if (!dry) { *(f32x4*)(X + (size_t)row * D_MODEL + col0 + co) = v;
                                u32x2 o; o[0] = cvt_pk_bf16(v[0], v[1]); o[1] = cvt_pk_bf16(v[2], v[3]);
                                *(u32x2*)(XB + (size_t)row * D_MODEL + col0 + co) = o; }
                            s += v[0] * v[0] + v[1] * v[1] + v[2] * v[2] + v[3] * v[3]; }
                    { const int ln = fq * 16 + fr; s += shx(s, ln, 16); s += shx(s, ln, 32); }
                    if (fq == 0 && !dry) atomicAdd(ssn + row, fx(s)); } }
    }
};
struct EpiSsdIn {
    static constexpr bool PERM = true;
    bf16_t* Z; bf16_t* XBC; float* DT; const u64* ss; const float* dt_bias;
    __device__ __forceinline__ void operator()(const f32x4 (&acc)[2][2][4][2], const Unit& u, int wr, int wc, int fr, int fq) const {
        const int row0 = u.pm * BM + wr * 64 + fr;
        const int kind = u.pn < 8 ? 0 : (u.pn < 20 ? 1 : 2);
        const int colt = kind == 0 ? u.pn * BM : (u.pn - 8) * BM;
        const int col0 = colt + wc * 32 + 8 * fq;
        float rs[2][4];
#pragma unroll
        for (int ai = 0; ai < 2; ++ai)
#pragma unroll
            for (int m = 0; m < 4; ++m) rs[ai][m] = ssf(ss + row0 + ai * HALF + m * 16);
#pragma unroll
        for (int ai = 0; ai < 2; ++ai)
#pragma unroll
            for (int m = 0; m < 4; ++m) { const int row = row0 + ai * HALF + m * 16; const float rstd = rsqrtf(rs[ai][m] * (1.f / D_MODEL) + EPS);
#pragma unroll
                for (int bj = 0; bj < 2; ++bj) { f32x4 v0 = acc[ai][bj][m][0] * rstd, v1 = acc[ai][bj][m][1] * rstd;
                    if (kind == 2) {
                        if (bj == 0 && wc == 0) { const int c = 8 * fq;
                            f32x4 b0 = *(const f32x4*)(dt_bias + c), b1 = *(const f32x4*)(dt_bias + c + 4);
                            f32x4 o0, o1; o0[0] = softplus_f(v0[0] + b0[0]); o0[1] = softplus_f(v0[1] + b0[1]); o0[2] = softplus_f(v0[2] + b0[2]); o0[3] = softplus_f(v0[3] + b0[3]);
                            o1[0] = softplus_f(v1[0] + b1[0]); o1[1] = softplus_f(v1[1] + b1[1]); o1[2] = softplus_f(v1[2] + b1[2]); o1[3] = softplus_f(v1[3] + b1[3]);
                            *(f32x4*)(DT + (size_t)row * 32 + c) = o0; *(f32x4*)(DT + (size_t)row * 32 + c + 4) = o1; }
                    } else {
                        if (kind == 0) { v0[0] = silu_f(v0[0]); v0[1] = silu_f(v0[1]); v0[2] = silu_f(v0[2]); v0[3] = silu_f(v0[3]); v1[0] = silu_f(v1[0]); v1[1] = silu_f(v1[1]); v1[2] = silu_f(v1[2]); v1[3] = silu_f(v1[3]); }
                        u32x4 o; o[0] = cvt_pk_bf16(v0[0], v0[1]); o[1] = cvt_pk_bf16(v0[2], v0[3]); o[2] = cvt_pk_bf16(v1[0], v1[1]); o[3] = cvt_pk_bf16(v1[2], v1[3]);
                        bf16_t* dst = kind == 0 ? Z + (size_t)row * D_INNER : XBC + (size_t)row * CONV_DIM;
                        *(u32x4*)(dst + col0 + bj * HALF) = o; } } }
    }
};
}

__device__ __forceinline__ void transpose_item(const float* W, int K, int N, bf16_t* WT, const float* kscale, int k0, int n0, float* scr, int lane) {
    const int kr = lane >> 3, n4 = (lane & 7) * 4;
    f32x4 v[8]; float sc[8];
#pragma unroll
    for (int i = 0; i < 8; ++i) { v[i] = *(const f32x4*)(W + (size_t)(k0 + kr + 8 * i) * N + n0 + n4); sc[i] = kscale ? kscale[k0 + kr + 8 * i] : 1.f; }
#pragma unroll
    for (int i = 0; i < 8; ++i) { float* t = scr + (kr + 8 * i) * 33 + n4; t[0] = v[i][0] * sc[i]; t[1] = v[i][1] * sc[i]; t[2] = v[i][2] * sc[i]; t[3] = v[i][3] * sc[i]; }
    asm volatile("s_waitcnt lgkmcnt(0)" ::: "memory");
    const int c = lane & 7;
#pragma unroll
    for (int jn = 0; jn < 4; ++jn) { const int n = (lane >> 3) + 8 * jn; const float* t = scr + (8 * c) * 33 + n;
        u32x4 o; o[0] = cvt_pk_bf16(t[0], t[33]); o[1] = cvt_pk_bf16(t[2 * 33], t[3 * 33]); o[2] = cvt_pk_bf16(t[4 * 33], t[5 * 33]); o[3] = cvt_pk_bf16(t[6 * 33], t[7 * 33]);
        *(u32x4*)(WT + (size_t)(n0 + n) * K + k0 + 8 * c) = o; }
    asm volatile("s_waitcnt lgkmcnt(0)" ::: "memory");
}

constexpr int W_FIRST = 16 * 128, W_PER = 16 * 128 + 4 * 8 * 16 + 32 * 32 + 16 * 161 + 32 * 32;
__device__ __forceinline__ void prep_weights(const Params& p, unsigned char* lds, int vb, int VG, const int tid, int it_lo, int it_hi) {
    const int lane = tid & 63, wid = tid >> 6;
    float* scr = (float*)lds + wid * (64 * 33);
    constexpr int T_PIN = 16 * 128, T_MIX = 4 * 8 * 16, T_POUT = 32 * 32, T_SIN = 16 * 161, T_SOUT = 32 * 32, T_PER = T_PIN + T_MIX + T_POUT + T_SIN + T_SOUT;
    for (int it = it_lo + vb * 8 + wid; it < (it_hi < 0 ? 2 * T_PER : it_hi); it += VG * 8) {
        const int j = it / T_PER; int r = it % T_PER;
        if (r < T_PIN) { const int kb = r / 128, nb = r % 128;
            transpose_item(p.pool_in_w + (size_t)j * 1024 * 4096, 1024, 4096, (bf16_t*)(p.ws + WS_WPIN) + (size_t)j * 4096 * 1024, p.norm_w + (2 * j) * 1024, kb * 64, nb * 32, scr, lane); continue; }
        r -= T_PIN;
        if (r < T_MIX) { const int g = r / 128, kb = (r % 128) / 16, nb = r % 16;
            transpose_item(p.pool_mix_w + ((size_t)j * 4 + g) * 512 * 512, 512, 512, (bf16_t*)(p.ws + WS_WMIX) + ((size_t)j * 2048 + g * 512) * 512, nullptr, kb * 64, nb * 32, scr, lane); continue; }
        r -= T_MIX;
        if (r < T_POUT) { const int kb = r / 32, nb = r % 32;
            transpose_item(p.pool_out_w + (size_t)j * 2048 * 1024, 2048, 1024, (bf16_t*)(p.ws + WS_WPOUT) + (size_t)j * 1024 * 2048, nullptr, kb * 64, nb * 32, scr, lane); continue; }
        r -= T_POUT;
        if (r < T_SIN) { const int kb = r / 161, nb = r % 161;
            transpose_item(p.ssd_in_w + (size_t)j * 1024 * SSD_IN, 1024, SSD_IN, (bf16_t*)(p.ws + WS_WSIN) + (size_t)j * SSD_IN_PAD * 1024, p.norm_w + (2 * j + 1) * 1024, kb * 64, nb * 32, scr, lane); continue; }
        r -= T_SIN;
        { const int kb = r / 32, nb = r % 32;
            transpose_item(p.ssd_out_w + (size_t)j * 2048 * 1024, 2048, 1024, (bf16_t*)(p.ws + WS_WSOUT) + (size_t)j * 1024 * 2048, p.ssd_norm_w + j * 2048, kb * 64, nb * 32, scr, lane); }
    }
}

__device__ __forceinline__ void phase_prep(const Params& p, unsigned char* lds, int bid, int G, const int tid) {
    const int lane = tid & 63, wid = tid >> 6;
    prep_weights(p, lds, bid, G, tid, 0, G > 64 ? W_FIRST : -1);
    { const size_t gt = (size_t)bid * NTHREADS + tid, gn = (size_t)G * NTHREADS;
        for (int j = 0; j < 2; ++j) { u32x4* z = (u32x4*)((bf16_t*)(p.ws + WS_WSIN) + ((size_t)j * SSD_IN_PAD + SSD_IN) * 1024);
            const size_t n16 = (size_t)(SSD_IN_PAD - SSD_IN) * 1024 * 2 / 16;
            for (size_t i = gt; i < n16; i += gn) z[i] = (u32x4){0u, 0u, 0u, 0u}; }
        u64* ss = (u64*)(p.ws + WS_SS) + T; for (size_t i = gt; i < (size_t)4 * T; i += gn) ss[i] = 0ull;
        u64* ss2 = (u64*)(p.ws + WS_SS2); for (size_t i = gt; i < (size_t)2 * T; i += gn) ss2[i] = 0ull; }
    { u64* ss0 = (u64*)(p.ws + WS_SS); bf16_t* XB = (bf16_t*)(p.ws + WS_XB);
        for (int row = bid * 8 + wid; row < T; row += G * 8) {
            const float* xr = row < TP ? p.x_prompt + (size_t)row * D_MODEL : p.x_sample + (size_t)(row - TP) * D_MODEL;
            float s = 0.f; f32x4 v[4];
#pragma unroll
            for (int i = 0; i < 4; ++i) v[i] = *(const f32x4*)(xr + i * 256 + lane * 4);
#pragma unroll
            for (int i = 0; i < 4; ++i) {
                s += v[i][0] * v[i][0] + v[i][1] * v[i][1] + v[i][2] * v[i][2] + v[i][3] * v[i][3];
                u32x2 o; o[0] = cvt_pk_bf16(v[i][0], v[i][1]); o[1] = cvt_pk_bf16(v[i][2], v[i][3]);
                *(u32x2*)(XB + (size_t)row * D_MODEL + i * 256 + lane * 4) = o; }
#pragma unroll
            for (int o = 1; o < 64; o <<= 1) s += shx(s, lane, o);
            if (lane == 0) ss0[row] = fx(s); } }
}

__device__ __forceinline__ void ld8(const bf16_t* p, float (&v)[8]) { const u32x4 u = *(const u32x4*)p;
    v[0] = bf_lo(u[0]); v[1] = bf_hi(u[0]); v[2] = bf_lo(u[1]); v[3] = bf_hi(u[1]); v[4] = bf_lo(u[2]); v[5] = bf_hi(u[2]); v[6] = bf_lo(u[3]); v[7] = bf_hi(u[3]); }
__device__ __forceinline__ void ld8f(const float* p, float (&v)[8]) { const f32x4 a = *(const f32x4*)p, b = *(const f32x4*)(p + 4);
    v[0] = a[0]; v[1] = a[1]; v[2] = a[2]; v[3] = a[3]; v[4] = b[0]; v[5] = b[1]; v[6] = b[2]; v[7] = b[3]; }
__device__ __forceinline__ void st8(bf16_t* p, const float (&v)[8]) { u32x4 o; o[0] = cvt_pk_bf16(v[0], v[1]); o[1] = cvt_pk_bf16(v[2], v[3]); o[2] = cvt_pk_bf16(v[4], v[5]); o[3] = cvt_pk_bf16(v[6], v[7]); *(u32x4*)p = o; }
__device__ __forceinline__ void st8f(float* p, const float (&v)[8]) { *(f32x4*)p = (f32x4){v[0], v[1], v[2], v[3]}; *(f32x4*)(p + 4) = (f32x4){v[4], v[5], v[6], v[7]}; }

__device__ __forceinline__ void up8(const u32x4 u, float (&v)[8]) { v[0] = bf_lo(u[0]); v[1] = bf_hi(u[0]); v[2] = bf_lo(u[1]); v[3] = bf_hi(u[1]); v[4] = bf_lo(u[2]); v[5] = bf_hi(u[2]); v[6] = bf_lo(u[3]); v[7] = bf_hi(u[3]); }
__device__ __forceinline__ u32x4 pk8f(const float* p) { const f32x4 a = *(const f32x4*)p, b = *(const f32x4*)(p + 4); u32x4 o; o[0] = cvt_pk_bf16(a[0], a[1]); o[1] = cvt_pk_bf16(a[2], a[3]); o[2] = cvt_pk_bf16(b[0], b[1]); o[3] = cvt_pk_bf16(b[2], b[3]); return o; }

template <int W, int NR, bool PROMPT>
__device__ __forceinline__ void pool_run(const Params& p, int j, const bf16_t* U, bf16_t* P, int run, int c0, int g) {
    const int cl = c0 - g * 512;
    u32x4 ext[W - 1 + NR];
    int row0, t0 = 0, b = 0, sb = 0;
    if (PROMPT) { row0 = run * NR; t0 = row0 & (SEQ - 1); b = row0 >> 11;
#pragma unroll
        for (int k = 0; k < W - 1; ++k) ext[k] = (t0 - (W - 1 - k) >= 0) ? *(const u32x4*)(U + (size_t)(row0 - (W - 1 - k)) * D_INNER + c0) : (u32x4){0u, 0u, 0u, 0u};
    } else { sb = run; row0 = TP + sb * DEC_SEQ;
        const float* buf = p.state_pool + (((size_t)j * DEC_BATCH + sb) * POOL_BUF) * D_INNER + c0;
#pragma unroll
        for (int k = 0; k < W - 1; ++k) ext[k] = pk8f(buf + (size_t)(POOL_BUF - (W - 1 - k)) * D_INNER); }
#pragma unroll
    for (int t = 0; t < NR; ++t) ext[W - 1 + t] = *(const u32x4*)(U + (size_t)(row0 + t) * D_INNER + c0);
    float sum[8], u[8], o[8];
#pragma unroll
    for (int e = 0; e < 8; ++e) sum[e] = 0.f;
#pragma unroll
    for (int k = 0; k < W - 1; ++k) { up8(ext[k], u);
#pragma unroll
        for (int e = 0; e < 8; ++e) sum[e] += u[e]; }
#pragma unroll
    for (int t = 0; t < NR; ++t) { const int row = row0 + t; up8(ext[W - 1 + t], u);
        const float inv = PROMPT ? 1.f / (float)min(t0 + t + 1, W) : 1.f / (float)W;
#pragma unroll
        for (int e = 0; e < 8; ++e) { sum[e] += u[e]; o[e] = sum[e] * inv - u[e]; }
        st8(P + ((size_t)g * T + row) * 512 + cl, o);
        if (PROMPT) { if (t0 + t >= SEQ - POOL_BUF) st8f(p.out + O_POOLP + (((size_t)j * BATCH + b) * POOL_BUF + (t0 + t - (SEQ - POOL_BUF))) * D_INNER + c0, u); }
        else st8f(p.out + O_POOLS + (((size_t)j * DEC_BATCH + sb) * POOL_BUF + (POOL_BUF - DEC_SEQ + t)) * D_INNER + c0, u);
        up8(ext[t], u);
#pragma unroll
        for (int e = 0; e < 8; ++e) sum[e] -= u[e]; }
}

__device__ __forceinline__ void phase_pool(const Params& p, int j, int bid, int G, const int tid) {
    const bf16_t* U = (const bf16_t*)(p.ws + WS_U); bf16_t* P = (bf16_t*)(p.ws + WS_P);
    const int NPR = (TP / 8) * 256, NSA = DEC_BATCH * 256;
    for (int it = bid * NTHREADS + tid; it < NPR + NSA; it += G * NTHREADS) {
        const int chunk = it & 255, run = it >> 8, c0 = chunk * 8, g = __builtin_amdgcn_readfirstlane(chunk >> 6);
        if (run < TP / 8) {
            if (g == 0) pool_run<2, 8, true>(p, j, U, P, run, c0, 0); else if (g == 1) pool_run<4, 8, true>(p, j, U, P, run, c0, 1);
            else if (g == 2) pool_run<8, 8, true>(p, j, U, P, run, c0, 2); else pool_run<16, 8, true>(p, j, U, P, run, c0, 3);
        } else { const int sb = run - TP / 8;
            if (g == 0) pool_run<2, 8, false>(p, j, U, P, sb, c0, 0); else if (g == 1) pool_run<4, 8, false>(p, j, U, P, sb, c0, 1);
            else if (g == 2) pool_run<8, 8, false>(p, j, U, P, sb, c0, 2); else pool_run<16, 8, false>(p, j, U, P, sb, c0, 3);
            const float* buf = p.state_pool + (((size_t)j * DEC_BATCH + sb) * POOL_BUF) * D_INNER + c0;
            float* po = p.out + O_POOLS + (((size_t)j * DEC_BATCH + sb) * POOL_BUF) * D_INNER + c0;
            f32x4 cp[POOL_BUF - DEC_SEQ][2];
#pragma unroll
            for (int i = 0; i < POOL_BUF - DEC_SEQ; ++i) { cp[i][0] = *(const f32x4*)(buf + (size_t)(DEC_SEQ + i) * D_INNER); cp[i][1] = *(const f32x4*)(buf + (size_t)(DEC_SEQ + i) * D_INNER + 4); }
#pragma unroll
            for (int i = 0; i < POOL_BUF - DEC_SEQ; ++i) { *(f32x4*)(po + (size_t)i * D_INNER) = cp[i][0]; *(f32x4*)(po + (size_t)i * D_INNER + 4) = cp[i][1]; }
        }
    }
}

__device__ __forceinline__ void phase_conv(const Params& p, int j, int bid, int G, const int tid) {
    const bf16_t* R = (const bf16_t*)(p.ws + WS_XBC); bf16_t* O = (bf16_t*)(p.ws + WS_XBCC);
    const int NIT = (T / 8) * 384;
    for (int it = bid * NTHREADS + tid; it < NIT; it += G * NTHREADS) {
        const int chunk = it % 384, run = it / 384, c0 = chunk * 8, row0 = run * 8;
        float w0[8], w1[8], w2[8], w3[8], bs[8], h1[8], h2[8], h3[8], cur[8], o[8];
        const bool prompt = row0 < TP; const int t0 = prompt ? (row0 & (SEQ - 1)) : 0;
        u32x4 rr[8];
#pragma unroll
        for (int t = 0; t < 8; ++t) rr[t] = *(const u32x4*)(R + (size_t)(row0 + t) * CONV_DIM + c0);
        if (prompt) {
            if (t0 > 0) { ld8(R + (size_t)(row0 - 3) * CONV_DIM + c0, h3); ld8(R + (size_t)(row0 - 2) * CONV_DIM + c0, h2); ld8(R + (size_t)(row0 - 1) * CONV_DIM + c0, h1); }
            else {
#pragma unroll
                for (int e = 0; e < 8; ++e) { h1[e] = 0.f; h2[e] = 0.f; h3[e] = 0.f; } }
        } else { const int sb = (row0 - TP) >> 3; const float* sc = p.state_conv + (((size_t)j * DEC_BATCH + sb) * 3) * CONV_DIM + c0;
            ld8f(sc, h3); ld8f(sc + CONV_DIM, h2); ld8f(sc + 2 * CONV_DIM, h1); }
        const float* cw = p.ssd_conv_w + (size_t)j * 4 * CONV_DIM + c0;
        ld8f(cw, w0); ld8f(cw + CONV_DIM, w1); ld8f(cw + 2 * CONV_DIM, w2); ld8f(cw + 3 * CONV_DIM, w3); ld8f(p.ssd_conv_b + (size_t)j * CONV_DIM + c0, bs);
#pragma unroll
        for (int t = 0; t < 8; ++t) { const int row = row0 + t;
            up8(rr[t], cur);
#pragma unroll
            for (int e = 0; e < 8; ++e) { const float v = w0[e] * h3[e] + w1[e] * h2[e] + w2[e] * h1[e] + w3[e] * cur[e] + bs[e]; o[e] = silu_f(v); h3[e] = h2[e]; h2[e] = h1[e]; h1[e] = cur[e]; }
            st8(O + (size_t)row * CONV_DIM + c0, o);
            if (prompt) { const int tt = t0 + t; if (tt >= SEQ - 3) st8f(p.out + O_CONVP + (((size_t)j * BATCH + (row0 >> 11)) * 3 + (tt - (SEQ - 3))) * CONV_DIM + c0, cur); }
            else if (t >= DEC_SEQ - 3) st8f(p.out + O_CONVS + (((size_t)j * DEC_BATCH + ((row0 - TP) >> 3)) * 3 + (t - (DEC_SEQ - 3))) * CONV_DIM + c0, cur);
        }
    }
}

#define LAS __attribute__((address_space(3)))
constexpr int RS = 272;
constexpr int L_CS = 0, L_BS = 128 * RS, L_WS = 2 * 128 * RS, L_XT = 3 * 128 * RS, L_XW = L_XT + 64 * RS, L_HS = L_XW + 64 * RS, L_DT = L_HS + 64 * RS  ,
              L_AC = L_DT + 1024  , L_END = L_AC + 1024;
static_assert(L_END <= LDS_STAGE, "scan LDS");
typedef const LAS bf16x8* lfrag_t;
#define LFRAG(ptr, off) (*(lfrag_t)((ptr) + (off)))

__device__ __forceinline__ void scan_unit(const Params& p, int j, LAS unsigned char* L, int unit, const int tid, const int dry) {
    const int lane = tid & 63, w = __builtin_amdgcn_readfirstlane(tid >> 6), fr = lane & 15, fq = lane >> 4;
    const int b = unit >> 5, h = unit & 31, g = h >> 3;
    const bf16_t* XC = (const bf16_t*)(p.ws + WS_XBCC); const bf16_t* Z = (const bf16_t*)(p.ws + WS_Z); const float* DT = (const float*)(p.ws + WS_DT);
    bf16_t* YG = (bf16_t*)(p.ws + WS_Y); u64* ss2 = (u64*)(p.ws + WS_SS2) + (size_t)j * T;
    const float A = -__expf(p.ssd_A_log[j * N_HEADS + h]), Dh = p.ssd_D[j * N_HEADS + h];
    LAS unsigned char* const pCf = L + L_CS + (16 * w + fr) * RS + fq * 16;
    LAS unsigned char* const pBf = L + L_BS + fr * RS + fq * 16;
    LAS unsigned char* const pWr = L + L_WS + (16 * w + fr) * RS + fq * 8;
    LAS unsigned char* const pWf = L + L_WS + (16 * w + fr) * RS + fq * 16;
    LAS unsigned char* const pXf = L + L_XT + fr * RS + fq * 16;
    LAS unsigned char* const pBg = L + L_BS + (fq * 8) * RS + (16 * w + fr) * 2;
    LAS unsigned char* const pSt = L + L_CS + (tid >> 4) * RS + (tid & 15) * 16;
    LAS unsigned char* const pSx = L + L_XT + ((tid >> 7) * 8) * RS + (tid & 127) * 2;
    LAS unsigned char* const pXe = L + L_XT + (fq * 4) * RS + (16 * w + fr) * 2;
    LAS unsigned char* const pDq = L + L_DT + fq * 16;
    LAS unsigned char* const pDj = L + L_DT + (tid & 127) * 4;
    LAS unsigned char* const pDi = L + L_AC + (16 * w + fr) * 4;
    LAS unsigned char* const pHw = L + L_HS + fr * RS + (16 * w + fq * 4) * 2;
    f32x4 hacc[4];
#pragma unroll
    for (int i = 0; i < 4; ++i) hacc[i] = (f32x4){0.f, 0.f, 0.f, 0.f};
    for (int i = tid; i < 64 * RS / 16; i += NTHREADS) *(LAS u32x4*)(L + L_HS + i * 16) = (u32x4){0u, 0u, 0u, 0u};
    u32x4 creg[4], breg[4], xreg[2]; float d0 = 0.f, d1 = 0.f;
    const unsigned voffT = (unsigned)((tid >> 4) * CONV_DIM + (tid & 15) * 8) * 2u, voffX = (unsigned)((tid & 127) * CONV_DIM + (tid >> 7) * 8) * 2u;
#define SCAN_PREFETCH(c_) do { const int r0_ = b * SEQ + (c_) * 128; \
        const char* bB_ = (const char*)(XC + (size_t)r0_ * CONV_DIM + D_INNER + g * 128); const char* bX_ = (const char*)(XC + (size_t)r0_ * CONV_DIM + h * 64); \
        _Pragma("unroll") for (int i = 0; i < 4; ++i) { \
            breg[i] = *(const u32x4*)(bB_ + (size_t)i * (32 * CONV_DIM * 2) + voffT); creg[i] = *(const u32x4*)(bB_ + (size_t)i * (32 * CONV_DIM * 2) + 1024 + voffT); } \
        _Pragma("unroll") for (int i = 0; i < 2; ++i) xreg[i] = *(const u32x4*)(bX_ + i * 64 + voffX); \
        if (w == 0) { d0 = DT[(size_t)(r0_ + 2 * lane) * 32 + h]; d1 = DT[(size_t)(r0_ + 2 * lane + 1) * 32 + h]; } } while (0)
    SCAN_PREFETCH(0);
#pragma unroll 1
    for (int c = 0; c < SEQ / 128; ++c) {
        const int r0 = b * SEQ + c * 128;
        const int po = (c & 1) * 512;
        if (w == 0) { const float a0 = d0 * A, a1 = d1 * A; float v = a0 + a1;
#pragma unroll
            for (int o = 1; o < 64; o <<= 1) { const float t = shup(v, lane, o); if (lane >= o) v += t; }
            *(LAS f32x2*)(L + L_DT + po + lane * 8) = (f32x2){d0, d1}; *(LAS f32x2*)(L + L_AC + po + lane * 8) = (f32x2){v - a1, v}; }
        __syncthreads();
        const float aend = *(const LAS float*)(L + L_AC + po + 127 * 4);
#pragma unroll
        for (int i = 0; i < 4; ++i) { *(LAS u32x4*)(pSt + 128 * RS + i * 32 * RS) = breg[i]; *(LAS u32x4*)(pSt + i * 32 * RS) = creg[i]; }
        { const float wj = __expf(aend - *(const LAS float*)(pDj + 1024 + po)) * *(const LAS float*)(pDj + po);
#pragma unroll
            for (int i = 0; i < 2; ++i)
#pragma unroll
                for (int e2 = 0; e2 < 4; ++e2) { const unsigned u = xreg[i][e2]; const float x0 = bf_lo(u), x1 = bf_hi(u);
                    const int ro = (i * 32 + e2 * 2) * RS;
                    *(LAS bf16_t*)(pSx + ro) = (bf16_t)(u & 0xffffu); *(LAS bf16_t*)(pSx + ro + RS) = (bf16_t)(u >> 16);
                    const unsigned s = cvt_pk_bf16(x0 * wj, x1 * wj);
                    *(LAS bf16_t*)(pSx + 64 * RS + ro) = (bf16_t)(s & 0xffffu); *(LAS bf16_t*)(pSx + 64 * RS + ro + RS) = (bf16_t)(s >> 16); } }
#pragma unroll
        for (int pt = 0; pt < 4; ++pt) { u32x2 o; o[0] = cvt_pk_bf16(hacc[pt][0], hacc[pt][1]); o[1] = cvt_pk_bf16(hacc[pt][2], hacc[pt][3]);
            *(LAS u32x2*)(pHw + pt * 16 * RS) = o; }
        const int irow = r0 + 16 * w + fr;
        u32x2 zreg[4];
#pragma unroll
        for (int pt = 0; pt < 4; ++pt) zreg[pt] = *(const u32x2*)(Z + (size_t)irow * D_INNER + h * 64 + pt * 16 + fq * 4);
        __syncthreads();
        u32x2 wpk[8]; float ea;
        {
            bf16x8 cf[4];
#pragma unroll
            for (int ks = 0; ks < 4; ++ks) cf[ks] = LFRAG(pCf, ks * 64);
            const int i = 16 * w + fr; const float aci = *(const LAS float*)(pDi + po); ea = __expf(aci);
#pragma unroll
            for (int j2 = 0; j2 < 4; ++j2) {
                wpk[2 * j2] = (u32x2){0u, 0u}; wpk[2 * j2 + 1] = (u32x2){0u, 0u};
                if (2 * j2 <= w) {
                    f32x4 g0 = (f32x4){0.f, 0.f, 0.f, 0.f}, g1 = (f32x4){0.f, 0.f, 0.f, 0.f};
#pragma unroll
                    for (int ks = 0; ks < 4; ++ks) { g0 = __builtin_amdgcn_mfma_f32_16x16x32_bf16(LFRAG(pBf, (2 * j2) * 16 * RS + ks * 64), cf[ks], g0, 0, 0, 0);
                        g1 = __builtin_amdgcn_mfma_f32_16x16x32_bf16(LFRAG(pBf, (2 * j2 + 1) * 16 * RS + ks * 64), cf[ks], g1, 0, 0, 0); }
#pragma unroll
                    for (int hh = 0; hh < 2; ++hh) { const int jt = 2 * j2 + hh, j0 = jt * 16 + fq * 4; const f32x4 gg = hh ? g1 : g0;
                        const f32x4 dtj = *(const LAS f32x4*)(pDq + po + jt * 64), acj = *(const LAS f32x4*)(pDq + 1024 + po + jt * 64);
                        float v[4];
#pragma unroll
                        for (int r = 0; r < 4; ++r) v[r] = (j0 + r <= i) ? gg[r] * __expf(aci - acj[r]) * dtj[r] : 0.f;
                        wpk[jt][0] = cvt_pk_bf16(v[0], v[1]); wpk[jt][1] = cvt_pk_bf16(v[2], v[3]); }
                }
                __builtin_amdgcn_sched_barrier(0);
            }
        }
        {
            const float dec = __expf(aend);
#pragma unroll
            for (int pt = 0; pt < 4; ++pt) hacc[pt] = hacc[pt] * dec;
#pragma unroll
            for (int ks = 0; ks < 4; ++ks) { bf16x8 bg;
#pragma unroll
                for (int e = 0; e < 8; ++e) bg[e] = *(const LAS short*)(pBg + (ks * 32 + e) * RS);
#pragma unroll
                for (int pt = 0; pt < 4; ++pt) hacc[pt] = __builtin_amdgcn_mfma_f32_16x16x32_bf16(bg, LFRAG(pXf, 64 * RS + pt * 16 * RS + ks * 64), hacc[pt], 0, 0, 0);
                __builtin_amdgcn_sched_barrier(0); }
        }
        if (c + 1 < SEQ / 128) SCAN_PREFETCH(c + 1);
#pragma unroll
        for (int jt = 0; jt < 8; ++jt) *(LAS u32x2*)(pWr + jt * 32) = wpk[jt];
        asm volatile("s_waitcnt lgkmcnt(0)" ::: "memory");
        {
            f32x4 yd[4], yoff[4];
#pragma unroll
            for (int pt = 0; pt < 4; ++pt) { yd[pt] = (f32x4){0.f, 0.f, 0.f, 0.f}; yoff[pt] = (f32x4){0.f, 0.f, 0.f, 0.f}; }
            LAS unsigned char* const pHf = pXf + 2 * 64 * RS;
#pragma unroll
            for (int ks = 0; ks < 4; ++ks) { const bf16x8 cfk = LFRAG(pCf, ks * 64);
#pragma unroll
                for (int pt = 0; pt < 4; ++pt) yoff[pt] = __builtin_amdgcn_mfma_f32_16x16x32_bf16(LFRAG(pHf, pt * 16 * RS + ks * 64), cfk, yoff[pt], 0, 0, 0);
                __builtin_amdgcn_sched_barrier(0); }
#pragma unroll
            for (int ks = 0; ks < 4; ++ks) if (2 * ks <= w) { const bf16x8 wf = LFRAG(pWf, ks * 64);
#pragma unroll
                for (int pt = 0; pt < 4; ++pt) yd[pt] = __builtin_amdgcn_mfma_f32_16x16x32_bf16(LFRAG(pXf, pt * 16 * RS + ks * 64), wf, yd[pt], 0, 0, 0);
                __builtin_amdgcn_sched_barrier(0); }
            float s = 0.f;
#pragma unroll
            for (int pt = 0; pt < 4; ++pt) { const int p0 = pt * 16 + fq * 4;
                float y[4];
#pragma unroll
                for (int r = 0; r < 4; ++r) { const float x = bf1(*(const LAS bf16_t*)(pXe + (pt * 16 + r) * RS)); y[r] = yd[pt][r] + ea * yoff[pt][r] + Dh * x; }
                y[0] *= bf_lo(zreg[pt][0]); y[1] *= bf_hi(zreg[pt][0]); y[2] *= bf_lo(zreg[pt][1]); y[3] *= bf_hi(zreg[pt][1]);
                s += y[0] * y[0] + y[1] * y[1] + y[2] * y[2] + y[3] * y[3];
                u32x2 o; o[0] = cvt_pk_bf16(y[0], y[1]); o[1] = cvt_pk_bf16(y[2], y[3]);
                *(u32x2*)(YG + (size_t)irow * D_INNER + h * 64 + p0) = o; }
            s += shx(s, lane, 16); s += shx(s, lane, 32);
            if (fq == 0 && !dry) atomicAdd(ss2 + irow, fx(s));
        }
    }
#undef SCAN_PREFETCH
    float* so = p.out + O_SSMP + (((size_t)j * BATCH + b) * N_HEADS + h) * 64 * D_STATE;
#pragma unroll
    for (int pt = 0; pt < 4; ++pt) *(f32x4*)(so + (size_t)(pt * 16 + fr) * D_STATE + 16 * w + fq * 4) = hacc[pt];
    __syncthreads();
}

__device__ __forceinline__ void phase_scan(const Params& p, int j, unsigned char* lds, int bid, int G, const int tid, const int dry) {
    for (int v = bid; v < BATCH * N_HEADS; v += G) { const int x = v & 7, slot = v >> 3, gi = x * 4 + (slot >> 3);
        const int u = (gi >> 2) * N_HEADS + (gi & 3) * 8 + (slot & 7);
        scan_unit(p, j, (LAS unsigned char*)lds, u, tid, dry); }
}

constexpr int D_TOK = 0  , D_YS = 8 * 320 * 4  , D_SDT = D_YS + 8 * 64 * 4  , D_PAR = D_SDT + 128  ;
__device__ __forceinline__ void decode_units(const Params& p, int j, LAS unsigned char* L, int bid, int G, const int tid, const int dry) {
    const int lane = tid & 63, w = __builtin_amdgcn_readfirstlane(tid >> 6), pp = tid >> 3, n0 = (tid & 7) * 16;
    const bf16_t* R = (const bf16_t*)(p.ws + WS_XBC); const bf16_t* Z = (const bf16_t*)(p.ws + WS_Z); const float* DT = (const float*)(p.ws + WS_DT);
    bf16_t* YG = (bf16_t*)(p.ws + WS_Y); u64* ss2 = (u64*)(p.ws + WS_SS2) + (size_t)j * T;
    const int NU = DEC_BATCH * N_HEADS;
    f32x4 hv[4], hvn[4]; float raw[8], rawn[8], hist[3], histn[3], cw[5], cwn[5]; float sd = 0.f, sdn = 0.f, zs = 0.f, zsn = 0.f;
#pragma unroll
    for (int i = 0; i < 8; ++i) { raw[i] = 0.f; rawn[i] = 0.f; }
#pragma unroll
    for (int i = 0; i < 3; ++i) { hist[i] = 0.f; histn[i] = 0.f; }
#pragma unroll
    for (int i = 0; i < 5; ++i) { cw[i] = 0.f; cwn[i] = 0.f; }
#define DEC_LOAD(u_, HV, RAW, HIST, CW, SD, ZS) do { const int sb_ = (u_) >> 5, h_ = (u_) & 31, g_ = h_ >> 3, row0_ = TP + sb_ * DEC_SEQ; \
        const float* sp_ = p.state_ssm + ((((size_t)j * DEC_BATCH + sb_) * N_HEADS + h_) * 64 + pp) * D_STATE + n0; \
        _Pragma("unroll") for (int i = 0; i < 4; ++i) HV[i] = *(const f32x4*)(sp_ + 4 * i); \
        if (tid < 320) { const int col_ = tid < 64 ? h_ * 64 + tid : (tid < 192 ? D_INNER + g_ * 128 + (tid - 64) : D_INNER + 512 + g_ * 128 + (tid - 192)); \
            _Pragma("unroll") for (int t = 0; t < 8; ++t) RAW[t] = bf1(R[(size_t)(row0_ + t) * CONV_DIM + col_]); \
            const float* sc_ = p.state_conv + (((size_t)j * DEC_BATCH + sb_) * 3) * CONV_DIM + col_; \
            HIST[0] = sc_[0]; HIST[1] = sc_[CONV_DIM]; HIST[2] = sc_[2 * CONV_DIM]; \
            const float* cw_ = p.ssd_conv_w + (size_t)j * 4 * CONV_DIM + col_; \
            CW[0] = cw_[0]; CW[1] = cw_[CONV_DIM]; CW[2] = cw_[2 * CONV_DIM]; CW[3] = cw_[3 * CONV_DIM]; CW[4] = p.ssd_conv_b[(size_t)j * CONV_DIM + col_]; } \
        if (tid >= 504) SD = DT[(size_t)(row0_ + tid - 504) * 32 + h_]; \
        ZS = bf1(Z[(size_t)(row0_ + w) * D_INNER + h_ * 64 + lane]); } while (0)
    int u = bid, par = 0;
    if (u < NU) DEC_LOAD(u, hv, raw, hist, cw, sd, zs);
    for (; u < NU; u += G, par ^= 1) {
        LAS unsigned char* const Lp = L + par * D_PAR;
        const int sb = u >> 5, h = u & 31, row0 = TP + sb * DEC_SEQ;
        const float A = -__expf(p.ssd_A_log[j * N_HEADS + h]), Dh = p.ssd_D[j * N_HEADS + h];
        if (tid < 320) { float h3 = hist[0], h2 = hist[1], h1 = hist[2];
#pragma unroll
            for (int t = 0; t < 8; ++t) { const float v = cw[0] * h3 + cw[1] * h2 + cw[2] * h1 + cw[3] * raw[t] + cw[4];
                *(LAS float*)(Lp + D_TOK + (t * 320 + tid) * 4) = silu_f(v); h3 = h2; h2 = h1; h1 = raw[t]; } }
        if (tid >= 504) { *(LAS float*)(Lp + D_SDT + (tid - 504) * 4) = sd; *(LAS float*)(Lp + D_SDT + 32 + (tid - 504) * 4) = __expf(sd * A); }
        __syncthreads();
        if (u + G < NU) DEC_LOAD(u + G, hvn, rawn, histn, cwn, sdn, zsn);
        float part[DEC_SEQ];
#pragma unroll
        for (int t = 0; t < DEC_SEQ; ++t) { LAS unsigned char* const tk = Lp + D_TOK + t * 1280;
            const float dec = *(const LAS float*)(Lp + D_SDT + 32 + t * 4), xdt = *(const LAS float*)(tk + pp * 4) * *(const LAS float*)(Lp + D_SDT + t * 4); float pt = 0.f;
#pragma unroll
            for (int i = 0; i < 4; ++i) { const f32x4 bv = *(const LAS f32x4*)(tk + 256 + (n0 + 4 * i) * 4), cv = *(const LAS f32x4*)(tk + 768 + (n0 + 4 * i) * 4);
                hv[i] = hv[i] * dec + bv * xdt;
                pt += hv[i][0] * cv[0] + hv[i][1] * cv[1] + hv[i][2] * cv[2] + hv[i][3] * cv[3]; }
            part[t] = pt; }
#pragma unroll
        for (int m = 1; m < 8; m <<= 1) {
#pragma unroll
            for (int t = 0; t < DEC_SEQ; ++t) part[t] += shx(part[t], lane, m); }
        if ((tid & 7) == 0) {
#pragma unroll
            for (int t = 0; t < DEC_SEQ; ++t) *(LAS float*)(Lp + D_YS + (t * 64 + pp) * 4) = part[t]; }
        { float* so = p.out + O_SSMS + ((((size_t)j * DEC_BATCH + sb) * N_HEADS + h) * 64 + pp) * D_STATE + n0;
#pragma unroll
            for (int i = 0; i < 4; ++i) *(f32x4*)(so + 4 * i) = hv[i]; }
        __syncthreads();
        { const int t = w, row = row0 + t; const float y = *(const LAS float*)(Lp + D_YS + (t * 64 + lane) * 4) + Dh * *(const LAS float*)(Lp + D_TOK + (t * 320 + lane) * 4);
            const float yg = y * zs;
            YG[(size_t)row * D_INNER + h * 64 + lane] = (bf16_t)(cvt_pk_bf16(yg, 0.f) & 0xffffu);
            float s = yg * yg;
#pragma unroll
            for (int o = 1; o < 64; o <<= 1) s += shx(s, lane, o);
            if (lane == 0 && !dry) atomicAdd(ss2 + row, fx(s)); }
#pragma unroll
        for (int i = 0; i < 4; ++i) hv[i] = hvn[i];
#pragma unroll
        for (int i = 0; i < 8; ++i) raw[i] = rawn[i];
#pragma unroll
        for (int i = 0; i < 3; ++i) hist[i] = histn[i];
#pragma unroll
        for (int i = 0; i < 5; ++i) cw[i] = cwn[i];
        sd = sdn; zs = zsn;
    }
#undef DEC_LOAD
}

__device__ __forceinline__ void sample_fix(const Params& p, int L, int bid, int G, const int tid) {
    const int lane = tid & 63, wid = tid >> 6;
    float* X = (float*)(p.ws + WS_X); bf16_t* XB = (bf16_t*)(p.ws + WS_XB); const float* PART = (const float*)(p.ws + WS_PART);
    u64* ssn = (u64*)(p.ws + WS_SS) + (size_t)(L + 1) * T;
    for (int r = bid * 8 + wid; r < TS; r += G * 8) { const int row = TP + r;
        const float* xo = L == 0 ? p.x_sample + (size_t)r * D_MODEL : X + (size_t)row * D_MODEL;
        f32x4 v[4], ps[4];
#pragma unroll
        for (int i = 0; i < 4; ++i) { v[i] = *(const f32x4*)(xo + i * 256 + lane * 4); ps[i] = (f32x4){0.f, 0.f, 0.f, 0.f}; }
#pragma unroll
        for (int kb = 0; kb < SPLITQ; kb += 4) { f32x4 q[4][4];
#pragma unroll
            for (int i = 0; i < 4; ++i)
#pragma unroll
                for (int k = 0; k < 4; ++k) q[k][i] = *(const f32x4*)(PART + ((size_t)(kb + k) * TS + r) * D_MODEL + i * 256 + lane * 4);
#pragma unroll
            for (int i = 0; i < 4; ++i) ps[i] = (((ps[i] + q[0][i]) + q[1][i]) + q[2][i]) + q[3][i]; }
        float s = 0.f;
#pragma unroll
        for (int i = 0; i < 4; ++i) { const f32x4 x = v[i] + ps[i];
            *(f32x4*)(X + (size_t)row * D_MODEL + i * 256 + lane * 4) = x;
            u32x2 o; o[0] = cvt_pk_bf16(x[0], x[1]); o[1] = cvt_pk_bf16(x[2], x[3]);
            *(u32x2*)(XB + (size_t)row * D_MODEL + i * 256 + lane * 4) = o;
            s += x[0] * x[0] + x[1] * x[1] + x[2] * x[2] + x[3] * x[3]; }
#pragma unroll
        for (int o = 1; o < 64; o <<= 1) s += shx(s, lane, o);
        if (lane == 0) ssn[row] = fx(s); }
}

__device__ __forceinline__ void phase_final(const Params& p, int bid, int G, const int tid) {
    const int lane = tid & 63, wid = tid >> 6;
    const float* X = (const float*)(p.ws + WS_X); const u64* ss = (const u64*)(p.ws + WS_SS) + (size_t)4 * T;
    f32x4 wv[4];
#pragma unroll
    for (int i = 0; i < 4; ++i) wv[i] = *(const f32x4*)(p.final_norm_w + i * 256 + lane * 4);
    const float* PART = (const float*)(p.ws + WS_PART);
    for (int row = bid * 8 + wid; row < T; row += G * 8) { f32x4 v[4];
#pragma unroll
        for (int i = 0; i < 4; ++i) v[i] = *(const f32x4*)(X + (size_t)row * D_MODEL + i * 256 + lane * 4);
        float rstd;
        if (row >= TP) {
            f32x4 ps[4];
#pragma unroll
            for (int i = 0; i < 4; ++i) ps[i] = (f32x4){0.f, 0.f, 0.f, 0.f};
#pragma unroll
            for (int kb = 0; kb < SPLITQ; kb += 4) { f32x4 q[4][4];
#pragma unroll
                for (int i = 0; i < 4; ++i)
#pragma unroll
                    for (int k = 0; k < 4; ++k) q[k][i] = *(const f32x4*)(PART + ((size_t)(kb + k) * TS + (row - TP)) * D_MODEL + i * 256 + lane * 4);
#pragma unroll
                for (int i = 0; i < 4; ++i) ps[i] = (((ps[i] + q[0][i]) + q[1][i]) + q[2][i]) + q[3][i]; }
            float s = 0.f;
#pragma unroll
            for (int i = 0; i < 4; ++i) { v[i] = v[i] + ps[i]; s += v[i][0] * v[i][0] + v[i][1] * v[i][1] + v[i][2] * v[i][2] + v[i][3] * v[i][3]; }
#pragma unroll
            for (int o = 1; o < 64; o <<= 1) s += shx(s, lane, o);
            rstd = rsqrtf(s * (1.f / D_MODEL) + EPS);
        } else rstd = rsqrtf(ssf(ss + row) * (1.f / D_MODEL) + EPS);
#pragma unroll
        for (int i = 0; i < 4; ++i) *(f32x4*)(p.out + (size_t)row * D_MODEL + i * 256 + lane * 4) = v[i] * rstd * wv[i]; }
}

#define XB_TMO      128
#define XB_XCNT(j)  (256  + 64 * (j))
#define XB_XSUB(j)  (1280 + 64 * (j))
#define XB_XGEN(j)  (2304 + 64 * (j))
#define XB_TOP      3328
#define XB_TOPGEN   3392
#define XCD_BAR_WORDS 3456
#define XB_SPIN_CAP (1u << 18)
__device__ __forceinline__ unsigned xb_ld(unsigned* p)              { return __hip_atomic_load(p, __ATOMIC_RELAXED, __HIP_MEMORY_SCOPE_AGENT); }
__device__ __forceinline__ unsigned xb_add(unsigned* p, unsigned v) { return __hip_atomic_fetch_add(p, v, __ATOMIC_RELAXED, __HIP_MEMORY_SCOPE_AGENT); }
__device__ __forceinline__ unsigned xb_xcc_id() { return (unsigned)__builtin_amdgcn_s_getreg((3 << 11) | 20) & 0xFu; }
#define XB_SPIN(cond, bar) do { unsigned _sp = 0; while (cond) { __builtin_amdgcn_s_sleep(1); \
    if ((++_sp & 255u) == 0u) { if (xb_ld(&(bar)[XB_TMO])) break; if (_sp > XB_SPIN_CAP) { atomicAdd(&(bar)[XB_TMO], 1u); break; } } } } while (0)
struct XcdBarrier { unsigned* bar; unsigned x; volatile LAS unsigned* st; };
__device__ __forceinline__ XcdBarrier xcd_barrier_post(unsigned* bar, volatile LAS unsigned* st) {
    XcdBarrier b; b.bar = bar; b.x = xb_xcc_id(); b.st = st;
    if (threadIdx.x == 0) (void)xb_add(&bar[XB_XCNT(b.x)], 1u);
    return b;
}
__device__ __forceinline__ void xcd_barrier_complete(unsigned* bar, unsigned x, unsigned& nloc, unsigned& nx) {
    const unsigned G = gridDim.x * gridDim.y * gridDim.z;
    unsigned sum, cnt, mine, sp = 0u;
    for (;;) {
        sum = 0u; cnt = 0u; mine = 0u;
#pragma unroll
        for (unsigned j = 0; j < 16; ++j) { const unsigned c = xb_ld(&bar[XB_XCNT(j)]); sum += c; cnt += (c > 0u) ? 1u : 0u; }
        if (sum == G) { mine = xb_ld(&bar[XB_XCNT(x)]); break; }
        __builtin_amdgcn_s_sleep(1);
        if ((++sp & 255u) == 0u) { if (xb_ld(&bar[XB_TMO])) break; if (sp > XB_SPIN_CAP) { atomicAdd(&bar[XB_TMO], 1u); break; } }
    }
    nloc = mine > 0u ? mine : 1u; nx = cnt > 0u ? cnt : 1u;
}
__device__ __forceinline__ void xcd_barrier(const XcdBarrier& b, const int tid) {
    asm volatile("s_waitcnt vmcnt(0)" ::: "memory");
    __syncthreads();
    if (tid == 0) {
        unsigned* bar = b.bar;
        __builtin_amdgcn_s_waitcnt(0);
        unsigned nloc = b.st[0], nx = b.st[1];
        if (nloc == 0u) { xcd_barrier_complete(bar, b.x, nloc, nx); b.st[0] = nloc; b.st[1] = nx; }
        const unsigned old = xb_add(&bar[XB_XSUB(b.x)], 1u);
        const unsigned gen = old / nloc;
        if (old + 1u == (gen + 1u) * nloc) {
            __builtin_amdgcn_fence(__ATOMIC_RELEASE, "agent");
            asm volatile("s_waitcnt vmcnt(0)" ::: "memory");
            const unsigned og = xb_add(&bar[XB_TOP], 1u);
            const unsigned tg = og / nx;
            if (og + 1u == (tg + 1u) * nx) xb_add(&bar[XB_TOPGEN], 1u);
            else XB_SPIN(xb_ld(&bar[XB_TOPGEN]) == tg, bar);
            __builtin_amdgcn_fence(__ATOMIC_ACQUIRE, "agent");
            xb_add(&bar[XB_XGEN(b.x)], 1u);
            asm volatile("s_waitcnt vmcnt(0)" ::: "memory");
        } else {
            XB_SPIN(xb_ld(&bar[XB_XGEN(b.x)]) == gen, bar);
            __builtin_amdgcn_fence(__ATOMIC_ACQUIRE, "agent");
            asm volatile("s_waitcnt vmcnt(0)" ::: "memory");
        }
    }
    __syncthreads();
}

constexpr int N_PHASES = 18;
#ifndef PH_MASK
#define PH_MASK 0x1ff
#endif
#define PH_ON(k) ((PH_MASK >> (k)) & 1)
#ifndef REP_MASK
#define REP_MASK 0
#endif
#define NREP(k) (((REP_MASK >> (k)) & 1) ? 2 : 1)
#define FRESH_TID(name) int name##_z = 0; asm volatile("" : "+v"(name##_z)); const int name = wid_s * 64 + (int)__builtin_amdgcn_mbcnt_hi(~0u, __builtin_amdgcn_mbcnt_lo(~0u, (unsigned)name##_z))
__global__ void __launch_bounds__(NTHREADS, 2) fwd_kernel(Params pin) {
    extern __shared__ __attribute__((aligned(16))) unsigned char shm[];
    volatile LAS unsigned* bst = (volatile LAS unsigned*)(LAS unsigned char*)(shm + LDS_STAGE);
    if (threadIdx.x == 0) { bst[0] = 0u; bst[1] = 0u; }
    __syncthreads();
    const XcdBarrier xbar = xcd_barrier_post((unsigned*)(pin.ws + WS_CTL), bst);
    const int wid_s = __builtin_amdgcn_readfirstlane((int)threadIdx.x >> 6);
    if (pin.ph_lo == 0) {
        const int bid = (int)blockIdx.x, G = (int)gridDim.x, tid = (int)threadIdx.x;
        if (PH_ON(0)) for (int rep = 0; rep < NREP(0); ++rep) phase_prep(pin, (unsigned char*)shm, bid, G, tid);
        if (pin.ph_hi > 1000) cg::this_grid().sync();
        else if (pin.ph_hi > 1) xcd_barrier(xbar, tid);
    }
    for (int ph = pin.ph_lo > 1 ? pin.ph_lo : 1; ph < pin.ph_hi; ++ph) {
        int sz = 0; asm volatile("" : "+s"(sz));
        const int bid = (int)blockIdx.x + sz, G = (int)gridDim.x + sz;
        Params p = pin; p.ws = pin.ws + sz; p.out = pin.out + sz;
        unsigned lb = (unsigned)(size_t)(LAS unsigned char*)shm; asm volatile("" : "+s"(lb));
        LAS unsigned char* const lds3 = (LAS unsigned char*)(size_t)lb; unsigned char* const ldsg = (unsigned char*)lds3;
        if (false) {}
        else if (ph == N_PHASES - 1) { if (PH_ON(1)) { FRESH_TID(t1); for (int rep = 0; rep < NREP(1); ++rep) phase_final(p, bid, G, t1); } }
        else {
            const int L = (ph - 1) >> 2, sub = (ph - 1) & 3, j = L >> 1; const bool ssd = L & 1;
            u64* SS = (u64*)(p.ws + WS_SS);
            if (sub == 0) {
                pg8::Sched S;
                if (!ssd) { if (PH_ON(2)) { S.init(NPANEL, 16, G, bid, 0, 16, 0);
                    pg8::Gemm g{(const bf16_t*)(p.ws + WS_XB), (const bf16_t*)(p.ws + WS_WPIN) + (size_t)j * 4096 * 1024, T, 4096, 1024};
                    pg8::EpiPoolIn E{(bf16_t*)(p.ws + WS_U), (bf16_t*)(p.ws + WS_Z), SS + (size_t)L * T};
                    FRESH_TID(t2); for (int rep = 0; rep < NREP(2); ++rep) pg8::gemm_phase(lds3, g, S, E, t2);
                    if (L == 0 && G > 64 && bid >= 64) prep_weights(p, ldsg, bid - 64, G - 64, t2, W_FIRST, G > 148 ? W_PER : -1); }
                } else if (PH_ON(3)) { S.init(NPANEL, SSD_IN_PAD / 256, G, bid, 0, 16, 0);
                    pg8::Gemm g{(const bf16_t*)(p.ws + WS_XB), (const bf16_t*)(p.ws + WS_WSIN) + (size_t)j * SSD_IN_PAD * 1024, T, SSD_IN_PAD, 1024};
                    pg8::EpiSsdIn E{(bf16_t*)(p.ws + WS_Z), (bf16_t*)(p.ws + WS_XBC), (float*)(p.ws + WS_DT), SS + (size_t)L * T, p.ssd_dt_bias + j * N_HEADS};
                    FRESH_TID(t3); for (int rep = 0; rep < NREP(3); ++rep) pg8::gemm_phase(lds3, g, S, E, t3);
                    if (L == 1 && G > 148 && bid >= 148) prep_weights(p, ldsg, bid - 148, G - 148, t3, W_PER, -1);
                }
            } else if (sub == 1) {
                if (!ssd) { if (PH_ON(4)) { FRESH_TID(t4); for (int rep = 0; rep < NREP(4); ++rep) phase_pool(p, j, bid, G, t4); } } else if (PH_ON(5)) { FRESH_TID(t5); for (int rep = 0; rep < NREP(5); ++rep) { phase_conv(p, j, bid, G, t5); decode_units(p, j, lds3, bid, G, t5, rep); } }
            } else if (sub == 2) {
                if (!ssd) { if (PH_ON(6)) { pg8::Sched S; S.init(NPANEL, 8, G, bid, 1, 8, 0);
                    pg8::Gemm g{(const bf16_t*)(p.ws + WS_P), (const bf16_t*)(p.ws + WS_WMIX) + (size_t)j * 2048 * 512, 4 * T, 2048, 512};
                    pg8::EpiPoolMix E{(bf16_t*)(p.ws + WS_Y), (const bf16_t*)(p.ws + WS_Z), p.pool_scale + j * D_INNER};
                    FRESH_TID(t6); for (int rep = 0; rep < NREP(6); ++rep) pg8::gemm_phase(lds3, g, S, E, t6); }
                } else if (PH_ON(7)) { FRESH_TID(t7); for (int rep = 0; rep < NREP(7); ++rep) phase_scan(p, j, ldsg, bid, G, t7, rep); }
            } else if (PH_ON(8)) {
                pg8::Sched S; S.init(64, 4, G, bid, 0, 32, 1);
                const bf16_t* Wt = ssd ? (const bf16_t*)(p.ws + WS_WSOUT) + (size_t)j * 1024 * 2048 : (const bf16_t*)(p.ws + WS_WPOUT) + (size_t)j * 1024 * 2048;
                pg8::Gemm g{(const bf16_t*)(p.ws + WS_Y), Wt, T, 1024, 2048};
                float* X = (float*)(p.ws + WS_X);
                pg8::EpiOut E{L == 0 ? p.x_prompt : X, L == 0 ? p.x_sample : X + (size_t)TP * D_MODEL, X, (bf16_t*)(p.ws + WS_XB), SS + (size_t)(L + 1) * T,
                              ssd ? (const u64*)(p.ws + WS_SS2) + (size_t)j * T : nullptr, 0, (float*)(p.ws + WS_PART)};
                FRESH_TID(t8); for (int rep = 0; rep < NREP(8); ++rep) { E.dry = rep; pg8::gemm_phase(lds3, g, S, E, t8); }
                if (L < 3) { xcd_barrier(xbar, t8); sample_fix(p, L, bid, G, t8); }
            }
        }
        if (ph + 1 < pin.ph_hi) { int tz2 = 0; asm volatile("" : "+v"(tz2));
            xcd_barrier(xbar, wid_s * 64 + (int)__builtin_amdgcn_mbcnt_hi(~0u, __builtin_amdgcn_mbcnt_lo(~0u, (unsigned)tz2))); }
    }
}

extern "C" void kernel_launch(void* const* d_in, const int* in_sizes, int n_in, void* d_out, int out_size, void* d_ws, size_t ws_size, hipStream_t stream) {
    static int grid = 0;
    if (grid == 0) {
        if (n_in != 19 || ws_size < WS_END) { fprintf(stderr, "kernel_launch: unexpected n_in %d / ws_size %zu (need %zu)\n", n_in, ws_size, (size_t)WS_END); grid = -1; return; }
        if (hipFuncSetAttribute((const void*)fwd_kernel, hipFuncAttributeMaxDynamicSharedMemorySize, LDS_BYTES) != hipSuccess) { fprintf(stderr, "kernel_launch: hipFuncSetAttribute failed\n"); grid = -1; return; }
        int dev = 0, cus = 0, per_cu = 0;
        hipGetDevice(&dev); hipDeviceGetAttribute(&cus, hipDeviceAttributeMultiprocessorCount, dev);
        hipOccupancyMaxActiveBlocksPerMultiprocessor(&per_cu, (const void*)fwd_kernel, NTHREADS, LDS_BYTES);
        (void)hipGetLastError();
        if (per_cu < 1) per_cu = 1;
        grid = cus;
    }
    if (grid < 0) return;
    Params p{};
    const float** f = (const float**)&p;
    for (int i = 0; i < 19; ++i) f[i] = (const float*)d_in[i];
    p.out = (float*)d_out; p.ws = (unsigned char*)d_ws;
    if (hipMemsetAsync((char*)d_ws + WS_CTL, 0, 16384, stream) != hipSuccess) { fprintf(stderr, "kernel_launch: memset failed\n"); return; }
#if MK_MULTI
    for (int ph = 0; ph < N_PHASES; ++ph) { p.ph_lo = ph; p.ph_hi = ph + 1; hipLaunchKernelGGL(fwd_kernel, dim3(grid), dim3(NTHREADS), LDS_BYTES, stream, p); }
#else
    p.ph_lo = 0; p.ph_hi = N_PHASES;
    void* args[] = {&p};
    hipError_t e = hipLaunchCooperativeKernel((const void*)fwd_kernel, dim3(grid), dim3(NTHREADS), args, LDS_BYTES, stream);
    if (e != hipSuccess) fprintf(stderr, "cooperative launch failed: %s (grid %d)\n", hipGetErrorString(e), grid);
#endif
}
```
